# Optimizing an MI355X kernel written in HIP

```python
import math
import jax, jax.numpy as jnp
from jax import lax
import numpy as np

D_MODEL = 1024
BATCH = 2
SEQ = 16384
DEPTH = 4

N_META = 16
CHUNK = 64
CONV_K = 4
N_BRANCH = 4
BRANCH_W = D_MODEL // 2

GDN_DK = 128
GDN_DV = 128
GDN_HEADS = BRANCH_W // GDN_DV

M2_HEADDIM = 64
M2_HEADS = BRANCH_W // M2_HEADDIM
M2_GROUPS = 2
M2_HPG = M2_HEADS // M2_GROUPS
M2_DSTATE = 128

HG_DK = 128
HG_HEADS = BRANCH_W // HG_DK
HG_DV = BRANCH_W // HG_HEADS

S5_GROUP = 16
S5_NG = BRANCH_W // S5_GROUP
S5_P = 64

ALPHA = (2 * DEPTH) ** 0.25
BETA_INIT = (8 * DEPTH) ** -0.25
LN_EPS = 1e-5
RMS_EPS = 1e-6

IN_SIZES = (
    3 * BRANCH_W,
    BRANCH_W,
    GDN_HEADS,
    GDN_HEADS,
    BRANCH_W + 2 * M2_GROUPS * M2_DSTATE,
    BRANCH_W,
    M2_HEADS,
    BRANCH_W,
    BRANCH_W,
    BRANCH_W,
    BRANCH_W,
    BRANCH_W,
    BRANCH_W,
    N_BRANCH * D_MODEL,
)
N_IN = sum(IN_SIZES)
IN_OFFSETS = tuple(sum(IN_SIZES[:i + 1]) for i in range(len(IN_SIZES) - 1))

kernel_name = 'hybrid_gdn_ssd_hgrn2_s5_parallel_gated'


def layer_norm(x, g, b):
    xf = x.astype(jnp.float32)
    mu = jnp.mean(xf, axis=-1, keepdims=True)
    var = jnp.mean(jnp.square(xf - mu), axis=-1, keepdims=True)
    return ((xf - mu) * lax.rsqrt(var + LN_EPS) * g + b).astype(x.dtype)


def rms_norm(t):
    return t * lax.rsqrt(jnp.mean(jnp.square(t), axis=-1, keepdims=True) + RMS_EPS)


def l2_norm(t):
    return t * lax.rsqrt(jnp.sum(jnp.square(t), axis=-1, keepdims=True) + RMS_EPS)


def heads(t, n):
    return t.reshape(t.shape[:-1] + (n, t.shape[-1] // n))


def causal_conv(x, w):
    L = x.shape[1]
    xp = jnp.pad(x, ((0, 0), (CONV_K - 1, 0), (0, 0)))
    out = xp[:, CONV_K - 1:] * w[CONV_K - 1]
    for j in range(CONV_K - 1):
        out = out + xp[:, j:j + L] * w[j]
    return out


def front_pad_chunks(t, pad):
    t = jnp.pad(t, ((0, 0), (pad, 0)) + ((0, 0),) * (t.ndim - 2))
    return t.reshape((t.shape[0], -1, CHUNK) + t.shape[2:])


def causal_mask(strict=False):
    i = jnp.arange(CHUNK)
    return (i[:, None] > i[None, :]) if strict else (i[:, None] >= i[None, :])


def gated_delta_rule(q, k, v, g, beta):
    L = q.shape[1]
    pad = (-L) % CHUNK
    prep = lambda t: jnp.moveaxis(front_pad_chunks(t, pad), 3, 1)
    q, k, v, g, beta = prep(q), prep(k), prep(v), prep(g), prep(beta)
    gc = jnp.cumsum(g, axis=-1)
    decay = jnp.exp(jnp.where(causal_mask(), gc[..., :, None] - gc[..., None, :], -jnp.inf))
    kb = k * beta[..., None]
    a = jnp.where(causal_mask(True), jnp.einsum('bhnid,bhnjd->bhnij', kb, k) * decay, 0.0)
    system = a + jnp.eye(CHUNK, dtype=a.dtype)
    u = lax.linalg.triangular_solve(system, v * beta[..., None], left_side=True, lower=True, unit_diagonal=True)
    w = lax.linalg.triangular_solve(system, kb * jnp.exp(gc)[..., None], left_side=True, lower=True, unit_diagonal=True)
    qk = jnp.einsum('bhnid,bhnjd->bhnij', q, k) * decay
    q_dec = q * jnp.exp(gc)[..., None]
    k_dec = k * jnp.exp(gc[..., -1:] - gc)[..., None]
    g_tot = jnp.exp(gc[..., -1])

    def step(S, inp):
        u_n, w_n, qk_n, qd_n, kd_n, gt_n = inp
        v_new = u_n - jnp.einsum('bhck,bhkv->bhcv', w_n, S)
        o_n = jnp.einsum('bhck,bhkv->bhcv', qd_n, S) + jnp.einsum('bhij,bhjv->bhiv', qk_n, v_new)
        S = S * gt_n[..., None, None] + jnp.einsum('bhck,bhcv->bhkv', kd_n, v_new)
        return S, o_n

    xs = tuple(jnp.moveaxis(t, 2, 0) for t in (u, w, qk, q_dec, k_dec, g_tot))
    S0 = jnp.zeros(q.shape[:2] + (q.shape[-1], v.shape[-1]), jnp.float32)
    _, o = lax.scan(step, S0, xs)
    o = jnp.moveaxis(o, 0, 2)
    o = jnp.moveaxis(o, 1, 3).reshape(o.shape[0], -1, o.shape[1], o.shape[-1])
    return o[:, pad:]


def ssd_chunked(xdt, a, Bm, Cm):
    L = xdt.shape[1]
    pad = (-L) % CHUNK
    X = front_pad_chunks(xdt, pad)
    Bsz, Nc = X.shape[:2]
    X = X.reshape(Bsz, Nc, CHUNK, M2_GROUPS, M2_HPG, M2_HEADDIM)
    Bc = front_pad_chunks(Bm, pad)
    Cc = front_pad_chunks(Cm, pad)
    a_cum = jnp.cumsum(front_pad_chunks(a, pad).reshape(Bsz, Nc, CHUNK, M2_GROUPS, M2_HPG), axis=2)
    diff = a_cum[:, :, :, None] - a_cum[:, :, None, :]
    Lmat = jnp.exp(jnp.where(causal_mask()[:, :, None, None], diff, -jnp.inf))
    CB = jnp.einsum('bnlgs,bnmgs->bnlmg', Cc, Bc)
    y_diag = jnp.einsum('bnlmgk,bnmgkp->bnlgkp', CB[..., None] * Lmat, X)
    decay_states = jnp.exp(a_cum[:, :, -1:] - a_cum)
    states = jnp.einsum('bnlgs,bnlgkp->bngkps', Bc, X * decay_states[..., None])
    chunk_decay = jnp.exp(a_cum[:, :, -1])

    def step(S, inp):
        st, dc = inp
        return S * dc[..., None, None] + st, S

    S0 = jnp.zeros((Bsz, M2_GROUPS, M2_HPG, M2_HEADDIM, M2_DSTATE), jnp.float32)
    _, S_start = lax.scan(step, S0, (jnp.moveaxis(states, 1, 0), jnp.moveaxis(chunk_decay, 1, 0)))
    S_start = jnp.moveaxis(S_start, 0, 1)
    y_off = jnp.einsum('bnlgs,bngkps->bnlgkp', Cc, S_start) * jnp.exp(a_cum)[..., None]
    y = (y_diag + y_off).reshape(Bsz, Nc * CHUNK, M2_HEADS, M2_HEADDIM)
    return y[:, pad:]


def hgrn2_chunked(q, log_f, k, i):
    L = q.shape[1]
    pad = (-L) % CHUNK
    prep = lambda t: jnp.moveaxis(front_pad_chunks(t, pad), 3, 1)
    q, log_f, k, i = prep(q), prep(log_f), prep(k), prep(i)
    Bsz, H, Nc = q.shape[:3]

    def intra(S, inp):
        q_t, f_t, k_t, i_t = inp
        S = S * f_t[..., None] + k_t[..., None] * i_t[..., None, :]
        return S, jnp.einsum('bhnk,bhnkv->bhnv', q_t, S)

    xs = tuple(jnp.moveaxis(t, 3, 0) for t in (q, jnp.exp(log_f), k, i))
    S_loc, o_intra = lax.scan(intra, jnp.zeros((Bsz, H, Nc, HG_DK, HG_DV), jnp.float32), xs)
    o_intra = jnp.moveaxis(o_intra, 0, 3)
    g_cum = jnp.cumsum(log_f, axis=3)
    chunk_decay = jnp.exp(g_cum[:, :, :, -1])

    def inter(S, inp):
        s_loc, dc = inp
        return S * dc[..., None] + s_loc, S

    _, S_start = lax.scan(inter, jnp.zeros((Bsz, H, HG_DK, HG_DV), jnp.float32),
                          (jnp.moveaxis(S_loc, 2, 0), jnp.moveaxis(chunk_decay, 2, 0)))
    S_start = jnp.moveaxis(S_start, 0, 2)
    o = o_intra + jnp.einsum('bhnck,bhnkv->bhncv', q * jnp.exp(g_cum), S_start)
    o = jnp.moveaxis(o, 1, 3).reshape(Bsz, Nc * CHUNK, H, HG_DV)
    return o[:, pad:]


def s5_ssm(u, A_re, A_im, B_re, B_im, C_re, C_im, D, log_dt):
    f = lambda t: t.astype(jnp.float32)
    A_re, A_im, B_re, B_im, C_re, C_im, D = map(f, (A_re, A_im, B_re, B_im, C_re, C_im, D))
    Bsz, L, _ = u.shape
    ug = u.reshape(Bsz, L, S5_NG, S5_GROUP)
    dt = jnp.exp(f(log_dt))[:, None]
    mag = jnp.exp(A_re * dt)
    lam_re, lam_im = mag * jnp.cos(A_im * dt), mag * jnp.sin(A_im * dt)
    den = jnp.square(A_re) + jnp.square(A_im)
    nr, ni = lam_re - 1.0, lam_im
    z_re, z_im = (nr * A_re + ni * A_im) / den, (ni * A_re - nr * A_im) / den
    Bb_re = z_re[..., None] * B_re - z_im[..., None] * B_im
    Bb_im = z_re[..., None] * B_im + z_im[..., None] * B_re
    bu_re = jnp.einsum('gpc,blgc->lbgp', Bb_re, ug)
    bu_im = jnp.einsum('gpc,blgc->lbgp', Bb_im, ug)
    a_re = jnp.broadcast_to(lam_re, (L, 1, S5_NG, S5_P))
    a_im = jnp.broadcast_to(lam_im, (L, 1, S5_NG, S5_P))

    def combine(e1, e2):
        a1r, a1i, b1r, b1i = e1
        a2r, a2i, b2r, b2i = e2
        return (a1r * a2r - a1i * a2i, a1r * a2i + a1i * a2r,
                a2r * b1r - a2i * b1i + b2r, a2r * b1i + a2i * b1r + b2i)

    _, _, x_re, x_im = lax.associative_scan(combine, (a_re, a_im, bu_re, bu_im), axis=0)
    y = jnp.einsum('gcp,lbgp->blgc', C_re, x_re) - jnp.einsum('gcp,lbgp->blgc', C_im, x_im)
    return y.reshape(Bsz, L, BRANCH_W) + D * u


def hybrid_layer(h, w_in, gdn_conv_w, gdn_A_log, gdn_dt_bias, gdn_norm_w,
                 m2_conv_w, m2_conv_b, m2_dt_bias, m2_A_log, m2_D, m2_norm_w,
                 hg_lb, hg_norm_w,
                 s5_A_re, s5_A_im, s5_B_re, s5_B_im, s5_C_re, s5_C_im, s5_D, s5_log_dt,
                 s5_glu_w1, s5_glu_w2, w_branch, w_out, ln_g, ln_b):
    f32 = lambda t: t.astype(jnp.float32)
    Bsz, L, _ = h.shape
    proj = h @ w_in
    (gdn_qkv, gdn_z, gdn_b, gdn_a, m2_xbc, m2_z, m2_dt,
     hg_q, hg_f, hg_i, hg_z, s5_u, s5_z, gates) = jnp.split(proj, IN_OFFSETS, axis=-1)

    qkv = jax.nn.silu(causal_conv(f32(gdn_qkv), f32(gdn_conv_w)))
    q, k, v = jnp.split(qkv, 3, axis=-1)
    q = l2_norm(heads(q, GDN_HEADS)) * GDN_DK ** -0.5
    k = l2_norm(heads(k, GDN_HEADS))
    v = heads(v, GDN_HEADS)
    beta = jax.nn.sigmoid(f32(gdn_b))
    g = -jnp.exp(f32(gdn_A_log)) * jax.nn.softplus(f32(gdn_a) + f32(gdn_dt_bias))
    o_a = gated_delta_rule(q, k, v, g, beta)
    y_a = (rms_norm(o_a) * f32(gdn_norm_w)).reshape(Bsz, L, BRANCH_W) * jax.nn.silu(f32(gdn_z))

    xbc = jax.nn.silu(causal_conv(f32(m2_xbc), f32(m2_conv_w)) + f32(m2_conv_b))
    xs, Bm, Cm = jnp.split(xbc, [BRANCH_W, BRANCH_W + M2_GROUPS * M2_DSTATE], axis=-1)
    xs = heads(xs, M2_HEADS)
    Bm, Cm = heads(Bm, M2_GROUPS), heads(Cm, M2_GROUPS)
    dt = jax.nn.softplus(f32(m2_dt) + f32(m2_dt_bias))
    y_ssd = ssd_chunked(xs * dt[..., None], dt * (-jnp.exp(f32(m2_A_log))), Bm, Cm)
    y_ssd = (y_ssd + f32(m2_D)[:, None] * xs).reshape(Bsz, L, BRANCH_W)
    y_b = rms_norm(heads(y_ssd * jax.nn.silu(f32(m2_z)), M2_GROUPS)).reshape(Bsz, L, BRANCH_W) * f32(m2_norm_w)

    zf = f32(hg_f)
    log_f = jnp.logaddexp(jnp.log(hg_lb), jnp.log1p(-hg_lb) + jax.nn.log_sigmoid(zf))
    k_c = (1.0 - hg_lb) * jax.nn.sigmoid(-zf)
    o_c = hgrn2_chunked(heads(jax.nn.silu(f32(hg_q)), HG_HEADS), heads(log_f, HG_HEADS),
                        heads(k_c, HG_HEADS), heads(f32(hg_i), HG_HEADS))
    y_c = (rms_norm(o_c) * f32(hg_norm_w)).reshape(Bsz, L, BRANCH_W) * jax.nn.silu(f32(hg_z))

    y_s5 = jax.nn.gelu(s5_ssm(f32(s5_u), s5_A_re, s5_A_im, s5_B_re, s5_B_im,
                              s5_C_re, s5_C_im, s5_D, s5_log_dt))
    y_d = (y_s5 @ s5_glu_w1) * jax.nn.sigmoid(y_s5 @ s5_glu_w2) * jax.nn.silu(f32(s5_z))

    branches = jnp.stack([y_a, y_b, y_c, y_d], axis=2)
    branch_out = jnp.einsum('blkw,kwd->blkd', branches, w_branch)
    gate = jax.nn.sigmoid(f32(gates).reshape(Bsz, L, N_BRANCH, D_MODEL))
    mixed = jnp.sum(gate * branch_out, axis=2)
    out = mixed @ w_out
    return layer_norm(ALPHA * f32(h) + out, ln_g, ln_b).astype(h.dtype)


def _dt_bias(key, shape):
    dt = jnp.exp(jax.random.uniform(key, shape, jnp.float32, math.log(1e-3), math.log(1e-1)))
    return dt + jnp.log(-jnp.expm1(-dt))


def setup_inputs(seed: int = 0) -> dict:
    key = jax.random.key(seed)
    ks = iter(jax.random.split(key, 48))
    nrm = lambda shape, s: jax.random.normal(next(ks), shape, jnp.float32) * s
    s5_n = jnp.arange(S5_P, dtype=jnp.float32)
    return {
        'x': nrm((BATCH, SEQ, D_MODEL), 1.0),
        'meta_tokens': nrm((N_META, D_MODEL), 1.0),
        'ln_in_g': 1.0 + nrm((D_MODEL,), 0.02),
        'ln_in_b': nrm((D_MODEL,), 0.02),
        'w_in': nrm((DEPTH, D_MODEL, N_IN), D_MODEL ** -0.5),
        'gdn_conv_w': nrm((DEPTH, CONV_K, 3 * BRANCH_W), CONV_K ** -0.5),
        'gdn_A_log': jnp.log(jax.random.uniform(next(ks), (DEPTH, GDN_HEADS), jnp.float32, 1.0, 16.0)),
        'gdn_dt_bias': _dt_bias(next(ks), (DEPTH, GDN_HEADS)),
        'gdn_norm_w': 1.0 + nrm((DEPTH, GDN_DV), 0.02),
        'm2_conv_w': nrm((DEPTH, CONV_K, BRANCH_W + 2 * M2_GROUPS * M2_DSTATE), CONV_K ** -0.5),
        'm2_conv_b': nrm((DEPTH, BRANCH_W + 2 * M2_GROUPS * M2_DSTATE), 0.02),
        'm2_dt_bias': _dt_bias(next(ks), (DEPTH, M2_HEADS)),
        'm2_A_log': jnp.log(jax.random.uniform(next(ks), (DEPTH, M2_HEADS), jnp.float32, 1.0, 16.0)),
        'm2_D': 1.0 + nrm((DEPTH, M2_HEADS), 0.1),
        'm2_norm_w': 1.0 + nrm((DEPTH, BRANCH_W), 0.02),
        'hg_lb_logits': nrm((DEPTH, BRANCH_W), 0.1),
        'hg_norm_w': 1.0 + nrm((DEPTH, HG_DV), 0.02),
        's5_A_re': -0.5 + nrm((DEPTH, S5_NG, S5_P), 0.01),
        's5_A_im': math.pi * s5_n + nrm((DEPTH, S5_NG, S5_P), 0.01),
        's5_B_re': nrm((DEPTH, S5_NG, S5_P, S5_GROUP), (2 * S5_GROUP) ** -0.5),
        's5_B_im': nrm((DEPTH, S5_NG, S5_P, S5_GROUP), (2 * S5_GROUP) ** -0.5),
        's5_C_re': nrm((DEPTH, S5_NG, S5_GROUP, S5_P), S5_P ** -0.5),
        's5_C_im': nrm((DEPTH, S5_NG, S5_GROUP, S5_P), S5_P ** -0.5),
        's5_D': nrm((DEPTH, BRANCH_W), 1.0),
        's5_log_dt': jax.random.uniform(next(ks), (DEPTH, S5_NG), jnp.float32, math.log(1e-3), math.log(1e-1)),
        's5_glu_w1': nrm((DEPTH, BRANCH_W, BRANCH_W), BRANCH_W ** -0.5),
        's5_glu_w2': nrm((DEPTH, BRANCH_W, BRANCH_W), BRANCH_W ** -0.5),
        'w_branch': nrm((DEPTH, N_BRANCH, BRANCH_W, D_MODEL), BRANCH_W ** -0.5 * BETA_INIT),
        'w_out': nrm((DEPTH, D_MODEL, D_MODEL), D_MODEL ** -0.5 * BETA_INIT),
        'ln_g': 1.0 + nrm((DEPTH, D_MODEL), 0.02),
        'ln_b': nrm((DEPTH, D_MODEL), 0.02),
    }


def reference(x, meta_tokens, ln_in_g, ln_in_b, w_in, gdn_conv_w, gdn_A_log, gdn_dt_bias, gdn_norm_w,
              m2_conv_w, m2_conv_b, m2_dt_bias, m2_A_log, m2_D, m2_norm_w,
              hg_lb_logits, hg_norm_w,
              s5_A_re, s5_A_im, s5_B_re, s5_B_im, s5_C_re, s5_C_im, s5_D, s5_log_dt,
              s5_glu_w1, s5_glu_w2, w_branch, w_out, ln_g, ln_b):
    Bsz = x.shape[0]
    meta = jnp.broadcast_to(meta_tokens.astype(x.dtype)[None], (Bsz, N_META, D_MODEL))
    h = layer_norm(jnp.concatenate([meta, x], axis=1), ln_in_g, ln_in_b)
    cum = jnp.cumsum(jax.nn.softmax(hg_lb_logits.astype(jnp.float32), axis=0), axis=0)
    lower_bounds = cum - cum[0:1]
    for l in range(DEPTH):
        h = hybrid_layer(h, w_in[l], gdn_conv_w[l], gdn_A_log[l], gdn_dt_bias[l], gdn_norm_w[l],
                         m2_conv_w[l], m2_conv_b[l], m2_dt_bias[l], m2_A_log[l], m2_D[l], m2_norm_w[l],
                         lower_bounds[l], hg_norm_w[l],
                         s5_A_re[l], s5_A_im[l], s5_B_re[l], s5_B_im[l], s5_C_re[l], s5_C_im[l],
                         s5_D[l], s5_log_dt[l], s5_glu_w1[l], s5_glu_w2[l],
                         w_branch[l], w_out[l], ln_g[l], ln_b[l])
    return h[:, N_META:]
```

```cpp
#include <hip/hip_runtime.h>
#include <hip/hip_cooperative_groups.h>
#include <cstdio>
namespace cg = cooperative_groups;

typedef unsigned short bfu;
using bf16x8 = __attribute__((ext_vector_type(8))) short;
using f32x4 = __attribute__((ext_vector_type(4))) float;
using u16x4 = __attribute__((ext_vector_type(4))) unsigned short;
using u16x8 = __attribute__((ext_vector_type(8))) unsigned short;
#define DI __device__ __forceinline__
#define MFMA16(a, b, c) __builtin_amdgcn_mfma_f32_16x16x32_bf16((a), (b), (c), 0, 0, 0)

#ifndef PH_MASK
#define PH_MASK 0xFFFFFF
#endif
#ifndef MULTI_LAUNCH
#define MULTI_LAUNCH 0
#endif

constexpr int TR = 32896;
constexpr int NCHK = 257;
constexpr int LBATCH = 16448;
constexpr int LDS_BYTES = 73728;
constexpr int NPL = 20;
constexpr int NPHASE = 1 + 4 * NPL + 1;

constexpr size_t OFF_H32 = 0;
constexpr size_t OFF_H16 = 134742016;
constexpr size_t OFF_Y = 202113024;
constexpr size_t OFF_P = 336855040;
constexpr size_t OFF_X = 471597056;
constexpr size_t OFF_SC = 623181824;
constexpr size_t OFF_PS = 627392512;
constexpr size_t OFF_W = 629497856;
constexpr size_t OFF_WIN = OFF_W;
constexpr size_t OFF_WS = OFF_WIN + 22020096;
constexpr size_t OFF_WGLU = OFF_WS + 32768;
constexpr size_t OFF_WB = OFF_WGLU + 1048576;
constexpr size_t OFF_WO = OFF_WB + 4194304;
constexpr size_t OFF_MS = OFF_WO + 2097152;
constexpr size_t OFF_MC = OFF_MS + 2097152;
constexpr size_t OFF_LB = OFF_MC + 6291456;
constexpr size_t OFF_LP = OFF_LB + 2048;
constexpr size_t OFF_BB = OFF_LP + 1114112;
constexpr size_t WS_NEEDED = OFF_BB + 1048576;
constexpr size_t OFF_PZ = OFF_P;
constexpr size_t OFF_U2 = OFF_P + 33685504;
constexpr size_t OFF_YS5 = OFF_U2 + 35651584;
constexpr size_t OFF_XLOC = OFF_X;
constexpr size_t OFF_XST = OFF_X + 35651584;

struct Params {
  const float* in[31];
  float* out;
  char* ws;
};

extern __shared__ __attribute__((aligned(16))) char g_smem[];
DI int tid_laundered() { int t = threadIdx.x; asm volatile("" : "+v"(t)); return t; }
DI int bid_laundered() { int b = blockIdx.x; asm volatile("" : "+s"(b)); return b; }
#define TIDX tid_laundered()
#define BIDX bid_laundered()


DI bfu f2bf(float x) { unsigned u = __float_as_uint(x); u += 0x7fffu + ((u >> 16) & 1u); return (bfu)(u >> 16); }
DI float bf2f(bfu b) { return __uint_as_float(((unsigned)b) << 16); }
DI float sigm(float x) { return 1.f / (1.f + __expf(-x)); }
DI float siluf(float x) { return x / (1.f + __expf(-x)); }
DI float softplusf(float x) { return x > 20.f ? x : log1pf(expf(x)); }
DI float wave_sum(float v) {
#pragma unroll
  for (int m = 32; m >= 1; m >>= 1) v += __shfl_xor(v, m);
  return v;
}
DI float wave_scan_incl(float s, int lane) {
#pragma unroll
  for (int d = 1; d < 64; d <<= 1) { float o = __shfl_up(s, d); if (lane >= d) s += o; }
  return s;
}

template <int NREP>
DI void gemm_tile(f32x4 (&acc)[4][NREP], const bfu* __restrict__ A, int lda, const bfu* __restrict__ Bt, int ldb, int K) {
  const int tid = TIDX, lane = tid & 63, wid = tid >> 6, wr = wid >> 1, wc = wid & 1, fr = lane & 15, fq = lane >> 4;
  char* SA = g_smem;
  char* SB = g_smem + 8192;
  for (int kt = 0; kt < K; kt += 32) {
#pragma unroll
    for (int i = 0; i < 2; ++i) {
      int b = tid * 16 + i * 4096; int r = b >> 6, c = (b & 63) >> 1;
      __builtin_amdgcn_global_load_lds((const unsigned*)(A + (long)r * lda + kt + c), (unsigned*)(SA + b), 16, 0, 0);
    }
#pragma unroll
    for (int i = 0; i < NREP / 2; ++i) {
      int b = tid * 16 + i * 4096; int r = b >> 6, c = (b & 63) >> 1;
      __builtin_amdgcn_global_load_lds((const unsigned*)(Bt + (long)r * ldb + kt + c), (unsigned*)(SB + b), 16, 0, 0);
    }
    asm volatile("s_waitcnt vmcnt(0)" ::: "memory");
    __syncthreads();
    bf16x8 af[4], bfr[NREP];
#pragma unroll
    for (int m = 0; m < 4; ++m) af[m] = *(const bf16x8*)(SA + (wr * 64 + m * 16 + fr) * 64 + fq * 16);
#pragma unroll
    for (int n = 0; n < NREP; ++n) bfr[n] = *(const bf16x8*)(SB + (wc * (NREP * 16) + n * 16 + fr) * 64 + fq * 16);
#pragma unroll
    for (int m = 0; m < 4; ++m)
#pragma unroll
      for (int n = 0; n < NREP; ++n) acc[m][n] = MFMA16(af[m], bfr[n], acc[m][n]);
    __syncthreads();
  }
}
template <int NREP>
DI void zero_acc(f32x4 (&acc)[4][NREP]) {
#pragma unroll
  for (int m = 0; m < 4; ++m)
#pragma unroll
    for (int n = 0; n < NREP; ++n) acc[m][n] = f32x4{0.f, 0.f, 0.f, 0.f};
}
#define ACC_FOREACH(NREP_, ...)                                                                \
  {                                                                                              \
    const int lane_ = TIDX & 63, wid_ = TIDX >> 6, wr_ = wid_ >> 1, wc_ = wid_ & 1; \
    const int fr_ = lane_ & 15, fq_ = lane_ >> 4;                                                \
    _Pragma("unroll") for (int m = 0; m < 4; ++m) _Pragma("unroll") for (int n = 0; n < NREP_; ++n) \
        _Pragma("unroll") for (int j = 0; j < 4; ++j) {                                          \
      const int trow = wr_ * 64 + m * 16 + fq_ * 4 + j;                                          \
      const int tcol = wc_ * (NREP_ * 16) + n * 16 + fr_;                                        \
      __VA_ARGS__                                                                                \
    }                                                                                            \
  }

DI void phase_tables(const Params& p) {
  const int gtid = BIDX * 256 + TIDX, gth = gridDim.x * 256;
  float2* LP = (float2*)(p.ws + OFF_LP);
  float2* BB = (float2*)(p.ws + OFF_BB);
  for (int idx = gtid; idx < 4 * 32 * 64; idx += gth) {
    int l = idx >> 11, g = (idx >> 6) & 31;
    float dt = expf(p.in[24][l * 32 + g]);
    float are = p.in[17][idx], aim = p.in[18][idx];
    float e1 = are * dt, a1 = aim * dt;
    for (int d = 0; d <= 16; ++d) {
      float mag = expf((float)d * e1), ang = (float)d * a1;
      LP[(long)idx * 17 + d] = make_float2(mag * cosf(ang), mag * sinf(ang));
    }
    float mag = expf(e1);
    float lre = mag * cosf(a1), lim = mag * sinf(a1);
    float den = are * are + aim * aim;
    float nr = lre - 1.f, ni = lim;
    float zre = (nr * are + ni * aim) / den, zim = (ni * are - nr * aim) / den;
    for (int c = 0; c < 16; ++c) {
      float bre = p.in[19][(long)idx * 16 + c], bim = p.in[20][(long)idx * 16 + c];
      BB[(long)idx * 16 + c] = make_float2(zre * bre - zim * bim, zre * bim + zim * bre);
    }
  }
}

DI void ln_rows(const Params& p, int layer, bool final_) {
  float* h32 = (float*)(p.ws + OFF_H32);
  bfu* h16 = (bfu*)(p.ws + OFF_H16);
  const int lane = TIDX & 63;
  const int gw = BIDX * 4 + (TIDX >> 6), nw = gridDim.x * 4;
  const float* gam = layer < 0 ? p.in[2] : p.in[29] + layer * 1024;
  const float* bet = layer < 0 ? p.in[3] : p.in[30] + layer * 1024;
  for (int r = gw; r < TR; r += nw) {
    int b = r / LBATCH, pos = r - b * LBATCH;
    float* d32 = h32 + (long)r * 1024;
    bfu* d16 = h16 + (long)r * 1024;
    if (pos < 48) {
      if (!final_) {
#pragma unroll
        for (int i = 0; i < 4; ++i) {
          *(float4*)(d32 + i * 256 + lane * 4) = make_float4(0.f, 0.f, 0.f, 0.f);
          *(u16x4*)(d16 + i * 256 + lane * 4) = u16x4{0, 0, 0, 0};
        }
      }
      continue;
    }
    const float* src;
    if (layer < 0) src = pos < 64 ? p.in[1] + (pos - 48) * 1024 : p.in[0] + ((long)b * 16384 + (pos - 64)) * 1024;
    else src = d32;
    float4 v[4];
    float s = 0.f;
#pragma unroll
    for (int i = 0; i < 4; ++i) { v[i] = *(const float4*)(src + i * 256 + lane * 4); s += v[i].x + v[i].y + v[i].z + v[i].w; }
    float mu = wave_sum(s) * (1.f / 1024.f);
    float q = 0.f;
#pragma unroll
    for (int i = 0; i < 4; ++i) {
      v[i].x -= mu; v[i].y -= mu; v[i].z -= mu; v[i].w -= mu;
      q += v[i].x * v[i].x + v[i].y * v[i].y + v[i].z * v[i].z + v[i].w * v[i].w;
    }
    float rs = rsqrtf(wave_sum(q) * (1.f / 1024.f) + 1e-5f);
#pragma unroll
    for (int i = 0; i < 4; ++i) {
      float4 g4 = *(const float4*)(gam + i * 256 + lane * 4), b4 = *(const float4*)(bet + i * 256 + lane * 4);
      float4 o = make_float4(v[i].x * rs * g4.x + b4.x, v[i].y * rs * g4.y + b4.y, v[i].z * rs * g4.z + b4.z, v[i].w * rs * g4.w + b4.w);
      if (final_) {
        if (pos >= 64) *(float4*)(p.out + ((long)b * 16384 + (pos - 64)) * 1024 + i * 256 + lane * 4) = o;
      } else {
        *(float4*)(d32 + i * 256 + lane * 4) = o;
        *(u16x4*)(d16 + i * 256 + lane * 4) = u16x4{f2bf(o.x), f2bf(o.y), f2bf(o.z), f2bf(o.w)};
      }
    }
  }
}

template <class F>
DI void conv_T(bfu* dst, int N, int K, F src) {
  const long gtid = BIDX * 256 + TIDX, gth = (long)gridDim.x * 256;
  const long total = (long)N * (K / 8);
  for (long idx = gtid; idx < total; idx += gth) {
    int n = (int)(idx % N); int kg = (int)(idx / N);
    u16x8 o;
#pragma unroll
    for (int j = 0; j < 8; ++j) o[j] = f2bf(src(kg * 8 + j, n));
    *(u16x8*)(dst + (long)n * K + kg * 8) = o;
  }
}

DI void phase_convert(const Params& p, int l) {
  const float* win = p.in[4] + (long)l * 1024 * 10768;
  conv_T((bfu*)(p.ws + OFF_WIN), 10752, 1024, [&](int k, int n) {
    int sc = n < 2048 ? n : n < 3584 ? n + 8 : n < 5632 ? n + 16 : n < 6656 ? n + 16 : n + 16;
    return win[(long)k * 10768 + sc];
  });
  conv_T((bfu*)(p.ws + OFF_WS), 16, 1024, [&](int k, int n) { int sc = n < 8 ? 2048 + n : 3592 + (n - 8); return win[(long)k * 10768 + sc]; });
  const float* w1 = p.in[25] + (long)l * 512 * 512;
  const float* w2 = p.in[26] + (long)l * 512 * 512;
  conv_T((bfu*)(p.ws + OFF_WGLU), 1024, 512, [&](int k, int r) {
    int j = r >> 7, wc = (r >> 6) & 1, n = (r >> 4) & 3, fr = r & 15;
    int oc = j * 64 + wc * 32 + (n & 1) * 16 + fr;
    return (n >> 1) ? w2[k * 512 + oc] : w1[k * 512 + oc];
  });
  const float* wb = p.in[27] + (long)l * 4 * 512 * 1024;
  conv_T((bfu*)(p.ws + OFF_WB), 4096, 512, [&](int k, int r) { int b = r >> 10, n = r & 1023; return wb[((long)b * 512 + k) * 1024 + n]; });
  const float* wo = p.in[28] + (long)l * 1024 * 1024;
  conv_T((bfu*)(p.ws + OFF_WO), 1024, 1024, [&](int k, int n) { return wo[(long)k * 1024 + n]; });
  const int gtid = BIDX * 256 + TIDX, gth = gridDim.x * 256;
  float* lbv = (float*)(p.ws + OFF_LB);
  for (int c = gtid; c < 512; c += gth) {
    float v0 = p.in[15][c], v1 = p.in[15][512 + c], v2 = p.in[15][1024 + c], v3 = p.in[15][1536 + c];
    float mx = fmaxf(fmaxf(v0, v1), fmaxf(v2, v3));
    float e0 = expf(v0 - mx), e1 = expf(v1 - mx), e2 = expf(v2 - mx), e3 = expf(v3 - mx);
    float inv = 1.f / (e0 + e1 + e2 + e3);
    float acc = 0.f;
    if (l >= 1) acc += e1 * inv;
    if (l >= 2) acc += e2 * inv;
    if (l >= 3) acc += e3 * inv;
    lbv[c] = acc;
  }
  const float2* LP = (const float2*)(p.ws + OFF_LP) + (long)l * 32 * 64 * 17;
  const float2* BB = (const float2*)(p.ws + OFF_BB) + (long)l * 32 * 64 * 16;
  const float* cre = p.in[21] + (long)l * 32 * 16 * 64;
  const float* cim = p.in[22] + (long)l * 32 * 16 * 64;
  const float* dd = p.in[23] + l * 512;
  bfu* Ms = (bfu*)(p.ws + OFF_MS);
  bfu* Mc = (bfu*)(p.ws + OFF_MC);
  for (int idx = gtid; idx < 32 * 128 * 256; idx += gth) {
    int g = idx >> 15, pp = (idx >> 8) & 127, kk = idx & 255;
    int s = kk >> 4, c2 = kk & 15, pr = pp & 63;
    float2 lp = LP[((long)g * 64 + pr) * 17 + (15 - s)];
    float2 bb = BB[((long)g * 64 + pr) * 16 + c2];
    float v = pp < 64 ? lp.x * bb.x - lp.y * bb.y : lp.x * bb.y + lp.y * bb.x;
    Ms[idx] = f2bf(v);
  }
  for (int idx = gtid; idx < 32 * 256 * 384; idx += gth) {
    int g = idx / (256 * 384); int rem = idx - g * (256 * 384);
    int o = rem / 384, kk = rem - o * 384;
    int t = o >> 4, c = o & 15;
    float v = 0.f;
    const float* cr = cre + ((long)g * 16 + c) * 64;
    const float* ci = cim + ((long)g * 16 + c) * 64;
    if (kk < 256) {
      int s = kk >> 4, c2 = kk & 15;
      if (t >= s) {
        int d = t - s;
        for (int pr = 0; pr < 64; ++pr) {
          float2 lp = LP[((long)g * 64 + pr) * 17 + d];
          float2 bb = BB[((long)g * 64 + pr) * 16 + c2];
          float ere = lp.x * bb.x - lp.y * bb.y, eim = lp.x * bb.y + lp.y * bb.x;
          v += cr[pr] * ere - ci[pr] * eim;
        }
        if (kk == o) v += dd[g * 16 + c];
      }
    } else {
      int pp = kk - 256, pr = pp & 63;
      float2 lp = LP[((long)g * 64 + pr) * 17 + (t + 1)];
      v = pp < 64 ? cr[pr] * lp.x - ci[pr] * lp.y : -(cr[pr] * lp.y + ci[pr] * lp.x);
    }
    Mc[idx] = f2bf(v);
  }
}

DI void phase_proj(const Params& p, int wrow0, int ncols, int mode, bool with_small) {
  const bfu* h16 = (const bfu*)(p.ws + OFF_H16);
  const bfu* WT = (const bfu*)(p.ws + OFF_WIN);
  bfu* P = (bfu*)(p.ws + OFF_P);
  bfu* U2 = (bfu*)(p.ws + OFF_U2);
  const int ntn = ncols >> 7;
  const int ntiles = 257 * ntn;
  const int total = ntiles + (with_small ? 257 : 0);
  for (int t = BIDX; t < total; t += gridDim.x) {
    if (t < ntiles) {
      int tm = t / ntn, tn = t - tm * ntn;
      f32x4 acc[4][4];
      zero_acc<4>(acc);
      gemm_tile<4>(acc, h16 + (long)tm * 128 * 1024, 1024, WT + (long)(wrow0 + tn * 128) * 1024, 1024, 1024);
      if (mode == 0) {
        ACC_FOREACH(4, { P[(long)(tm * 128 + trow) * ncols + tn * 128 + tcol] = f2bf(acc[m][n][j]); })
      } else {
        ACC_FOREACH(4, {
          int row = tm * 128 + trow, col = tn * 128 + tcol;
          if (col < 512) { int g = col >> 4, c2 = col & 15; U2[((long)g * 2176 + (row >> 4)) * 256 + (row & 15) * 16 + c2] = f2bf(acc[m][n][j]); }
          else P[(long)row * 512 + (col - 512)] = f2bf(acc[m][n][j]);
        })
      }
    } else {
      int tm = t - ntiles;
      const int lane = TIDX & 63, w = TIDX >> 6, fr = lane & 15, fq = lane >> 4;
      const bfu* WsT = (const bfu*)(p.ws + OFF_WS);
      float* Ps = (float*)(p.ws + OFF_PS);
      f32x4 a0 = {0.f, 0.f, 0.f, 0.f}, a1 = {0.f, 0.f, 0.f, 0.f};
      const bfu* pa0 = h16 + (long)(tm * 128 + w * 32 + fr) * 1024 + fq * 8;
      const bfu* pa1 = pa0 + 16 * 1024;
      const bfu* pb = WsT + fr * 1024 + fq * 8;
      for (int k = 0; k < 1024; k += 32) {
        bf16x8 x0 = *(const bf16x8*)(pa0 + k), x1 = *(const bf16x8*)(pa1 + k), y = *(const bf16x8*)(pb + k);
        a0 = MFMA16(x0, y, a0);
        a1 = MFMA16(x1, y, a1);
      }
#pragma unroll
      for (int j = 0; j < 4; ++j) {
        Ps[(long)(tm * 128 + w * 32 + fq * 4 + j) * 16 + fr] = a0[j];
        Ps[(long)(tm * 128 + w * 32 + 16 + fq * 4 + j) * 16 + fr] = a1[j];
      }
    }
  }
}

DI void gdn_prep_item(const Params& p, int layer, int item) {
  const int tid = TIDX, lane = tid & 63, w = tid >> 6, fr = lane & 15, fq = lane >> 4;
  const int h = item & 3, cn = item >> 2, n = cn % NCHK;
  const long r0 = (long)cn * 64;
  const bfu* P = (const bfu*)(p.ws + OFF_P);
  const float* Ps = (const float*)(p.ws + OFF_PS);
  bfu* Xb = (bfu*)(p.ws + OFF_X) + (long)item * 36864;
  float* SC = (float*)(p.ws + OFF_SC) + (long)item * 256;
  bfu* rawQ = (bfu*)g_smem;
  bfu* rawK = rawQ + 64 * 136;
  bfu* rawV = rawK + 64 * 136;
  float* aL = (float*)(g_smem + 52224);
  float* sm = (float*)(g_smem + 69632);
  const float* cw = p.in[5] + layer * 4 * 1536;
  for (int cc = tid; cc < 384; cc += 256) {
    int which = cc >> 7, c = cc & 127, col = which * 512 + h * 128 + c;
    float w0 = cw[col], w1 = cw[1536 + col], w2 = cw[2 * 1536 + col], w3 = cw[3 * 1536 + col];
    const bfu* src = P + r0 * 2048 + col;
    float xm3 = 0.f, xm2 = 0.f, xm1 = 0.f;
    if (n > 0) { xm3 = bf2f(*(src - 3 * 2048)); xm2 = bf2f(*(src - 2 * 2048)); xm1 = bf2f(*(src - 2048)); }
    bfu* dst = rawQ + which * (64 * 136) + c;
    for (int t = 0; t < 64; ++t) {
      float x = bf2f(src[(long)t * 2048]);
      float v = w0 * xm3 + w1 * xm2 + w2 * xm1 + w3 * x;
      dst[t * 136] = f2bf(siluf(v));
      xm3 = xm2; xm2 = xm1; xm1 = x;
    }
  }
  if (w == 2) {
    const float* ps = Ps + (r0 + lane) * 16;
    float be = sigm(ps[h]);
    float gl = -expf(p.in[6][layer * 4 + h]) * softplusf(ps[4 + h] + p.in[7][layer * 4 + h]);
    float s = wave_scan_incl(gl, lane);
    sm[128 + lane] = be;
    sm[192 + lane] = s;
  }
  __syncthreads();
  if (tid < 128) {
    int row = tid & 63, mat = tid >> 6;
    const bfu* rp = rawQ + mat * (64 * 136) + row * 136;
    float ss = 0.f;
    for (int c = 0; c < 128; ++c) { float v = bf2f(rp[c]); ss += v * v; }
    float sc = rsqrtf(ss + 1e-6f);
    if (mat == 0) sc *= 0.08838834764831845f;
    sm[mat * 64 + row] = sc;
  }
  __syncthreads();
  if (tid < 64) { float be = sm[128 + tid]; sm[256 + tid] = be; sm[320 + tid] = be * sm[64 + tid] * expf(sm[192 + tid]); }
  {
    bf16x8 kf[4], qf[4];
#pragma unroll
    for (int ks = 0; ks < 4; ++ks) {
      kf[ks] = *(const bf16x8*)(rawK + (16 * w + fr) * 136 + ks * 32 + fq * 8);
      qf[ks] = *(const bf16x8*)(rawQ + (16 * w + fr) * 136 + ks * 32 + fq * 8);
    }
    bfu* AMg = Xb + 32768;
    for (int tj = 0; tj < 4; ++tj) {
      if (tj <= w) {
        f32x4 akk = {0.f, 0.f, 0.f, 0.f}, aqk = {0.f, 0.f, 0.f, 0.f};
#pragma unroll
        for (int ks = 0; ks < 4; ++ks) {
          bf16x8 bk = *(const bf16x8*)(rawK + (16 * tj + fr) * 136 + ks * 32 + fq * 8);
          akk = MFMA16(kf[ks], bk, akk);
          aqk = MFMA16(qf[ks], bk, aqk);
        }
        int j = 16 * tj + fr;
        float rkj = sm[64 + j], gcj = sm[192 + j];
#pragma unroll
        for (int r = 0; r < 4; ++r) {
          int i = 16 * w + fq * 4 + r;
          float dec = (i >= j) ? expf(sm[192 + i] - gcj) : 0.f;
          aL[i * 68 + j] = (i > j) ? sm[128 + i] * sm[64 + i] * rkj * akk[r] * dec : 0.f;
          AMg[i * 64 + j] = f2bf((i >= j) ? sm[i] * rkj * aqk[r] * dec : 0.f);
        }
      } else {
#pragma unroll
        for (int r = 0; r < 4; ++r) AMg[(16 * w + fq * 4 + r) * 64 + 16 * tj + fr] = 0;
      }
    }
  }
  __syncthreads();
  {
    const bfu* src = (tid < 128) ? (rawV + tid) : (rawK + (tid - 128));
    const float* rs = sm + ((tid < 128) ? 256 : 320);
    float x[64];
#pragma unroll
    for (int i = 0; i < 64; ++i) {
      float a = bf2f(src[i * 136]) * rs[i];
#pragma unroll
      for (int j = 0; j < i; ++j) a -= aL[i * 68 + j] * x[j];
      x[i] = a;
    }
    if (tid < 128) {
      bfu* UT = Xb + 24576 + tid * 64;
#pragma unroll
      for (int i = 0; i < 64; i += 8) {
        u16x8 o;
#pragma unroll
        for (int j = 0; j < 8; ++j) o[j] = f2bf(x[i + j]);
        *(u16x8*)(UT + i) = o;
      }
    } else {
      bfu* Wg = Xb + 8192 + (tid - 128);
#pragma unroll
      for (int i = 0; i < 64; ++i) Wg[i * 128] = f2bf(x[i]);
    }
  }
  {
    bfu* QDg = Xb;
    bfu* KDTg = Xb + 16384;
    float gl_last = sm[192 + 63];
    for (int idx = tid; idx < 8192; idx += 256) { int i = idx >> 7, c = idx & 127; QDg[idx] = f2bf(bf2f(rawQ[i * 136 + c]) * sm[i] * expf(sm[192 + i])); }
    for (int idx = tid; idx < 8192; idx += 256) { int c = idx >> 6, i = idx & 63; KDTg[idx] = f2bf(bf2f(rawK[i * 136 + c]) * sm[64 + i] * expf(gl_last - sm[192 + i])); }
    if (tid < 128) SC[128 + tid] = expf(gl_last);
  }
  __syncthreads();
}

DI void ssd_prep_item(const Params& p, int layer, int item) {
  const int tid = TIDX, lane = tid & 63, w = tid >> 6, fr = lane & 15, fq = lane >> 4;
  const int g = item & 1, cn = item >> 1, n = cn % NCHK;
  const long r0 = (long)cn * 64;
  const bfu* P = (const bfu*)(p.ws + OFF_P);
  const float* Ps = (const float*)(p.ws + OFF_PS);
  bfu* Xb = (bfu*)(p.ws + OFF_X) + (long)cn * 131072;
  float* SCb = (float*)(p.ws + OFF_SC) + (long)cn * 8 * 256;
  bfu* Bm = (bfu*)g_smem;
  bfu* Cm = Bm + 64 * 136;
  float* cb = (float*)(g_smem + 34816);
  float* sm = (float*)(g_smem + 34816 + 17408);
  {
    int hd = g * 4 + w;
    float dtv = softplusf(Ps[(r0 + lane) * 16 + 8 + hd] + p.in[11][layer * 8 + hd]);
    float a = -dtv * expf(p.in[12][layer * 8 + hd]);
    float ac = wave_scan_incl(a, lane);
    sm[w * 64 + lane] = dtv;
    sm[256 + w * 64 + lane] = ac;
  }
  __syncthreads();
  const float* cw = p.in[9] + layer * 4 * 1024;
  const float* cbias = p.in[10] + layer * 1024;
  for (int cc = tid; cc < 512; cc += 256) {
    int col = (cc < 128) ? 512 + g * 128 + cc : (cc < 256) ? 768 + g * 128 + (cc - 128) : g * 256 + (cc - 256);
    float w0 = cw[col], w1 = cw[1024 + col], w2 = cw[2048 + col], w3 = cw[3072 + col], bb = cbias[col];
    const bfu* src = P + r0 * 1536 + col;
    float xm3 = 0.f, xm2 = 0.f, xm1 = 0.f;
    if (n > 0) { xm3 = bf2f(*(src - 3 * 1536)); xm2 = bf2f(*(src - 2 * 1536)); xm1 = bf2f(*(src - 1536)); }
    int hh = (cc - 256) >> 6, pp = (cc - 256) & 63;
    bfu* vt = Xb + 32768 + (g * 4 + (hh & 3)) * 12288 + 4096 + pp * 64;
    for (int t = 0; t < 64; ++t) {
      float x = bf2f(src[(long)t * 1536]);
      float v = siluf(w0 * xm3 + w1 * xm2 + w2 * xm1 + w3 * x + bb);
      if (n == 0 && t < 48) v = 0.f;
      if (cc < 128) Bm[t * 136 + cc] = f2bf(v);
      else if (cc < 256) Cm[t * 136 + (cc - 128)] = f2bf(v);
      else vt[t] = f2bf(v * sm[hh * 64 + t]);
      xm3 = xm2; xm2 = xm1; xm1 = x;
    }
  }
  __syncthreads();
  {
    bf16x8 cf[4];
#pragma unroll
    for (int ks = 0; ks < 4; ++ks) cf[ks] = *(const bf16x8*)(Cm + (16 * w + fr) * 136 + ks * 32 + fq * 8);
    for (int tj = 0; tj < 4; ++tj) {
      if (tj <= w) {
        f32x4 a = {0.f, 0.f, 0.f, 0.f};
#pragma unroll
        for (int ks = 0; ks < 4; ++ks) {
          bf16x8 bk = *(const bf16x8*)(Bm + (16 * tj + fr) * 136 + ks * 32 + fq * 8);
          a = MFMA16(cf[ks], bk, a);
        }
#pragma unroll
        for (int r = 0; r < 4; ++r) cb[(16 * w + fq * 4 + r) * 68 + 16 * tj + fr] = a[r];
      }
    }
    bfu* Cg = Xb + g * 16384;
    bfu* BTg = Cg + 8192;
    for (int idx = tid; idx < 8192; idx += 256) Cg[idx] = Cm[(idx >> 7) * 136 + (idx & 127)];
    for (int idx = tid; idx < 8192; idx += 256) BTg[idx] = Bm[(idx & 63) * 136 + (idx >> 6)];
  }
  __syncthreads();
  for (int hh = 0; hh < 4; ++hh) {
    int hd = g * 4 + hh;
    bfu* AMg = Xb + 32768 + hd * 12288;
    float Dh = p.in[13][layer * 8 + hd];
    const float* dtp = sm + hh * 64;
    const float* acp = sm + 256 + hh * 64;
    for (int idx = tid; idx < 4096; idx += 256) {
      int l = idx >> 6, m = idx & 63;
      float v = (m <= l) ? cb[l * 68 + m] * expf(acp[l] - acp[m]) : 0.f;
      if (m == l) v += Dh / dtp[l];
      AMg[idx] = f2bf(v);
    }
    float* sc = SCb + hd * 256;
    float alast = acp[63];
    if (tid < 64) { sc[tid] = expf(acp[tid]); sc[64 + tid] = expf(alast - acp[tid]); }
    else if (tid < 192) sc[128 + (tid - 64)] = expf(alast);
  }
  __syncthreads();
}

DI void hg_prep_item(const Params& p, int layer, int item) {
  const int tid = TIDX, lane = tid & 63, w = tid >> 6, fr = lane & 15, fq = lane >> 4;
  const int h = item & 3, cn = item >> 2;
  const long r0 = (long)cn * 64;
  const bfu* P = (const bfu*)(p.ws + OFF_P);
  const float* lbv = (const float*)(p.ws + OFF_LB);
  bfu* Xb = (bfu*)(p.ws + OFF_X) + (long)item * 28672;
  float* SC = (float*)(p.ws + OFF_SC) + (long)item * 256;
  bfu* Qall = (bfu*)g_smem;
  bfu* Ks = Qall + 160 * 136;
  bfu* QDg = Xb;
  bfu* KDTg = Xb + 8192;
  bfu* AMg = Xb + 16384;
  bfu* VTg = Xb + 20480;
  if (tid < 128) {
    const int k = tid;
    const float lb = lbv[h * 128 + k];
    const bfu* fp = P + r0 * 2048 + 512 + h * 128 + k;
    const bfu* qp = P + r0 * 2048 + h * 128 + k;
    float lf[64];
    float G = 0.f, G1 = 0.f, G2 = 0.f, G3 = 0.f;
#pragma unroll
    for (int t = 0; t < 64; ++t) {
      float zf = bf2f(fp[(long)t * 2048]);
      float f = lb + (1.f - lb) * (1.f / (1.f + expf(-zf)));
      lf[t] = logf(f);
      G += lf[t];
      if (t == 15) G1 = G;
      if (t == 31) G2 = G;
      if (t == 47) G3 = G;
    }
    const float Glast = G;
    G = 0.f;
#pragma unroll
    for (int t = 0; t < 64; ++t) {
      G += lf[t];
      float zf = bf2f(fp[(long)t * 2048]);
      float kk = (1.f - lb) * (1.f / (1.f + expf(zf)));
      float q = siluf(bf2f(qp[(long)t * 2048]));
      bfu qd = f2bf(q * expf(G));
      QDg[t * 128 + k] = qd;
      Qall[t * 136 + k] = qd;
      if (t >= 16) Qall[(64 + t - 16) * 136 + k] = f2bf(q * expf(G - G1));
      if (t >= 32) Qall[(112 + t - 32) * 136 + k] = f2bf(q * expf(G - G2));
      if (t >= 48) Qall[(144 + t - 48) * 136 + k] = f2bf(q * expf(G - G3));
      float GJ = (t < 16) ? 0.f : (t < 32) ? G1 : (t < 48) ? G2 : G3;
      Ks[t * 136 + k] = f2bf(kk * expf(fminf(GJ - G, 80.f)));
      KDTg[k * 64 + t] = f2bf(kk * expf(Glast - G));
    }
    SC[128 + k] = expf(Glast);
  } else {
    const int v = tid - 128;
    const bfu* ip = P + r0 * 2048 + 1024 + h * 128 + v;
    for (int t = 0; t < 64; ++t) VTg[v * 64 + t] = ip[(long)t * 2048];
  }
  __syncthreads();
  for (int J = 0; J < 4; ++J) {
    if (J <= w) {
      int rowbase = (J == 0 ? 0 : J == 1 ? 64 : J == 2 ? 112 : 144) + 16 * (w - J);
      f32x4 a = {0.f, 0.f, 0.f, 0.f};
#pragma unroll
      for (int ks = 0; ks < 4; ++ks) {
        bf16x8 af = *(const bf16x8*)(Qall + (rowbase + fr) * 136 + ks * 32 + fq * 8);
        bf16x8 bk = *(const bf16x8*)(Ks + (16 * J + fr) * 136 + ks * 32 + fq * 8);
        a = MFMA16(af, bk, a);
      }
#pragma unroll
      for (int r = 0; r < 4; ++r) {
        int t = 16 * w + fq * 4 + r, s = 16 * J + fr;
        AMg[t * 64 + s] = f2bf((s <= t) ? a[r] : 0.f);
      }
    } else {
#pragma unroll
      for (int r = 0; r < 4; ++r) AMg[(16 * w + fq * 4 + r) * 64 + 16 * J + fr] = 0;
    }
  }
  __syncthreads();
}

struct EngArgs {
  const bfu* qd; long qd_cs;
  const bfu* w; long w_cs;
  const bfu* kdt; long kdt_cs;
  const bfu* am; long am_cs;
  const bfu* vt; long vt_cs;
  const float* sc; long sc_cs;
  bfu* o;
};
template <bool HAS_W, bool USE_RS, bool USE_KS>
struct EngFrags {
  bf16x8 wf[4], qf[4], amf[2], kf[2][2];
  u16x4 v[2];
  f32x4 rs, ks, dv[2];
};
template <bool HAS_W, bool USE_RS, bool USE_KS>
DI void eng_load(EngFrags<HAS_W, USE_RS, USE_KS>& f, const EngArgs& e, int n, int w, int fr, int fq) {
#pragma unroll
  for (int ks = 0; ks < 4; ++ks) {
    if (HAS_W) f.wf[ks] = *(const bf16x8*)(e.w + n * e.w_cs + (16 * w + fr) * 128 + ks * 32 + fq * 8);
    f.qf[ks] = *(const bf16x8*)(e.qd + n * e.qd_cs + (16 * w + fr) * 128 + ks * 32 + fq * 8);
  }
#pragma unroll
  for (int ks = 0; ks < 2; ++ks) {
    f.amf[ks] = *(const bf16x8*)(e.am + n * e.am_cs + (16 * w + fr) * 64 + ks * 32 + fq * 8);
#pragma unroll
    for (int a = 0; a < 2; ++a) f.kf[a][ks] = *(const bf16x8*)(e.kdt + n * e.kdt_cs + ((2 * w + a) * 16 + fr) * 64 + ks * 32 + fq * 8);
  }
#pragma unroll
  for (int jv = 0; jv < 2; ++jv) f.v[jv] = *(const u16x4*)(e.vt + n * e.vt_cs + (jv * 16 + fr) * 64 + 16 * w + fq * 4);
  const float* sc = e.sc + n * e.sc_cs;
  if (USE_RS) f.rs = *(const f32x4*)(sc + 16 * w + fq * 4);
  if (USE_KS) f.ks = *(const f32x4*)(sc + 64 + 16 * w + fq * 4);
#pragma unroll
  for (int a = 0; a < 2; ++a) f.dv[a] = *(const f32x4*)(sc + 128 + (2 * w + a) * 16 + fq * 4);
}
template <bool HAS_W, bool USE_RS, bool USE_KS>
DI void engine_run(const EngArgs& e) {
  const int tid = TIDX, lane = tid & 63, w = tid >> 6, fr = lane & 15, fq = lane >> 4;
  char* VT = g_smem + 17408;
  char* VT2 = USE_KS ? (g_smem + 17408 + 4608) : VT;
  f32x4 S[2][2];
#pragma unroll
  for (int a = 0; a < 2; ++a)
#pragma unroll
    for (int jv = 0; jv < 2; ++jv) S[a][jv] = f32x4{0.f, 0.f, 0.f, 0.f};
  EngFrags<HAS_W, USE_RS, USE_KS> cur, nxt;
  eng_load(cur, e, 0, w, fr, fq);
  for (int n = 0; n < NCHK; ++n) {
    char* STc = g_smem + (n & 1) * 8704;
    eng_load(nxt, e, (n + 1 < NCHK) ? n + 1 : n, w, fr, fq);
#pragma unroll
    for (int a = 0; a < 2; ++a)
#pragma unroll
      for (int jv = 0; jv < 2; ++jv) {
        u16x4 pk = {f2bf(S[a][jv][0]), f2bf(S[a][jv][1]), f2bf(S[a][jv][2]), f2bf(S[a][jv][3])};
        *(u16x4*)(STc + ((jv * 16 + fr) * 136 + (2 * w + a) * 16 + fq * 4) * 2) = pk;
      }
    __syncthreads();
    f32x4 vn[2];
    if (HAS_W) {
      f32x4 av[2] = {f32x4{0.f, 0.f, 0.f, 0.f}, f32x4{0.f, 0.f, 0.f, 0.f}};
#pragma unroll
      for (int ks = 0; ks < 4; ++ks)
#pragma unroll
        for (int jv = 0; jv < 2; ++jv) {
          bf16x8 sf = *(const bf16x8*)(STc + ((jv * 16 + fr) * 136 + ks * 32 + fq * 8) * 2);
          av[jv] = MFMA16(cur.wf[ks], sf, av[jv]);
        }
#pragma unroll
      for (int jv = 0; jv < 2; ++jv)
#pragma unroll
        for (int r = 0; r < 4; ++r) vn[jv][r] = bf2f(cur.v[jv][r]) - av[jv][r];
    } else {
#pragma unroll
      for (int jv = 0; jv < 2; ++jv)
#pragma unroll
        for (int r = 0; r < 4; ++r) vn[jv][r] = bf2f(cur.v[jv][r]);
    }
#pragma unroll
    for (int jv = 0; jv < 2; ++jv) {
      u16x4 pk = {f2bf(vn[jv][0]), f2bf(vn[jv][1]), f2bf(vn[jv][2]), f2bf(vn[jv][3])};
      *(u16x4*)(VT + ((jv * 16 + fr) * 72 + 16 * w + fq * 4) * 2) = pk;
      if (USE_KS) {
        u16x4 pk2 = {f2bf(vn[jv][0] * cur.ks[0]), f2bf(vn[jv][1] * cur.ks[1]), f2bf(vn[jv][2] * cur.ks[2]), f2bf(vn[jv][3] * cur.ks[3])};
        *(u16x4*)(VT2 + ((jv * 16 + fr) * 72 + 16 * w + fq * 4) * 2) = pk2;
      }
    }
    __syncthreads();
    f32x4 ao[2] = {f32x4{0.f, 0.f, 0.f, 0.f}, f32x4{0.f, 0.f, 0.f, 0.f}};
#pragma unroll
    for (int ks = 0; ks < 4; ++ks)
#pragma unroll
      for (int jv = 0; jv < 2; ++jv) {
        bf16x8 sf = *(const bf16x8*)(STc + ((jv * 16 + fr) * 136 + ks * 32 + fq * 8) * 2);
        ao[jv] = MFMA16(cur.qf[ks], sf, ao[jv]);
      }
    if (USE_RS) {
#pragma unroll
      for (int jv = 0; jv < 2; ++jv)
#pragma unroll
        for (int r = 0; r < 4; ++r) ao[jv][r] *= cur.rs[r];
    }
#pragma unroll
    for (int ks = 0; ks < 2; ++ks)
#pragma unroll
      for (int jv = 0; jv < 2; ++jv) {
        bf16x8 vf = *(const bf16x8*)(VT + ((jv * 16 + fr) * 72 + ks * 32 + fq * 8) * 2);
        ao[jv] = MFMA16(cur.amf[ks], vf, ao[jv]);
      }
#pragma unroll
    for (int jv = 0; jv < 2; ++jv)
#pragma unroll
      for (int r = 0; r < 4; ++r) e.o[(long)(n * 64 + 16 * w + fq * 4 + r) * 512 + jv * 16 + fr] = f2bf(ao[jv][r]);
#pragma unroll
    for (int a = 0; a < 2; ++a) {
#pragma unroll
      for (int jv = 0; jv < 2; ++jv)
#pragma unroll
        for (int r = 0; r < 4; ++r) S[a][jv][r] *= cur.dv[a][r];
#pragma unroll
      for (int ks = 0; ks < 2; ++ks)
#pragma unroll
        for (int jv = 0; jv < 2; ++jv) {
          bf16x8 vf = *(const bf16x8*)(VT2 + ((jv * 16 + fr) * 72 + ks * 32 + fq * 8) * 2);
          S[a][jv] = MFMA16(cur.kf[a][ks], vf, S[a][jv]);
        }
    }
    cur = nxt;
  }
  __syncthreads();
}

DI void phase_post(const Params& p, int branch, int mode, const float* nw, int zld, int zoff) {
  bfu* Y = (bfu*)(p.ws + OFF_Y) + (long)branch * TR * 512;
  const bfu* P = (const bfu*)(p.ws + OFF_P);
  const int lane = TIDX & 63;
  const int gw = BIDX * 4 + (TIDX >> 6), nwv = gridDim.x * 4;
  for (int r = gw; r < TR; r += nwv) {
    u16x8 o = *(const u16x8*)(Y + (long)r * 512 + lane * 8);
    u16x8 z = *(const u16x8*)(P + (long)r * zld + zoff + lane * 8);
    float v[8];
    float ss = 0.f;
#pragma unroll
    for (int j = 0; j < 8; ++j) {
      v[j] = bf2f(o[j]);
      if (mode == 1) v[j] *= siluf(bf2f(z[j]));
      ss += v[j] * v[j];
    }
    ss += __shfl_xor(ss, 1); ss += __shfl_xor(ss, 2); ss += __shfl_xor(ss, 4); ss += __shfl_xor(ss, 8);
    float rs;
    if (mode == 1) { ss += __shfl_xor(ss, 16); rs = rsqrtf(ss * (1.f / 256.f) + 1e-6f); }
    else rs = rsqrtf(ss * (1.f / 128.f) + 1e-6f);
    u16x8 res;
#pragma unroll
    for (int j = 0; j < 8; ++j) {
      int c = lane * 8 + j;
      float y = v[j] * rs * (mode == 1 ? nw[c] : nw[c & 127]);
      if (mode == 0) y *= siluf(bf2f(z[j]));
      res[j] = f2bf(y);
    }
    *(u16x8*)(Y + (long)r * 512 + lane * 8) = res;
  }
}

DI float geluf(float x) { float u = 0.7978845608028654f * (x + 0.044715f * x * x * x); return 0.5f * x * (1.f + tanhf(u)); }

DI void phase_s5_gemm1(const Params& p) {
  const bfu* U2 = (const bfu*)(p.ws + OFF_U2);
  const bfu* Ms = (const bfu*)(p.ws + OFF_MS);
  float* Xloc = (float*)(p.ws + OFF_XLOC);
  for (int t = BIDX; t < 32 * 17; t += gridDim.x) {
    int g = t / 17, tm = t - g * 17;
    f32x4 acc[4][4];
    zero_acc<4>(acc);
    gemm_tile<4>(acc, U2 + ((long)g * 2176 + tm * 128) * 256, 256, Ms + (long)g * 128 * 256, 256, 256);
    ACC_FOREACH(4, { Xloc[((long)g * 2176 + tm * 128 + trow) * 128 + tcol] = acc[m][n][j]; })
  }
}
DI void phase_s5_scan(const Params& p, int layer) {
  float* Xloc = (float*)(p.ws + OFF_XLOC);
  bfu* Xst = (bfu*)(p.ws + OFF_XST);
  const float2* LP = (const float2*)(p.ws + OFF_LP) + (long)layer * 32 * 64 * 17;
  const int pr = TIDX;
  for (int it = BIDX; it < 64; it += gridDim.x) {
    if (pr < 64) {
      int g = it >> 1, b = it & 1;
      float2 l16 = LP[((long)g * 64 + pr) * 17 + 16];
      float sre = 0.f, sim = 0.f;
      const float* xl = Xloc + ((long)g * 2176 + b * 1028) * 128;
      bfu* xs = Xst + ((long)g * 2176 + b * 1028) * 128;
#pragma unroll 8
      for (int n = 0; n < 1028; ++n) {
        float lre = xl[(long)n * 128 + pr], lim = xl[(long)n * 128 + 64 + pr];
        xs[(long)n * 128 + pr] = f2bf(sre);
        xs[(long)n * 128 + 64 + pr] = f2bf(sim);
        float nre = l16.x * sre - l16.y * sim + lre;
        float nim = l16.x * sim + l16.y * sre + lim;
        sre = nre; sim = nim;
      }
    }
  }
}
DI void phase_s5_gemm2(const Params& p) {
  const bfu* U2 = (const bfu*)(p.ws + OFF_U2);
  const bfu* Xst = (const bfu*)(p.ws + OFF_XST);
  const bfu* Mc = (const bfu*)(p.ws + OFF_MC);
  bfu* Ys5 = (bfu*)(p.ws + OFF_YS5);
  for (int t = BIDX; t < 32 * 17 * 2; t += gridDim.x) {
    int g = t / 34, rem = t - g * 34, tm = rem >> 1, tn = rem & 1;
    f32x4 acc[4][4];
    zero_acc<4>(acc);
    const bfu* Bt = Mc + ((long)g * 256 + tn * 128) * 384;
    gemm_tile<4>(acc, U2 + ((long)g * 2176 + tm * 128) * 256, 256, Bt, 384, 256);
    gemm_tile<4>(acc, Xst + ((long)g * 2176 + tm * 128) * 128, 128, Bt + 256, 384, 128);
    ACC_FOREACH(4, {
      int nc = tm * 128 + trow, o = tn * 128 + tcol;
      if (nc < 2056) Ys5[((long)nc * 16 + (o >> 4)) * 512 + g * 16 + (o & 15)] = f2bf(geluf(acc[m][n][j]));
    })
  }
}
DI void phase_glu(const Params& p) {
  const bfu* Ys5 = (const bfu*)(p.ws + OFF_YS5);
  const bfu* Wg = (const bfu*)(p.ws + OFF_WGLU);
  const bfu* Pz = (const bfu*)(p.ws + OFF_PZ);
  bfu* Yd = (bfu*)(p.ws + OFF_Y) + (long)3 * TR * 512;
  for (int t = BIDX; t < 257 * 8; t += gridDim.x) {
    int tm = t >> 3, tn = t & 7;
    f32x4 acc[4][4];
    zero_acc<4>(acc);
    gemm_tile<4>(acc, Ys5 + (long)tm * 128 * 512, 512, Wg + (long)tn * 128 * 512, 512, 512);
    const int lane = TIDX & 63, wid = TIDX >> 6, wr = wid >> 1, wc = wid & 1, fr = lane & 15, fq = lane >> 4;
#pragma unroll
    for (int m = 0; m < 4; ++m)
#pragma unroll
      for (int n = 0; n < 2; ++n)
#pragma unroll
        for (int j = 0; j < 4; ++j) {
          int row = tm * 128 + wr * 64 + m * 16 + fq * 4 + j;
          int oc = tn * 64 + wc * 32 + n * 16 + fr;
          float z = bf2f(Pz[(long)row * 512 + oc]);
          Yd[(long)row * 512 + oc] = f2bf(acc[m][n][j] * sigm(acc[m][n + 2][j]) * siluf(z));
        }
  }
}
DI void phase_merge(const Params& p) {
  const bfu* h16 = (const bfu*)(p.ws + OFF_H16);
  const bfu* WT = (const bfu*)(p.ws + OFF_WIN);
  const bfu* WbT = (const bfu*)(p.ws + OFF_WB);
  const bfu* Y = (const bfu*)(p.ws + OFF_Y);
  bfu* mixed = (bfu*)(p.ws + OFF_P);
  for (int t = BIDX; t < 257 * 16; t += gridDim.x) {
    int tm = t >> 4, tn = t & 15;
    f32x4 tot[4][2];
    zero_acc<2>(tot);
    for (int b = 0; b < 4; ++b) {
      f32x4 ag[4][2];
      zero_acc<2>(ag);
      gemm_tile<2>(ag, h16 + (long)tm * 128 * 1024, 1024, WT + (long)(6656 + b * 1024 + tn * 64) * 1024, 1024, 1024);
#pragma unroll
      for (int m = 0; m < 4; ++m)
#pragma unroll
        for (int n = 0; n < 2; ++n)
#pragma unroll
          for (int j = 0; j < 4; ++j) ag[m][n][j] = sigm(ag[m][n][j]);
      f32x4 ay[4][2];
      zero_acc<2>(ay);
      gemm_tile<2>(ay, Y + ((long)b * TR + tm * 128) * 512, 512, WbT + (long)(b * 1024 + tn * 64) * 512, 512, 512);
#pragma unroll
      for (int m = 0; m < 4; ++m)
#pragma unroll
        for (int n = 0; n < 2; ++n)
#pragma unroll
          for (int j = 0; j < 4; ++j) tot[m][n][j] += ag[m][n][j] * ay[m][n][j];
    }
    ACC_FOREACH(2, { mixed[(long)(tm * 128 + trow) * 1024 + tn * 64 + tcol] = f2bf(tot[m][n][j]); })
  }
}
DI void phase_out(const Params& p) {
  const bfu* mixed = (const bfu*)(p.ws + OFF_P);
  const bfu* WoT = (const bfu*)(p.ws + OFF_WO);
  float* h32 = (float*)(p.ws + OFF_H32);
  const float ALPHA = 1.6817928305074290f;
  for (int t = BIDX; t < 257 * 8; t += gridDim.x) {
    int tm = t >> 3, tn = t & 7;
    f32x4 acc[4][4];
    zero_acc<4>(acc);
    gemm_tile<4>(acc, mixed + (long)tm * 128 * 1024, 1024, WoT + (long)tn * 128 * 1024, 1024, 1024);
    ACC_FOREACH(4, {
      long a = (long)(tm * 128 + trow) * 1024 + tn * 128 + tcol;
      h32[a] = ALPHA * h32[a] + acc[m][n][j];
    })
  }
}

DI void run_phase(const Params& p, int ph) {
  if (ph == 0) { phase_tables(p); return; }
  if (ph == NPHASE - 1) { ln_rows(p, 3, true); return; }
  const int layer = (ph - 1) / NPL, sub = (ph - 1) % NPL;
  bfu* Xb = (bfu*)(p.ws + OFF_X);
  float* SC = (float*)(p.ws + OFF_SC);
  bfu* Y = (bfu*)(p.ws + OFF_Y);
  switch (sub) {
    case 0: if (!((PH_MASK >> 0) & 1)) break; ln_rows(p, layer - 1, false); phase_convert(p, layer); break;
    case 1: if (!((PH_MASK >> 1) & 1)) break; phase_proj(p, 0, 2048, 0, true); break;
    case 2: if (!((PH_MASK >> 2) & 1)) break; for (int it = BIDX; it < 2056; it += gridDim.x) gdn_prep_item(p, layer, it); break;
    case 3: if (!((PH_MASK >> 3) & 1)) break;       if (BIDX < 32) {
        int b = BIDX >> 4, h = (BIDX >> 2) & 3, sl = BIDX & 3;
        EngArgs e;
        const bfu* base = Xb + ((long)(b * NCHK) * 4 + h) * 36864;
        e.qd = base; e.qd_cs = 4 * 36864;
        e.w = base + 8192; e.w_cs = 4 * 36864;
        e.kdt = base + 16384; e.kdt_cs = 4 * 36864;
        e.vt = base + 24576 + sl * 32 * 64; e.vt_cs = 4 * 36864;
        e.am = base + 32768; e.am_cs = 4 * 36864;
        e.sc = SC + ((long)(b * NCHK) * 4 + h) * 256; e.sc_cs = 4 * 256;
        e.o = Y + (long)(b * LBATCH) * 512 + h * 128 + sl * 32;
        engine_run<true, false, false>(e);
      }
      break;
    case 4: if (!((PH_MASK >> 4) & 1)) break; phase_post(p, 0, 0, p.in[8] + layer * 128, 2048, 1536); break;
    case 5: if (!((PH_MASK >> 5) & 1)) break; phase_proj(p, 2048, 1536, 0, false); break;
    case 6: if (!((PH_MASK >> 6) & 1)) break; for (int it = BIDX; it < 1028; it += gridDim.x) ssd_prep_item(p, layer, it); break;
    case 7: if (!((PH_MASK >> 7) & 1)) break;       if (BIDX < 32) {
        int b = BIDX >> 4, hd = (BIDX >> 1) & 7, sl = BIDX & 1, g = hd >> 2;
        EngArgs e;
        const bfu* base = Xb + (long)(b * NCHK) * 131072;
        e.qd = base + g * 16384; e.qd_cs = 131072;
        e.w = nullptr; e.w_cs = 0;
        e.kdt = base + g * 16384 + 8192; e.kdt_cs = 131072;
        e.am = base + 32768 + hd * 12288; e.am_cs = 131072;
        e.vt = base + 32768 + hd * 12288 + 4096 + sl * 32 * 64; e.vt_cs = 131072;
        e.sc = SC + ((long)(b * NCHK) * 8 + hd) * 256; e.sc_cs = 8 * 256;
        e.o = Y + (long)TR * 512 + (long)(b * LBATCH) * 512 + hd * 64 + sl * 32;
        engine_run<false, true, true>(e);
      }
      break;
    case 8: if (!((PH_MASK >> 8) & 1)) break; phase_post(p, 1, 1, p.in[14] + layer * 512, 1536, 1024); break;
    case 9: if (!((PH_MASK >> 9) & 1)) break; phase_proj(p, 3584, 2048, 0, false); break;
    case 10: if (!((PH_MASK >> 10) & 1)) break; for (int it = BIDX; it < 2056; it += gridDim.x) hg_prep_item(p, layer, it); break;
    case 11: if (!((PH_MASK >> 11) & 1)) break;       if (BIDX < 32) {
        int b = BIDX >> 4, h = (BIDX >> 2) & 3, sl = BIDX & 3;
        EngArgs e;
        const bfu* base = Xb + ((long)(b * NCHK) * 4 + h) * 28672;
        e.qd = base; e.qd_cs = 4 * 28672;
        e.w = nullptr; e.w_cs = 0;
        e.kdt = base + 8192; e.kdt_cs = 4 * 28672;
        e.am = base + 16384; e.am_cs = 4 * 28672;
        e.vt = base + 20480 + sl * 32 * 64; e.vt_cs = 4 * 28672;
        e.sc = SC + ((long)(b * NCHK) * 4 + h) * 256; e.sc_cs = 4 * 256;
        e.o = Y + (long)2 * TR * 512 + (long)(b * LBATCH) * 512 + h * 128 + sl * 32;
        engine_run<false, false, false>(e);
      }
      break;
    case 12: if (!((PH_MASK >> 12) & 1)) break; phase_post(p, 2, 0, p.in[16] + layer * 128, 2048, 1536); break;
    case 13: if (!((PH_MASK >> 13) & 1)) break; phase_proj(p, 5632, 1024, 1, false); break;
    case 14: if (!((PH_MASK >> 14) & 1)) break; phase_s5_gemm1(p); break;
    case 15: if (!((PH_MASK >> 15) & 1)) break; phase_s5_scan(p, layer); break;
    case 16: if (!((PH_MASK >> 16) & 1)) break; phase_s5_gemm2(p); break;
    case 17: if (!((PH_MASK >> 17) & 1)) break; phase_glu(p); break;
    case 18: if (!((PH_MASK >> 18) & 1)) break; phase_merge(p); break;
    case 19: if (!((PH_MASK >> 19) & 1)) break; phase_out(p); break;
  }
}

__global__ void __launch_bounds__(256, 2) mega_kernel(Params p, int ph_lo, int ph_hi) {
  if (ph_hi - ph_lo == 1) { run_phase(p, ph_lo); return; }
  cg::grid_group grid = cg::this_grid();
  for (int ph = ph_lo; ph < ph_hi; ++ph) {
    run_phase(p, ph);
    if (ph + 1 < ph_hi) grid.sync();
  }
}

extern "C" void kernel_launch(void* const* d_in, const int* in_sizes, int n_in, void* d_out, int out_size, void* d_ws, size_t ws_size,
                              hipStream_t stream) {
  static int grid_blocks = 0;
  if (!grid_blocks) {
    int dev = 0, cus = 0, per_cu = 0;
    hipGetDevice(&dev);
    hipDeviceGetAttribute(&cus, hipDeviceAttributeMultiprocessorCount, dev);
    hipFuncSetAttribute((const void*)mega_kernel, hipFuncAttributeMaxDynamicSharedMemorySize, LDS_BYTES);
    hipOccupancyMaxActiveBlocksPerMultiprocessor(&per_cu, mega_kernel, 256, LDS_BYTES);
    if (per_cu > 2) per_cu = 2;
    if (per_cu < 1) per_cu = 1;
    grid_blocks = cus * per_cu;
  }
  if (ws_size < WS_NEEDED) { fprintf(stderr, "workspace too small: %zu < %zu\n", ws_size, WS_NEEDED); return; }
  Params p{};
  for (int i = 0; i < 31; ++i) p.in[i] = (const float*)d_in[i];
  p.out = (float*)d_out;
  p.ws = (char*)d_ws;
#if MULTI_LAUNCH
  for (int ph = 0; ph < NPHASE; ++ph) {
    hipLaunchKernelGGL(mega_kernel, dim3(grid_blocks), dim3(256), LDS_BYTES, stream, p, ph, ph + 1);
  }
#else
  int lo = 0, hi = NPHASE;
  void* args[] = {&p, &lo, &hi};
  hipError_t e = hipLaunchCooperativeKernel((void*)mega_kernel, dim3(grid_blocks), dim3(256), args, LDS_BYTES, stream);
  if (e != hipSuccess) fprintf(stderr, "cooperative launch failed: %s (grid %d)\n", hipGetErrorString(e), grid_blocks);
#endif
}
```

```cpp
#include <hip/hip_runtime.h>
#include <hip/hip_cooperative_groups.h>
#include <cstdio>
namespace cg = cooperative_groups;

typedef unsigned short bfu;
using bf16x8 = __attribute__((ext_vector_type(8))) short;
using f32x4 = __attribute__((ext_vector_type(4))) float;
using u16x4 = __attribute__((ext_vector_type(4))) unsigned short;
using u16x8 = __attribute__((ext_vector_type(8))) unsigned short;
#define DI __device__ __forceinline__
#define MFMA16(a, b, c) __builtin_amdgcn_mfma_f32_16x16x32_bf16((a), (b), (c), 0, 0, 0)

#ifndef PH_MASK
#define PH_MASK 0xFFFFFF
#endif
#ifndef MULTI_LAUNCH
#define MULTI_LAUNCH 0
#endif

constexpr int TR = 32896;
constexpr int NCHK = 257;
constexpr int LBATCH = 16448;
constexpr int LDS_BYTES = 73728;
constexpr int NPL = 21;
constexpr int NPHASE = 1 + 4 * NPL + 1;

constexpr size_t OFF_H32 = 0;
constexpr size_t OFF_H16 = 134742016;
constexpr size_t OFF_Y = 202113024;
constexpr size_t OFF_P = 336855040;
constexpr size_t OFF_X = 471597056;
constexpr size_t OFF_SC = 623181824;
constexpr size_t OFF_PS = 627392512;
constexpr size_t OFF_W = 629497856;
constexpr size_t OFF_WIN = OFF_W;
constexpr size_t OFF_WS = OFF_WIN + 22020096;
constexpr size_t OFF_WGLU = OFF_WS + 32768;
constexpr size_t OFF_WB = OFF_WGLU + 1048576;
constexpr size_t OFF_WO = OFF_WB + 4194304;
constexpr size_t OFF_MS = OFF_WO + 2097152;
constexpr size_t OFF_MC = OFF_MS + 2097152;
constexpr size_t OFF_LB = OFF_MC + 6291456;
constexpr size_t OFF_LP = OFF_LB + 2048;
constexpr size_t OFF_BB = OFF_LP + 1114112;
constexpr size_t OFF_BAR = OFF_BB + 1048576;
constexpr size_t WS_NEEDED = OFF_BAR + 16384;
constexpr size_t OFF_PZ = OFF_P;
constexpr size_t OFF_U2 = OFF_P + 33685504;
constexpr size_t OFF_YS5 = OFF_U2 + 35651584;
constexpr size_t OFF_XLOC = OFF_X;
constexpr size_t OFF_XST = OFF_X + 35651584;

struct Params {
  const float* in[31];
  float* out;
  char* ws;
};

extern __shared__ __attribute__((aligned(16))) char g_smem[];
DI int tid_laundered() { int t = threadIdx.x; asm volatile("" : "+v"(t)); return t; }
DI int bid_laundered() { int b = blockIdx.x; asm volatile("" : "+s"(b)); return b; }
#define TIDX tid_laundered()
#define BIDX bid_laundered()


DI bfu f2bf(float x) { unsigned u = __float_as_uint(x); u += 0x7fffu + ((u >> 16) & 1u); return (bfu)(u >> 16); }
DI float bf2f(bfu b) { return __uint_as_float(((unsigned)b) << 16); }
DI float sigm(float x) { return 1.f / (1.f + __expf(-x)); }
DI float siluf(float x) { return x / (1.f + __expf(-x)); }
DI float softplusf(float x) { return x > 20.f ? x : log1pf(expf(x)); }
DI float wave_sum(float v) {
#pragma unroll
  for (int m = 32; m >= 1; m >>= 1) v += __shfl_xor(v, m);
  return v;
}
DI float wave_scan_incl(float s, int lane) {
#pragma unroll
  for (int d = 1; d < 64; d <<= 1) { float o = __shfl_up(s, d); if (lane >= d) s += o; }
  return s;
}

template <int NREP>
DI void gemm_stage(const bfu* __restrict__ A, int lda, const bfu* __restrict__ Bt, int ldb, int kt, char* buf, int tid) {
#pragma unroll
  for (int i = 0; i < 2; ++i) {
    int b = tid * 16 + i * 4096; int r = b >> 6, c = (b & 63) >> 1;
    __builtin_amdgcn_global_load_lds((const unsigned*)(A + (long)r * lda + kt + c), (unsigned*)(buf + b), 16, 0, 0);
  }
#pragma unroll
  for (int i = 0; i < NREP / 2; ++i) {
    int b = tid * 16 + i * 4096; int r = b >> 6, c = (b & 63) >> 1;
    __builtin_amdgcn_global_load_lds((const unsigned*)(Bt + (long)r * ldb + kt + c), (unsigned*)(buf + 8192 + b), 16, 0, 0);
  }
}
template <int NREP>
DI void gemm_tile(f32x4 (&acc)[4][NREP], const bfu* __restrict__ A, int lda, const bfu* __restrict__ Bt, int ldb, int K) {
  const int tid = TIDX, lane = tid & 63, wid = tid >> 6, wr = wid >> 1, wc = wid & 1, fr = lane & 15, fq = lane >> 4;
  __syncthreads();
  gemm_stage<NREP>(A, lda, Bt, ldb, 0, g_smem, tid);
  int cur = 0;
  for (int kt = 0; kt < K; kt += 32) {
    asm volatile("s_waitcnt vmcnt(0)" ::: "memory");
    __syncthreads();
    if (kt + 32 < K) gemm_stage<NREP>(A, lda, Bt, ldb, kt + 32, g_smem + (cur ^ 1) * 16384, tid);
    const char* SA = g_smem + cur * 16384;
    const char* SB = SA + 8192;
    bf16x8 af[4], bfr[NREP];
#pragma unroll
    for (int m = 0; m < 4; ++m) af[m] = *(const bf16x8*)(SA + (wr * 64 + m * 16 + fr) * 64 + fq * 16);
#pragma unroll
    for (int n = 0; n < NREP; ++n) bfr[n] = *(const bf16x8*)(SB + (wc * (NREP * 16) + n * 16 + fr) * 64 + fq * 16);
#pragma unroll
    for (int m = 0; m < 4; ++m)
#pragma unroll
      for (int n = 0; n < NREP; ++n) acc[m][n] = MFMA16(af[m], bfr[n], acc[m][n]);
    cur ^= 1;
  }
}
template <int NREP>
DI void zero_acc(f32x4 (&acc)[4][NREP]) {
#pragma unroll
  for (int m = 0; m < 4; ++m)
#pragma unroll
    for (int n = 0; n < NREP; ++n) acc[m][n] = f32x4{0.f, 0.f, 0.f, 0.f};
}
#define ACC_FOREACH(NREP_, ...)                                                                \
  {                                                                                              \
    const int lane_ = TIDX & 63, wid_ = TIDX >> 6, wr_ = wid_ >> 1, wc_ = wid_ & 1; \
    const int fr_ = lane_ & 15, fq_ = lane_ >> 4;                                                \
    _Pragma("unroll") for (int m = 0; m < 4; ++m) _Pragma("unroll") for (int n = 0; n < NREP_; ++n) \
        _Pragma("unroll") for (int j = 0; j < 4; ++j) {                                          \
      const int trow = wr_ * 64 + m * 16 + fq_ * 4 + j;                                          \
      const int tcol = wc_ * (NREP_ * 16) + n * 16 + fr_;                                        \
      __VA_ARGS__                                                                                \
    }                                                                                            \
  }

DI void phase_tables(const Params& p) {
  const int gtid = BIDX * 256 + TIDX, gth = gridDim.x * 256;
  float2* LP = (float2*)(p.ws + OFF_LP);
  float2* BB = (float2*)(p.ws + OFF_BB);
  for (int idx = gtid; idx < 4 * 32 * 64; idx += gth) {
    int l = idx >> 11, g = (idx >> 6) & 31;
    float dt = expf(p.in[24][l * 32 + g]);
    float are = p.in[17][idx], aim = p.in[18][idx];
    float e1 = are * dt, a1 = aim * dt;
    for (int d = 0; d <= 16; ++d) {
      float mag = expf((float)d * e1), ang = (float)d * a1;
      LP[(long)idx * 17 + d] = make_float2(mag * cosf(ang), mag * sinf(ang));
    }
    float mag = expf(e1);
    float lre = mag * cosf(a1), lim = mag * sinf(a1);
    float den = are * are + aim * aim;
    float nr = lre - 1.f, ni = lim;
    float zre = (nr * are + ni * aim) / den, zim = (ni * are - nr * aim) / den;
    for (int c = 0; c < 16; ++c) {
      float bre = p.in[19][(long)idx * 16 + c], bim = p.in[20][(long)idx * 16 + c];
      BB[(long)idx * 16 + c] = make_float2(zre * bre - zim * bim, zre * bim + zim * bre);
    }
  }
}

DI void ln_rows(const Params& p, int layer, bool final_) {
  float* h32 = (float*)(p.ws + OFF_H32);
  bfu* h16 = (bfu*)(p.ws + OFF_H16);
  const int lane = TIDX & 63;
  const int gw = BIDX * 4 + (TIDX >> 6), nw = gridDim.x * 4;
  const float* gam = layer < 0 ? p.in[2] : p.in[29] + layer * 1024;
  const float* bet = layer < 0 ? p.in[3] : p.in[30] + layer * 1024;
  for (int r = gw; r < TR; r += nw) {
    int b = r / LBATCH, pos = r - b * LBATCH;
    float* d32 = h32 + (long)r * 1024;
    bfu* d16 = h16 + (long)r * 1024;
    if (pos < 48) {
      if (!final_) {
#pragma unroll
        for (int i = 0; i < 4; ++i) {
          *(float4*)(d32 + i * 256 + lane * 4) = make_float4(0.f, 0.f, 0.f, 0.f);
          *(u16x4*)(d16 + i * 256 + lane * 4) = u16x4{0, 0, 0, 0};
        }
      }
      continue;
    }
    const float* src;
    if (layer < 0) src = pos < 64 ? p.in[1] + (pos - 48) * 1024 : p.in[0] + ((long)b * 16384 + (pos - 64)) * 1024;
    else src = d32;
    float4 v[4];
    float s = 0.f;
#pragma unroll
    for (int i = 0; i < 4; ++i) { v[i] = *(const float4*)(src + i * 256 + lane * 4); s += v[i].x + v[i].y + v[i].z + v[i].w; }
    float mu = wave_sum(s) * (1.f / 1024.f);
    float q = 0.f;
#pragma unroll
    for (int i = 0; i < 4; ++i) {
      v[i].x -= mu; v[i].y -= mu; v[i].z -= mu; v[i].w -= mu;
      q += v[i].x * v[i].x + v[i].y * v[i].y + v[i].z * v[i].z + v[i].w * v[i].w;
    }
    float rs = rsqrtf(wave_sum(q) * (1.f / 1024.f) + 1e-5f);
#pragma unroll
    for (int i = 0; i < 4; ++i) {
      float4 g4 = *(const float4*)(gam + i * 256 + lane * 4), b4 = *(const float4*)(bet + i * 256 + lane * 4);
      float4 o = make_float4(v[i].x * rs * g4.x + b4.x, v[i].y * rs * g4.y + b4.y, v[i].z * rs * g4.z + b4.z, v[i].w * rs * g4.w + b4.w);
      if (final_) {
        if (pos >= 64) *(float4*)(p.out + ((long)b * 16384 + (pos - 64)) * 1024 + i * 256 + lane * 4) = o;
      } else {
        *(float4*)(d32 + i * 256 + lane * 4) = o;
        *(u16x4*)(d16 + i * 256 + lane * 4) = u16x4{f2bf(o.x), f2bf(o.y), f2bf(o.z), f2bf(o.w)};
      }
    }
  }
}

template <class F>
DI void conv_T(bfu* dst, int N, int K, F src) {
  const long gtid = BIDX * 256 + TIDX, gth = (long)gridDim.x * 256;
  const long total = (long)N * (K / 8);
  for (long idx = gtid; idx < total; idx += gth) {
    int n = (int)(idx % N); int kg = (int)(idx / N);
    u16x8 o;
#pragma unroll
    for (int j = 0; j < 8; ++j) o[j] = f2bf(src(kg * 8 + j, n));
    *(u16x8*)(dst + (long)n * K + kg * 8) = o;
  }
}

DI void phase_convert(const Params& p, int l) {
  const float* win = p.in[4] + (long)l * 1024 * 10768;
  conv_T((bfu*)(p.ws + OFF_WIN), 10752, 1024, [&](int k, int n) {
    int sc = n < 2048 ? n : n < 3584 ? n + 8 : n < 5632 ? n + 16 : n < 6656 ? n + 16 : n + 16;
    return win[(long)k * 10768 + sc];
  });
  conv_T((bfu*)(p.ws + OFF_WS), 16, 1024, [&](int k, int n) { int sc = n < 8 ? 2048 + n : 3592 + (n - 8); return win[(long)k * 10768 + sc]; });
  const float* w1 = p.in[25] + (long)l * 512 * 512;
  const float* w2 = p.in[26] + (long)l * 512 * 512;
  conv_T((bfu*)(p.ws + OFF_WGLU), 1024, 512, [&](int k, int r) {
    int j = r >> 7, wc = (r >> 6) & 1, n = (r >> 4) & 3, fr = r & 15;
    int oc = j * 64 + wc * 32 + (n & 1) * 16 + fr;
    return (n >> 1) ? w2[k * 512 + oc] : w1[k * 512 + oc];
  });
  const float* wb = p.in[27] + (long)l * 4 * 512 * 1024;
  conv_T((bfu*)(p.ws + OFF_WB), 4096, 512, [&](int k, int r) { int b = r >> 10, n = r & 1023; return wb[((long)b * 512 + k) * 1024 + n]; });
  const float* wo = p.in[28] + (long)l * 1024 * 1024;
  conv_T((bfu*)(p.ws + OFF_WO), 1024, 1024, [&](int k, int n) { return wo[(long)k * 1024 + n]; });
  const int gtid = BIDX * 256 + TIDX, gth = gridDim.x * 256;
  float* lbv = (float*)(p.ws + OFF_LB);
  for (int c = gtid; c < 512; c += gth) {
    float v0 = p.in[15][c], v1 = p.in[15][512 + c], v2 = p.in[15][1024 + c], v3 = p.in[15][1536 + c];
    float mx = fmaxf(fmaxf(v0, v1), fmaxf(v2, v3));
    float e0 = expf(v0 - mx), e1 = expf(v1 - mx), e2 = expf(v2 - mx), e3 = expf(v3 - mx);
    float inv = 1.f / (e0 + e1 + e2 + e3);
    float acc = 0.f;
    if (l >= 1) acc += e1 * inv;
    if (l >= 2) acc += e2 * inv;
    if (l >= 3) acc += e3 * inv;
    lbv[c] = acc;
  }
  const float2* LP = (const float2*)(p.ws + OFF_LP) + (long)l * 32 * 64 * 17;
  const float2* BB = (const float2*)(p.ws + OFF_BB) + (long)l * 32 * 64 * 16;
  const float* cre = p.in[21] + (long)l * 32 * 16 * 64;
  const float* cim = p.in[22] + (long)l * 32 * 16 * 64;
  const float* dd = p.in[23] + l * 512;
  bfu* Ms = (bfu*)(p.ws + OFF_MS);
  bfu* Mc = (bfu*)(p.ws + OFF_MC);
  for (int idx = gtid; idx < 32 * 128 * 256; idx += gth) {
    int g = idx >> 15, pp = (idx >> 8) & 127, kk = idx & 255;
    int s = kk >> 4, c2 = kk & 15, pr = pp & 63;
    float2 lp = LP[((long)g * 64 + pr) * 17 + (15 - s)];
    float2 bb = BB[((long)g * 64 + pr) * 16 + c2];
    float v = pp < 64 ? lp.x * bb.x - lp.y * bb.y : lp.x * bb.y + lp.y * bb.x;
    Ms[idx] = f2bf(v);
  }
  for (int idx = gtid; idx < 32 * 256 * 384; idx += gth) {
    int g = idx / (256 * 384); int rem = idx - g * (256 * 384);
    int o = rem / 384, kk = rem - o * 384;
    int t = o >> 4, c = o & 15;
    float v = 0.f;
    const float* cr = cre + ((long)g * 16 + c) * 64;
    const float* ci = cim + ((long)g * 16 + c) * 64;
    if (kk < 256) {
      int s = kk >> 4, c2 = kk & 15;
      if (t >= s) {
        int d = t - s;
        for (int pr = 0; pr < 64; ++pr) {
          float2 lp = LP[((long)g * 64 + pr) * 17 + d];
          float2 bb = BB[((long)g * 64 + pr) * 16 + c2];
          float ere = lp.x * bb.x - lp.y * bb.y, eim = lp.x * bb.y + lp.y * bb.x;
          v += cr[pr] * ere - ci[pr] * eim;
        }
        if (kk == o) v += dd[g * 16 + c];
      }
    } else {
      int pp = kk - 256, pr = pp & 63;
      float2 lp = LP[((long)g * 64 + pr) * 17 + (t + 1)];
      v = pp < 64 ? cr[pr] * lp.x - ci[pr] * lp.y : -(cr[pr] * lp.y + ci[pr] * lp.x);
    }
    Mc[idx] = f2bf(v);
  }
}

DI void phase_proj(const Params& p, int wrow0, int ncols, int mode, bool with_small) {
  const bfu* h16 = (const bfu*)(p.ws + OFF_H16);
  const bfu* WT = (const bfu*)(p.ws + OFF_WIN);
  bfu* P = (bfu*)(p.ws + OFF_P);
  bfu* U2 = (bfu*)(p.ws + OFF_U2);
  const int ntn = ncols >> 7;
  const int ntiles = 257 * ntn;
  const int total = ntiles + (with_small ? 257 : 0);
  for (int t = BIDX; t < total; t += gridDim.x) {
    if (t < ntiles) {
      int tm = t / ntn, tn = t - tm * ntn;
      f32x4 acc[4][4];
      zero_acc<4>(acc);
      gemm_tile<4>(acc, h16 + (long)tm * 128 * 1024, 1024, WT + (long)(wrow0 + tn * 128) * 1024, 1024, 1024);
      if (mode == 0) {
        ACC_FOREACH(4, { P[(long)(tm * 128 + trow) * ncols + tn * 128 + tcol] = f2bf(acc[m][n][j]); })
      } else {
        ACC_FOREACH(4, {
          int row = tm * 128 + trow, col = tn * 128 + tcol;
          if (col < 512) { int g = col >> 4, c2 = col & 15; U2[((long)g * 2176 + (row >> 4)) * 256 + (row & 15) * 16 + c2] = f2bf(acc[m][n][j]); }
          else P[(long)row * 512 + (col - 512)] = f2bf(acc[m][n][j]);
        })
      }
    } else {
      int tm = t - ntiles;
      const int lane = TIDX & 63, w = TIDX >> 6, fr = lane & 15, fq = lane >> 4;
      const bfu* WsT = (const bfu*)(p.ws + OFF_WS);
      float* Ps = (float*)(p.ws + OFF_PS);
      f32x4 a0 = {0.f, 0.f, 0.f, 0.f}, a1 = {0.f, 0.f, 0.f, 0.f};
      const bfu* pa0 = h16 + (long)(tm * 128 + w * 32 + fr) * 1024 + fq * 8;
      const bfu* pa1 = pa0 + 16 * 1024;
      const bfu* pb = WsT + fr * 1024 + fq * 8;
      for (int k = 0; k < 1024; k += 32) {
        bf16x8 x0 = *(const bf16x8*)(pa0 + k), x1 = *(const bf16x8*)(pa1 + k), y = *(const bf16x8*)(pb + k);
        a0 = MFMA16(x0, y, a0);
        a1 = MFMA16(x1, y, a1);
      }
#pragma unroll
      for (int j = 0; j < 4; ++j) {
        Ps[(long)(tm * 128 + w * 32 + fq * 4 + j) * 16 + fr] = a0[j];
        Ps[(long)(tm * 128 + w * 32 + 16 + fq * 4 + j) * 16 + fr] = a1[j];
      }
    }
  }
}

DI void gdn_prep_item(const Params& p, int layer, int item) {
  const int tid = TIDX, lane = tid & 63, w = tid >> 6, fr = lane & 15, fq = lane >> 4;
  const int h = item & 3, cn = item >> 2, n = cn % NCHK;
  const long r0 = (long)cn * 64;
  const bfu* P = (const bfu*)(p.ws + OFF_P);
  const float* Ps = (const float*)(p.ws + OFF_PS);
  bfu* Xb = (bfu*)(p.ws + OFF_X) + (long)item * 36864;
  float* SC = (float*)(p.ws + OFF_SC) + (long)item * 256;
  bfu* rawQ = (bfu*)g_smem;
  bfu* rawK = rawQ + 64 * 136;
  bfu* rawV = rawK + 64 * 136;
  float* aL = (float*)(g_smem + 52224);
  float* sm = (float*)(g_smem + 69632);
  const float* cw = p.in[5] + layer * 4 * 1536;
  for (int cc = tid; cc < 384; cc += 256) {
    int which = cc >> 7, c = cc & 127, col = which * 512 + h * 128 + c;
    float w0 = cw[col], w1 = cw[1536 + col], w2 = cw[2 * 1536 + col], w3 = cw[3 * 1536 + col];
    const bfu* src = P + r0 * 2048 + col;
    float xm3 = 0.f, xm2 = 0.f, xm1 = 0.f;
    if (n > 0) { xm3 = bf2f(*(src - 3 * 2048)); xm2 = bf2f(*(src - 2 * 2048)); xm1 = bf2f(*(src - 2048)); }
    bfu* dst = rawQ + which * (64 * 136) + c;
#pragma unroll 16
    for (int t = 0; t < 64; ++t) {
      float x = bf2f(src[(long)t * 2048]);
      float v = w0 * xm3 + w1 * xm2 + w2 * xm1 + w3 * x;
      dst[t * 136] = f2bf(siluf(v));
      xm3 = xm2; xm2 = xm1; xm1 = x;
    }
  }
  if (w == 2) {
    const float* ps = Ps + (r0 + lane) * 16;
    float be = sigm(ps[h]);
    float gl = -expf(p.in[6][layer * 4 + h]) * softplusf(ps[4 + h] + p.in[7][layer * 4 + h]);
    float s = wave_scan_incl(gl, lane);
    sm[128 + lane] = be;
    sm[192 + lane] = s;
  }
  __syncthreads();
  if (tid < 128) {
    int row = tid & 63, mat = tid >> 6;
    const bfu* rp = rawQ + mat * (64 * 136) + row * 136;
    float ss = 0.f;
    for (int c = 0; c < 128; ++c) { float v = bf2f(rp[c]); ss += v * v; }
    float sc = rsqrtf(ss + 1e-6f);
    if (mat == 0) sc *= 0.08838834764831845f;
    sm[mat * 64 + row] = sc;
  }
  __syncthreads();
  if (tid < 64) { float be = sm[128 + tid]; sm[256 + tid] = be; sm[320 + tid] = be * sm[64 + tid] * expf(sm[192 + tid]); }
  {
    bf16x8 kf[4], qf[4];
#pragma unroll
    for (int ks = 0; ks < 4; ++ks) {
      kf[ks] = *(const bf16x8*)(rawK + (16 * w + fr) * 136 + ks * 32 + fq * 8);
      qf[ks] = *(const bf16x8*)(rawQ + (16 * w + fr) * 136 + ks * 32 + fq * 8);
    }
    bfu* AMg = Xb + 32768;
    for (int tj = 0; tj < 4; ++tj) {
      if (tj <= w) {
        f32x4 akk = {0.f, 0.f, 0.f, 0.f}, aqk = {0.f, 0.f, 0.f, 0.f};
#pragma unroll
        for (int ks = 0; ks < 4; ++ks) {
          bf16x8 bk = *(const bf16x8*)(rawK + (16 * tj + fr) * 136 + ks * 32 + fq * 8);
          akk = MFMA16(kf[ks], bk, akk);
          aqk = MFMA16(qf[ks], bk, aqk);
        }
        int j = 16 * tj + fr;
        float rkj = sm[64 + j], gcj = sm[192 + j];
#pragma unroll
        for (int r = 0; r < 4; ++r) {
          int i = 16 * w + fq * 4 + r;
          float dec = (i >= j) ? expf(sm[192 + i] - gcj) : 0.f;
          aL[i * 68 + j] = (i > j) ? sm[128 + i] * sm[64 + i] * rkj * akk[r] * dec : 0.f;
          AMg[i * 64 + j] = f2bf((i >= j) ? sm[i] * rkj * aqk[r] * dec : 0.f);
        }
      } else {
#pragma unroll
        for (int r = 0; r < 4; ++r) AMg[(16 * w + fq * 4 + r) * 64 + 16 * tj + fr] = 0;
      }
    }
  }
  __syncthreads();
  {
    const bfu* src = (tid < 128) ? (rawV + tid) : (rawK + (tid - 128));
    const float* rs = sm + ((tid < 128) ? 256 : 320);
    float x[64];
#pragma unroll
    for (int i = 0; i < 64; ++i) {
      float a = bf2f(src[i * 136]) * rs[i];
#pragma unroll
      for (int j = 0; j < i; ++j) a -= aL[i * 68 + j] * x[j];
      x[i] = a;
    }
    if (tid < 128) {
      bfu* UT = Xb + 24576 + tid * 64;
#pragma unroll
      for (int i = 0; i < 64; i += 8) {
        u16x8 o;
#pragma unroll
        for (int j = 0; j < 8; ++j) o[j] = f2bf(x[i + j]);
        *(u16x8*)(UT + i) = o;
      }
    } else {
      bfu* Wg = Xb + 8192 + (tid - 128);
#pragma unroll
      for (int i = 0; i < 64; ++i) Wg[i * 128] = f2bf(x[i]);
    }
  }
  {
    bfu* QDg = Xb;
    bfu* KDTg = Xb + 16384;
    float gl_last = sm[192 + 63];
    for (int idx = tid; idx < 8192; idx += 256) { int i = idx >> 7, c = idx & 127; QDg[idx] = f2bf(bf2f(rawQ[i * 136 + c]) * sm[i] * expf(sm[192 + i])); }
    for (int idx = tid; idx < 8192; idx += 256) { int c = idx >> 6, i = idx & 63; KDTg[idx] = f2bf(bf2f(rawK[i * 136 + c]) * sm[64 + i] * expf(gl_last - sm[192 + i])); }
    if (tid < 128) SC[128 + tid] = expf(gl_last);
  }
  __syncthreads();
}

DI void ssd_prep_item(const Params& p, int layer, int item) {
  const int tid = TIDX, lane = tid & 63, w = tid >> 6, fr = lane & 15, fq = lane >> 4;
  const int g = item & 1, cn = item >> 1, n = cn % NCHK;
  const long r0 = (long)cn * 64;
  const bfu* P = (const bfu*)(p.ws + OFF_P);
  const float* Ps = (const float*)(p.ws + OFF_PS);
  bfu* Xb = (bfu*)(p.ws + OFF_X) + (long)cn * 131072;
  float* SCb = (float*)(p.ws + OFF_SC) + (long)cn * 8 * 256;
  bfu* Bm = (bfu*)g_smem;
  bfu* Cm = Bm + 64 * 136;
  float* cb = (float*)(g_smem + 34816);
  float* sm = (float*)(g_smem + 34816 + 17408);
  {
    int hd = g * 4 + w;
    float dtv = softplusf(Ps[(r0 + lane) * 16 + 8 + hd] + p.in[11][layer * 8 + hd]);
    float a = -dtv * expf(p.in[12][layer * 8 + hd]);
    float ac = wave_scan_incl(a, lane);
    sm[w * 64 + lane] = dtv;
    sm[256 + w * 64 + lane] = ac;
  }
  __syncthreads();
  const float* cw = p.in[9] + layer * 4 * 1024;
  const float* cbias = p.in[10] + layer * 1024;
  for (int cc = tid; cc < 512; cc += 256) {
    int col = (cc < 128) ? 512 + g * 128 + cc : (cc < 256) ? 768 + g * 128 + (cc - 128) : g * 256 + (cc - 256);
    float w0 = cw[col], w1 = cw[1024 + col], w2 = cw[2048 + col], w3 = cw[3072 + col], bb = cbias[col];
    const bfu* src = P + r0 * 1536 + col;
    float xm3 = 0.f, xm2 = 0.f, xm1 = 0.f;
    if (n > 0) { xm3 = bf2f(*(src - 3 * 1536)); xm2 = bf2f(*(src - 2 * 1536)); xm1 = bf2f(*(src - 1536)); }
    int hh = (cc - 256) >> 6, pp = (cc - 256) & 63;
    bfu* vt = Xb + 32768 + (g * 4 + (hh & 3)) * 12288 + 4096 + pp * 64;
#pragma unroll 16
    for (int t = 0; t < 64; ++t) {
      float x = bf2f(src[(long)t * 1536]);
      float v = siluf(w0 * xm3 + w1 * xm2 + w2 * xm1 + w3 * x + bb);
      if (n == 0 && t < 48) v = 0.f;
      if (cc < 128) Bm[t * 136 + cc] = f2bf(v);
      else if (cc < 256) Cm[t * 136 + (cc - 128)] = f2bf(v);
      else { float xd = v * sm[hh * 64 + t]; vt[t] = f2bf(xd); vt[4096 + t] = f2bf(xd * expf(sm[256 + hh * 64 + 63] - sm[256 + hh * 64 + t])); }
      xm3 = xm2; xm2 = xm1; xm1 = x;
    }
  }
  __syncthreads();
  {
    bf16x8 cf[4];
#pragma unroll
    for (int ks = 0; ks < 4; ++ks) cf[ks] = *(const bf16x8*)(Cm + (16 * w + fr) * 136 + ks * 32 + fq * 8);
    for (int tj = 0; tj < 4; ++tj) {
      if (tj <= w) {
        f32x4 a = {0.f, 0.f, 0.f, 0.f};
#pragma unroll
        for (int ks = 0; ks < 4; ++ks) {
          bf16x8 bk = *(const bf16x8*)(Bm + (16 * tj + fr) * 136 + ks * 32 + fq * 8);
          a = MFMA16(cf[ks], bk, a);
        }
#pragma unroll
        for (int r = 0; r < 4; ++r) cb[(16 * w + fq * 4 + r) * 68 + 16 * tj + fr] = a[r];
      }
    }
    bfu* Cg = Xb + g * 16384;
    bfu* BTg = Cg + 8192;
    for (int idx = tid; idx < 8192; idx += 256) Cg[idx] = Cm[(idx >> 7) * 136 + (idx & 127)];
    for (int idx = tid; idx < 8192; idx += 256) BTg[idx] = Bm[(idx & 63) * 136 + (idx >> 6)];
  }
  __syncthreads();
  for (int hh = 0; hh < 4; ++hh) {
    int hd = g * 4 + hh;
    bfu* AMg = Xb + 32768 + hd * 12288;
    float Dh = p.in[13][layer * 8 + hd];
    const float* dtp = sm + hh * 64;
    const float* acp = sm + 256 + hh * 64;
    for (int idx = tid; idx < 4096; idx += 256) {
      int l = idx >> 6, m = idx & 63;
      float v = (m <= l) ? cb[l * 68 + m] * expf(acp[l] - acp[m]) : 0.f;
      if (m == l) v += Dh / dtp[l];
      AMg[idx] = f2bf(v);
    }
    float* sc = SCb + hd * 256;
    float alast = acp[63];
    if (tid < 64) { sc[tid] = expf(acp[tid]); sc[64 + tid] = expf(alast - acp[tid]); }
    else if (tid < 192) sc[128 + (tid - 64)] = expf(alast);
  }
  __syncthreads();
}

DI void hg_prep_item(const Params& p, int layer, int item) {
  const int tid = TIDX, lane = tid & 63, w = tid >> 6, fr = lane & 15, fq = lane >> 4;
  const int h = item & 3, cn = item >> 2;
  const long r0 = (long)cn * 64;
  const bfu* P = (const bfu*)(p.ws + OFF_P);
  const float* lbv = (const float*)(p.ws + OFF_LB);
  bfu* Xb = (bfu*)(p.ws + OFF_X) + (long)item * 28672;
  float* SC = (float*)(p.ws + OFF_SC) + (long)item * 256;
  bfu* Qall = (bfu*)g_smem;
  bfu* Ks = Qall + 160 * 136;
  bfu* QDg = Xb;
  bfu* KDTg = Xb + 8192;
  bfu* AMg = Xb + 16384;
  bfu* VTg = Xb + 20480;
  if (tid < 128) {
    const int k = tid;
    const float lb = lbv[h * 128 + k];
    const bfu* fp = P + r0 * 2048 + 512 + h * 128 + k;
    const bfu* qp = P + r0 * 2048 + h * 128 + k;
    float lf[64];
    float G = 0.f, G1 = 0.f, G2 = 0.f, G3 = 0.f;
#pragma unroll
    for (int t = 0; t < 64; ++t) {
      float zf = bf2f(fp[(long)t * 2048]);
      float f = lb + (1.f - lb) * (1.f / (1.f + expf(-zf)));
      lf[t] = logf(f);
      G += lf[t];
      if (t == 15) G1 = G;
      if (t == 31) G2 = G;
      if (t == 47) G3 = G;
    }
    const float Glast = G;
    G = 0.f;
#pragma unroll
    for (int t = 0; t < 64; ++t) {
      G += lf[t];
      float zf = bf2f(fp[(long)t * 2048]);
      float kk = (1.f - lb) * (1.f / (1.f + expf(zf)));
      float q = siluf(bf2f(qp[(long)t * 2048]));
      bfu qd = f2bf(q * expf(G));
      QDg[t * 128 + k] = qd;
      Qall[t * 136 + k] = qd;
      if (t >= 16) Qall[(64 + t - 16) * 136 + k] = f2bf(q * expf(G - G1));
      if (t >= 32) Qall[(112 + t - 32) * 136 + k] = f2bf(q * expf(G - G2));
      if (t >= 48) Qall[(144 + t - 48) * 136 + k] = f2bf(q * expf(G - G3));
      float GJ = (t < 16) ? 0.f : (t < 32) ? G1 : (t < 48) ? G2 : G3;
      Ks[t * 136 + k] = f2bf(kk * expf(fminf(GJ - G, 80.f)));
      KDTg[k * 64 + t] = f2bf(kk * expf(Glast - G));
    }
    SC[128 + k] = expf(Glast);
  } else {
    const int v = tid - 128;
    const bfu* ip = P + r0 * 2048 + 1024 + h * 128 + v;
#pragma unroll
    for (int t0 = 0; t0 < 64; t0 += 8) {
      u16x8 o;
#pragma unroll
      for (int j = 0; j < 8; ++j) o[j] = ip[(long)(t0 + j) * 2048];
      *(u16x8*)(VTg + v * 64 + t0) = o;
    }
  }
  __syncthreads();
  for (int J = 0; J < 4; ++J) {
    if (J <= w) {
      int rowbase = (J == 0 ? 0 : J == 1 ? 64 : J == 2 ? 112 : 144) + 16 * (w - J);
      f32x4 a = {0.f, 0.f, 0.f, 0.f};
#pragma unroll
      for (int ks = 0; ks < 4; ++ks) {
        bf16x8 af = *(const bf16x8*)(Qall + (rowbase + fr) * 136 + ks * 32 + fq * 8);
        bf16x8 bk = *(const bf16x8*)(Ks + (16 * J + fr) * 136 + ks * 32 + fq * 8);
        a = MFMA16(af, bk, a);
      }
#pragma unroll
      for (int r = 0; r < 4; ++r) {
        int t = 16 * w + fq * 4 + r, s = 16 * J + fr;
        AMg[t * 64 + s] = f2bf((s <= t) ? a[r] : 0.f);
      }
    } else {
#pragma unroll
      for (int r = 0; r < 4; ++r) AMg[(16 * w + fq * 4 + r) * 64 + 16 * J + fr] = 0;
    }
  }
  __syncthreads();
}

struct LinArgs {
  const bfu* kdt; long kdt_cs;
  const bfu* vt; long vt_cs;
  const float* sc; long sc_cs;
  bfu* ss; long ss_cs;
};
struct LinFrags { bf16x8 kf[2][2]; bf16x8 vf[2][2]; f32x4 dv[2]; };
DI void lin_load(LinFrags& f, const LinArgs& e, int n, int w, int fr, int fq) {
#pragma unroll
  for (int a = 0; a < 2; ++a)
#pragma unroll
    for (int ks = 0; ks < 2; ++ks) f.kf[a][ks] = *(const bf16x8*)(e.kdt + n * e.kdt_cs + ((2 * w + a) * 16 + fr) * 64 + ks * 32 + fq * 8);
#pragma unroll
  for (int jv = 0; jv < 2; ++jv)
#pragma unroll
    for (int ks = 0; ks < 2; ++ks) f.vf[jv][ks] = *(const bf16x8*)(e.vt + n * e.vt_cs + (jv * 16 + fr) * 64 + ks * 32 + fq * 8);
#pragma unroll
  for (int a = 0; a < 2; ++a) f.dv[a] = *(const f32x4*)(e.sc + n * e.sc_cs + 128 + (2 * w + a) * 16 + fq * 4);
}
template <int NST>
DI void engine_lin(const LinArgs& e) {
  const int tid = TIDX, lane = tid & 63, w = tid >> 6, fr = lane & 15, fq = lane >> 4;
  f32x4 S[2][2];
#pragma unroll
  for (int a = 0; a < 2; ++a)
#pragma unroll
    for (int jv = 0; jv < 2; ++jv) S[a][jv] = f32x4{0.f, 0.f, 0.f, 0.f};
  LinFrags f[NST];
#pragma unroll
  for (int s = 0; s < NST - 1; ++s) lin_load(f[s], e, s, w, fr, fq);
  for (int n0 = 0; n0 < NCHK; n0 += NST) {
#pragma unroll
    for (int s = 0; s < NST; ++s) {
      const int n = n0 + s;
      if (n < NCHK) {
        int nl = n + NST - 1; if (nl > NCHK - 1) nl = NCHK - 1;
        lin_load(f[(s + NST - 1) % NST], e, nl, w, fr, fq);
        const LinFrags& c = f[s];
#pragma unroll
        for (int a = 0; a < 2; ++a)
#pragma unroll
          for (int jv = 0; jv < 2; ++jv) {
            u16x4 pk = {f2bf(S[a][jv][0]), f2bf(S[a][jv][1]), f2bf(S[a][jv][2]), f2bf(S[a][jv][3])};
            *(u16x4*)(e.ss + n * e.ss_cs + (jv * 16 + fr) * 128 + (2 * w + a) * 16 + fq * 4) = pk;
          }
#pragma unroll
        for (int a = 0; a < 2; ++a) {
#pragma unroll
          for (int jv = 0; jv < 2; ++jv)
#pragma unroll
            for (int r = 0; r < 4; ++r) S[a][jv][r] *= c.dv[a][r];
#pragma unroll
          for (int ks = 0; ks < 2; ++ks)
#pragma unroll
            for (int jv = 0; jv < 2; ++jv) S[a][jv] = MFMA16(c.kf[a][ks], c.vf[jv][ks], S[a][jv]);
        }
      }
    }
  }
}

struct GdnArgs {
  const bfu* w; const bfu* kdt; bfu* ut; long cs;
  const float* sc; long sc_cs;
  bfu* ss; long ss_cs;
};
struct GdnFrags { bf16x8 wf[4]; bf16x8 kf[2][2]; u16x4 v[2]; float dv; };
DI void gdn_load(GdnFrags& f, const GdnArgs& e, int n, int w, int fr, int fq) {
#pragma unroll
  for (int ks = 0; ks < 4; ++ks) f.wf[ks] = *(const bf16x8*)(e.w + n * e.cs + (16 * w + fr) * 128 + ks * 32 + fq * 8);
#pragma unroll
  for (int a = 0; a < 2; ++a)
#pragma unroll
    for (int ks = 0; ks < 2; ++ks) f.kf[a][ks] = *(const bf16x8*)(e.kdt + n * e.cs + ((2 * w + a) * 16 + fr) * 64 + ks * 32 + fq * 8);
#pragma unroll
  for (int jv = 0; jv < 2; ++jv) f.v[jv] = *(const u16x4*)(e.ut + n * e.cs + (jv * 16 + fr) * 64 + 16 * w + fq * 4);
  f.dv = e.sc[n * e.sc_cs + 128];
}
template <int NST>
DI void engine_gdn(const GdnArgs& e) {
  const int tid = TIDX, lane = tid & 63, w = tid >> 6, fr = lane & 15, fq = lane >> 4;
  char* VT = g_smem + 17408;
  f32x4 S[2][2];
#pragma unroll
  for (int a = 0; a < 2; ++a)
#pragma unroll
    for (int jv = 0; jv < 2; ++jv) S[a][jv] = f32x4{0.f, 0.f, 0.f, 0.f};
  GdnFrags f[NST];
#pragma unroll
  for (int s = 0; s < NST - 1; ++s) gdn_load(f[s], e, s, w, fr, fq);
  for (int n0 = 0; n0 < NCHK; n0 += NST) {
#pragma unroll
    for (int s = 0; s < NST; ++s) {
      const int n = n0 + s;
      if (n < NCHK) {
        int nl = n + NST - 1; if (nl > NCHK - 1) nl = NCHK - 1;
        gdn_load(f[(s + NST - 1) % NST], e, nl, w, fr, fq);
        const GdnFrags& c = f[s];
        char* STc = g_smem + (n & 1) * 8704;
#pragma unroll
        for (int a = 0; a < 2; ++a)
#pragma unroll
          for (int jv = 0; jv < 2; ++jv) {
            u16x4 pk = {f2bf(S[a][jv][0]), f2bf(S[a][jv][1]), f2bf(S[a][jv][2]), f2bf(S[a][jv][3])};
            *(u16x4*)(STc + ((jv * 16 + fr) * 136 + (2 * w + a) * 16 + fq * 4) * 2) = pk;
            *(u16x4*)(e.ss + n * e.ss_cs + (jv * 16 + fr) * 128 + (2 * w + a) * 16 + fq * 4) = pk;
          }
        __syncthreads();
        f32x4 av[2] = {f32x4{0.f, 0.f, 0.f, 0.f}, f32x4{0.f, 0.f, 0.f, 0.f}};
#pragma unroll
        for (int ks = 0; ks < 4; ++ks)
#pragma unroll
          for (int jv = 0; jv < 2; ++jv) {
            bf16x8 sf = *(const bf16x8*)(STc + ((jv * 16 + fr) * 136 + ks * 32 + fq * 8) * 2);
            av[jv] = MFMA16(c.wf[ks], sf, av[jv]);
          }
#pragma unroll
        for (int jv = 0; jv < 2; ++jv) {
          u16x4 pk;
#pragma unroll
          for (int r = 0; r < 4; ++r) pk[r] = f2bf(bf2f(c.v[jv][r]) - av[jv][r]);
          *(u16x4*)(VT + ((jv * 16 + fr) * 72 + 16 * w + fq * 4) * 2) = pk;
          *(u16x4*)(e.ut + n * e.cs + (jv * 16 + fr) * 64 + 16 * w + fq * 4) = pk;
        }
        __syncthreads();
#pragma unroll
        for (int a = 0; a < 2; ++a) {
#pragma unroll
          for (int jv = 0; jv < 2; ++jv)
#pragma unroll
            for (int r = 0; r < 4; ++r) S[a][jv][r] *= c.dv;
#pragma unroll
          for (int ks = 0; ks < 2; ++ks)
#pragma unroll
            for (int jv = 0; jv < 2; ++jv) {
              bf16x8 vf = *(const bf16x8*)(VT + ((jv * 16 + fr) * 72 + ks * 32 + fq * 8) * 2);
              S[a][jv] = MFMA16(c.kf[a][ks], vf, S[a][jv]);
            }
        }
      }
    }
  }
  __syncthreads();
}

template <int NVT, bool USE_RS>
DI void oproj_core(f32x4 (&acc)[NVT], const bfu* qd, const bfu* am, const bfu* st, const bfu* vt, const float* rsp, int w, int fr, int fq) {
#pragma unroll
  for (int jv = 0; jv < NVT; ++jv) acc[jv] = f32x4{0.f, 0.f, 0.f, 0.f};
#pragma unroll
  for (int ks = 0; ks < 4; ++ks) {
    bf16x8 qf = *(const bf16x8*)(qd + (16 * w + fr) * 128 + ks * 32 + fq * 8);
#pragma unroll
    for (int jv = 0; jv < NVT; ++jv) {
      bf16x8 sf = *(const bf16x8*)(st + (jv * 16 + fr) * 128 + ks * 32 + fq * 8);
      acc[jv] = MFMA16(qf, sf, acc[jv]);
    }
  }
  if (USE_RS) {
    f32x4 rs = *(const f32x4*)(rsp + 16 * w + fq * 4);
#pragma unroll
    for (int jv = 0; jv < NVT; ++jv)
#pragma unroll
      for (int r = 0; r < 4; ++r) acc[jv][r] *= rs[r];
  }
#pragma unroll
  for (int ks = 0; ks < 2; ++ks) {
    bf16x8 af = *(const bf16x8*)(am + (16 * w + fr) * 64 + ks * 32 + fq * 8);
#pragma unroll
    for (int jv = 0; jv < NVT; ++jv) {
      bf16x8 vf = *(const bf16x8*)(vt + (jv * 16 + fr) * 64 + ks * 32 + fq * 8);
      acc[jv] = MFMA16(af, vf, acc[jv]);
    }
  }
}
DI void oproj_head128(const bfu* qd, const bfu* am, const bfu* st, const bfu* vt, const bfu* zP, int zld, const float* nw, bfu* Yo) {
  const int tid = TIDX, lane = tid & 63, w = tid >> 6, fr = lane & 15, fq = lane >> 4;
  f32x4 acc[8];
  oproj_core<8, false>(acc, qd, am, st, vt, nullptr, w, fr, fq);
  float ss[4] = {0.f, 0.f, 0.f, 0.f};
#pragma unroll
  for (int jv = 0; jv < 8; ++jv)
#pragma unroll
    for (int r = 0; r < 4; ++r) ss[r] += acc[jv][r] * acc[jv][r];
#pragma unroll
  for (int r = 0; r < 4; ++r) {
    float s = ss[r];
    s += __shfl_xor(s, 1); s += __shfl_xor(s, 2); s += __shfl_xor(s, 4); s += __shfl_xor(s, 8);
    ss[r] = rsqrtf(s * (1.f / 128.f) + 1e-6f);
  }
#pragma unroll
  for (int jv = 0; jv < 8; ++jv) {
    float wv = nw[jv * 16 + fr];
#pragma unroll
    for (int r = 0; r < 4; ++r) {
      int tok = 16 * w + fq * 4 + r;
      float z = bf2f(zP[(long)tok * zld + jv * 16 + fr]);
      Yo[(long)tok * 512 + jv * 16 + fr] = f2bf(acc[jv][r] * ss[r] * wv * siluf(z));
    }
  }
}
DI void oproj_ssd(const bfu* Xb  , int g, const float* SCb, const bfu* SSb, const bfu* zP, const float* nw, bfu* Yo) {
  const int tid = TIDX, lane = tid & 63, w = tid >> 6, fr = lane & 15, fq = lane >> 4;
  f32x4 acc[4][4];
#pragma unroll
  for (int hh = 0; hh < 4; ++hh) {
    int hd = g * 4 + hh;
    oproj_core<4, true>(acc[hh], Xb + g * 16384, Xb + 32768 + hd * 12288, SSb + hd * 8192, Xb + 32768 + hd * 12288 + 4096, SCb + hd * 256, w, fr, fq);
  }
  float ss[4] = {0.f, 0.f, 0.f, 0.f};
#pragma unroll
  for (int hh = 0; hh < 4; ++hh)
#pragma unroll
    for (int jv = 0; jv < 4; ++jv)
#pragma unroll
      for (int r = 0; r < 4; ++r) {
        int tok = 16 * w + fq * 4 + r;
        float z = bf2f(zP[(long)tok * 1536 + hh * 64 + jv * 16 + fr]);
        float y = acc[hh][jv][r] * siluf(z);
        acc[hh][jv][r] = y;
        ss[r] += y * y;
      }
#pragma unroll
  for (int r = 0; r < 4; ++r) {
    float s = ss[r];
    s += __shfl_xor(s, 1); s += __shfl_xor(s, 2); s += __shfl_xor(s, 4); s += __shfl_xor(s, 8);
    ss[r] = rsqrtf(s * (1.f / 256.f) + 1e-6f);
  }
#pragma unroll
  for (int hh = 0; hh < 4; ++hh)
#pragma unroll
    for (int jv = 0; jv < 4; ++jv) {
      float wv = nw[hh * 64 + jv * 16 + fr];
#pragma unroll
      for (int r = 0; r < 4; ++r) {
        int tok = 16 * w + fq * 4 + r;
        Yo[(long)tok * 512 + hh * 64 + jv * 16 + fr] = f2bf(acc[hh][jv][r] * ss[r] * wv);
      }
    }
}

DI float geluf(float x) { float u = 0.7978845608028654f * (x + 0.044715f * x * x * x); return 0.5f * x * (1.f + tanhf(u)); }

DI void phase_s5_gemm1(const Params& p) {
  const bfu* U2 = (const bfu*)(p.ws + OFF_U2);
  const bfu* Ms = (const bfu*)(p.ws + OFF_MS);
  float* Xloc = (float*)(p.ws + OFF_XLOC);
  for (int t = BIDX; t < 32 * 17; t += gridDim.x) {
    int g = t / 17, tm = t - g * 17;
    f32x4 acc[4][4];
    zero_acc<4>(acc);
    gemm_tile<4>(acc, U2 + ((long)g * 2176 + tm * 128) * 256, 256, Ms + (long)g * 128 * 256, 256, 256);
    ACC_FOREACH(4, { Xloc[((long)g * 2176 + tm * 128 + trow) * 128 + tcol] = acc[m][n][j]; })
  }
}
DI void phase_s5_scan(const Params& p, int layer) {
  float* Xloc = (float*)(p.ws + OFF_XLOC);
  bfu* Xst = (bfu*)(p.ws + OFF_XST);
  const float2* LP = (const float2*)(p.ws + OFF_LP) + (long)layer * 32 * 64 * 17;
  const int pr = TIDX;
  for (int it = BIDX; it < 64; it += gridDim.x) {
    if (pr < 64) {
      int g = it >> 1, b = it & 1;
      float2 l16 = LP[((long)g * 64 + pr) * 17 + 16];
      float sre = 0.f, sim = 0.f;
      const float* xl = Xloc + ((long)g * 2176 + b * 1028) * 128;
      bfu* xs = Xst + ((long)g * 2176 + b * 1028) * 128;
#pragma unroll 8
      for (int n = 0; n < 1028; ++n) {
        float lre = xl[(long)n * 128 + pr], lim = xl[(long)n * 128 + 64 + pr];
        xs[(long)n * 128 + pr] = f2bf(sre);
        xs[(long)n * 128 + 64 + pr] = f2bf(sim);
        float nre = l16.x * sre - l16.y * sim + lre;
        float nim = l16.x * sim + l16.y * sre + lim;
        sre = nre; sim = nim;
      }
    }
  }
}
DI void phase_s5_gemm2(const Params& p) {
  const bfu* U2 = (const bfu*)(p.ws + OFF_U2);
  const bfu* Xst = (const bfu*)(p.ws + OFF_XST);
  const bfu* Mc = (const bfu*)(p.ws + OFF_MC);
  bfu* Ys5 = (bfu*)(p.ws + OFF_YS5);
  for (int t = BIDX; t < 32 * 17 * 2; t += gridDim.x) {
    int g = t / 34, rem = t - g * 34, tm = rem >> 1, tn = rem & 1;
    f32x4 acc[4][4];
    zero_acc<4>(acc);
    const bfu* Bt = Mc + ((long)g * 256 + tn * 128) * 384;
    gemm_tile<4>(acc, U2 + ((long)g * 2176 + tm * 128) * 256, 256, Bt, 384, 256);
    gemm_tile<4>(acc, Xst + ((long)g * 2176 + tm * 128) * 128, 128, Bt + 256, 384, 128);
    ACC_FOREACH(4, {
      int nc = tm * 128 + trow, o = tn * 128 + tcol;
      if (nc < 2056) Ys5[((long)nc * 16 + (o >> 4)) * 512 + g * 16 + (o & 15)] = f2bf(geluf(acc[m][n][j]));
    })
  }
}
DI void phase_glu(const Params& p) {
  const bfu* Ys5 = (const bfu*)(p.ws + OFF_YS5);
  const bfu* Wg = (const bfu*)(p.ws + OFF_WGLU);
  const bfu* Pz = (const bfu*)(p.ws + OFF_PZ);
  bfu* Yd = (bfu*)(p.ws + OFF_Y) + (long)3 * TR * 512;
  for (int t = BIDX; t < 257 * 8; t += gridDim.x) {
    int tm = t >> 3, tn = t & 7;
    f32x4 acc[4][4];
    zero_acc<4>(acc);
    gemm_tile<4>(acc, Ys5 + (long)tm * 128 * 512, 512, Wg + (long)tn * 128 * 512, 512, 512);
    const int lane = TIDX & 63, wid = TIDX >> 6, wr = wid >> 1, wc = wid & 1, fr = lane & 15, fq = lane >> 4;
#pragma unroll
    for (int m = 0; m < 4; ++m)
#pragma unroll
      for (int n = 0; n < 2; ++n)
#pragma unroll
        for (int j = 0; j < 4; ++j) {
          int row = tm * 128 + wr * 64 + m * 16 + fq * 4 + j;
          int oc = tn * 64 + wc * 32 + n * 16 + fr;
          float z = bf2f(Pz[(long)row * 512 + oc]);
          Yd[(long)row * 512 + oc] = f2bf(acc[m][n][j] * sigm(acc[m][n + 2][j]) * siluf(z));
        }
  }
}
DI void phase_gates(const Params& p) {
  const bfu* h16 = (const bfu*)(p.ws + OFF_H16);
  const bfu* WT = (const bfu*)(p.ws + OFF_WIN);
  bfu* G = (bfu*)(p.ws + OFF_P);
  for (int t = BIDX; t < 257 * 32; t += gridDim.x) {
    int tm = t >> 5, tn = t & 31;
    f32x4 acc[4][4];
    zero_acc<4>(acc);
    gemm_tile<4>(acc, h16 + (long)tm * 128 * 1024, 1024, WT + (long)(6656 + tn * 128) * 1024, 1024, 1024);
    ACC_FOREACH(4, { G[(long)(tm * 128 + trow) * 4096 + tn * 128 + tcol] = f2bf(sigm(acc[m][n][j])); })
  }
}
DI void phase_merge(const Params& p) {
  const bfu* WbT = (const bfu*)(p.ws + OFF_WB);
  const bfu* Y = (const bfu*)(p.ws + OFF_Y);
  const bfu* G = (const bfu*)(p.ws + OFF_P);
  bfu* mixed = (bfu*)(p.ws + OFF_H16);
  for (int t = BIDX; t < 257 * 8; t += gridDim.x) {
    int tm = t >> 3, tn = t & 7;
    f32x4 tot[4][4];
    zero_acc<4>(tot);
    for (int b = 0; b < 4; ++b) {
      f32x4 acc[4][4];
      zero_acc<4>(acc);
      gemm_tile<4>(acc, Y + ((long)b * TR + tm * 128) * 512, 512, WbT + (long)(b * 1024 + tn * 128) * 512, 512, 512);
      ACC_FOREACH(4, { tot[m][n][j] += bf2f(G[(long)(tm * 128 + trow) * 4096 + b * 1024 + tn * 128 + tcol]) * acc[m][n][j]; })
    }
    ACC_FOREACH(4, { mixed[(long)(tm * 128 + trow) * 1024 + tn * 128 + tcol] = f2bf(tot[m][n][j]); })
  }
}
DI void phase_out(const Params& p) {
  const bfu* mixed = (const bfu*)(p.ws + OFF_H16);
  const bfu* WoT = (const bfu*)(p.ws + OFF_WO);
  float* h32 = (float*)(p.ws + OFF_H32);
  const float ALPHA = 1.6817928305074290f;
  for (int t = BIDX; t < 257 * 8; t += gridDim.x) {
    int tm = t >> 3, tn = t & 7;
    f32x4 acc[4][4];
    zero_acc<4>(acc);
    gemm_tile<4>(acc, mixed + (long)tm * 128 * 1024, 1024, WoT + (long)tn * 128 * 1024, 1024, 1024);
    ACC_FOREACH(4, {
      long a = (long)(tm * 128 + trow) * 1024 + tn * 128 + tcol;
      h32[a] = ALPHA * h32[a] + acc[m][n][j];
    })
  }
}

DI void run_phase(const Params& p, int ph) {
  if (ph == 0) { phase_tables(p); return; }
  if (ph == NPHASE - 1) { ln_rows(p, 3, true); return; }
  const int layer = (ph - 1) / NPL, sub = (ph - 1) % NPL;
  bfu* Xb = (bfu*)(p.ws + OFF_X);
  float* SC = (float*)(p.ws + OFF_SC);
  bfu* Y = (bfu*)(p.ws + OFF_Y);
  switch (sub) {
    case 0: if (!((PH_MASK >> 0) & 1)) break; ln_rows(p, layer - 1, false); phase_convert(p, layer); break;
    case 1: if (!((PH_MASK >> 1) & 1)) break; phase_proj(p, 0, 2048, 0, true); break;
    case 2: if (!((PH_MASK >> 2) & 1)) break; for (int it = BIDX; it < 2056; it += gridDim.x) gdn_prep_item(p, layer, it); break;
    case 3: if (!((PH_MASK >> 3) & 1)) break;
      if (BIDX < 32) {
        int bi = BIDX; int b = bi >> 4, h = (bi >> 2) & 3, sl = bi & 3;
        GdnArgs e;
        bfu* base = Xb + ((long)(b * NCHK) * 4 + h) * 36864;
        e.w = base + 8192; e.kdt = base + 16384; e.ut = base + 24576 + sl * 32 * 64; e.cs = 4 * 36864;
        e.sc = SC + ((long)(b * NCHK) * 4 + h) * 256; e.sc_cs = 4 * 256;
        e.ss = Y + (long)TR * 512 + ((long)(b * NCHK) * 4 + h) * 16384 + sl * 32 * 128; e.ss_cs = 4 * 16384;
        engine_gdn<3>(e);
      }
      break;
    case 4: if (!((PH_MASK >> 4) & 1)) break;
      for (int it = BIDX; it < 2056; it += gridDim.x) {
        int h = it & 3; long r0 = (long)(it >> 2) * 64;
        const bfu* base = Xb + (long)it * 36864;
        oproj_head128(base, base + 32768, Y + (long)TR * 512 + (long)it * 16384, base + 24576,
                      (const bfu*)(p.ws + OFF_P) + r0 * 2048 + 1536 + h * 128, 2048, p.in[8] + layer * 128, Y + r0 * 512 + h * 128);
      }
      break;
    case 5: if (!((PH_MASK >> 5) & 1)) break; phase_proj(p, 2048, 1536, 0, false); break;
    case 6: if (!((PH_MASK >> 6) & 1)) break; for (int it = BIDX; it < 1028; it += gridDim.x) ssd_prep_item(p, layer, it); break;
    case 7: if (!((PH_MASK >> 7) & 1)) break;
      if (BIDX < 32) {
        int bi = BIDX; int b = bi >> 4, hd = (bi >> 1) & 7, sl = bi & 1, g = hd >> 2;
        LinArgs e;
        const bfu* base = Xb + (long)(b * NCHK) * 131072;
        e.kdt = base + g * 16384 + 8192; e.kdt_cs = 131072;
        e.vt = base + 32768 + hd * 12288 + 8192 + sl * 32 * 64; e.vt_cs = 131072;
        e.sc = SC + ((long)(b * NCHK) * 8 + hd) * 256; e.sc_cs = 8 * 256;
        e.ss = Y + (long)2 * TR * 512 + ((long)(b * NCHK) * 8 + hd) * 8192 + sl * 32 * 128; e.ss_cs = 8 * 8192;
        engine_lin<4>(e);
      }
      break;
    case 8: if (!((PH_MASK >> 8) & 1)) break;
      for (int it = BIDX; it < 1028; it += gridDim.x) {
        int g = it & 1; long cn = it >> 1; long r0 = cn * 64;
        oproj_ssd(Xb + cn * 131072, g, SC + cn * 8 * 256, Y + (long)2 * TR * 512 + cn * 8 * 8192,
                  (const bfu*)(p.ws + OFF_P) + r0 * 1536 + 1024 + g * 256, p.in[14] + layer * 512 + g * 256, Y + (long)TR * 512 + r0 * 512 + g * 256);
      }
      break;
    case 9: if (!((PH_MASK >> 9) & 1)) break; phase_proj(p, 3584, 2048, 0, false); break;
    case 10: if (!((PH_MASK >> 10) & 1)) break; for (int it = BIDX; it < 2056; it += gridDim.x) hg_prep_item(p, layer, it); break;
    case 11: if (!((PH_MASK >> 11) & 1)) break;
      if (BIDX < 32) {
        int bi = BIDX; int b = bi >> 4, h = (bi >> 2) & 3, sl = bi & 3;
        LinArgs e;
        const bfu* base = Xb + ((long)(b * NCHK) * 4 + h) * 28672;
        e.kdt = base + 8192; e.kdt_cs = 4 * 28672;
        e.vt = base + 20480 + sl * 32 * 64; e.vt_cs = 4 * 28672;
        e.sc = SC + ((long)(b * NCHK) * 4 + h) * 256; e.sc_cs = 4 * 256;
        bfu* ssb = b == 0 ? (Y + (long)3 * TR * 512) : (Xb + (long)2056 * 28672);
        e.ss = ssb + (long)h * 16384 + sl * 32 * 128; e.ss_cs = 4 * 16384;
        engine_lin<4>(e);
      }
      break;
    case 12: if (!((PH_MASK >> 12) & 1)) break;
      for (int it = BIDX; it < 2056; it += gridDim.x) {
        int h = it & 3; int cn = it >> 2; long r0 = (long)cn * 64;
        int b = cn / NCHK, n = cn - b * NCHK;
        const bfu* base = Xb + (long)it * 28672;
        const bfu* ssb = b == 0 ? (Y + (long)3 * TR * 512) : (Xb + (long)2056 * 28672);
        oproj_head128(base, base + 16384, ssb + ((long)n * 4 + h) * 16384, base + 20480,
                      (const bfu*)(p.ws + OFF_P) + r0 * 2048 + 1536 + h * 128, 2048, p.in[16] + layer * 128, Y + (long)2 * TR * 512 + r0 * 512 + h * 128);
      }
      break;
    case 13: if (!((PH_MASK >> 13) & 1)) break; phase_proj(p, 5632, 1024, 1, false); break;
    case 14: if (!((PH_MASK >> 14) & 1)) break; phase_s5_gemm1(p); break;
    case 15: if (!((PH_MASK >> 15) & 1)) break; phase_s5_scan(p, layer); break;
    case 16: if (!((PH_MASK >> 16) & 1)) break; phase_s5_gemm2(p); break;
    case 17: if (!((PH_MASK >> 17) & 1)) break; phase_glu(p); break;
    case 18: if (!((PH_MASK >> 18) & 1)) break; phase_gates(p); break;
    case 19: if (!((PH_MASK >> 19) & 1)) break; phase_merge(p); break;
    case 20: if (!((PH_MASK >> 20) & 1)) break; phase_out(p); break;
  }
}


#define XB_TMO      128
#define XB_XCNT(j)  (256  + 64 * (j))
#define XB_XSUB(j)  (1280 + 64 * (j))
#define XB_XGEN(j)  (2304 + 64 * (j))
#define XB_TOP      3328
#define XB_TOPGEN   3392
#define XCD_BAR_WORDS 3456
#define XB_SPIN_CAP (1u << 20)
#define LAS __attribute__((address_space(3)))
DI unsigned xb_ld(unsigned* p) { return __hip_atomic_load(p, __ATOMIC_RELAXED, __HIP_MEMORY_SCOPE_AGENT); }
DI unsigned xb_add(unsigned* p, unsigned v) { return __hip_atomic_fetch_add(p, v, __ATOMIC_RELAXED, __HIP_MEMORY_SCOPE_AGENT); }
DI unsigned xb_xcc_id() { return (unsigned)__builtin_amdgcn_s_getreg((3 << 11) | 20) & 0xFu; }
#define XB_SPIN(cond, bar) do { unsigned _sp = 0; while (cond) { __builtin_amdgcn_s_sleep(1); \
    if ((++_sp & 255u) == 0u) { if (xb_ld(&(bar)[XB_TMO])) break; if (_sp > XB_SPIN_CAP) { atomicAdd(&(bar)[XB_TMO], 1u); break; } } } } while (0)
struct XcdBarrier { unsigned* bar; unsigned x; volatile LAS unsigned* st; };
DI XcdBarrier xcd_barrier_post(unsigned* bar, volatile LAS unsigned* st) {
  XcdBarrier b; b.bar = bar; b.x = xb_xcc_id(); b.st = st;
  if (threadIdx.x == 0) (void)xb_add(&bar[XB_XCNT(b.x)], 1u);
  return b;
}
DI void xcd_barrier_complete(unsigned* bar, unsigned x, unsigned& nloc, unsigned& nx) {
  const unsigned G = gridDim.x * gridDim.y * gridDim.z;
  unsigned sum, cnt, mine, sp = 0u;
  for (;;) {
    sum = 0u; cnt = 0u; mine = 0u;
#pragma unroll
    for (unsigned j = 0; j < 16; ++j) { const unsigned c = xb_ld(&bar[XB_XCNT(j)]); sum += c; cnt += (c > 0u) ? 1u : 0u; mine = (j == x) ? c : mine; }
    if (sum == G) break;
    __builtin_amdgcn_s_sleep(1);
    if ((++sp & 255u) == 0u) { if (xb_ld(&bar[XB_TMO])) break; if (sp > XB_SPIN_CAP) { atomicAdd(&bar[XB_TMO], 1u); break; } }
  }
  nloc = mine > 0u ? mine : 1u; nx = cnt > 0u ? cnt : 1u;
}
DI void xcd_barrier(const XcdBarrier& b) {
  asm volatile("s_waitcnt vmcnt(0)" ::: "memory");
  __syncthreads();
  if (threadIdx.x == 0) {
    unsigned* bar = b.bar;
    __builtin_amdgcn_s_waitcnt(0);
    unsigned nloc = b.st[0], nx = b.st[1];
    if (nloc == 0u) { xcd_barrier_complete(bar, b.x, nloc, nx); b.st[0] = nloc; b.st[1] = nx; }
    const unsigned old = xb_add(&bar[XB_XSUB(b.x)], 1u);
    const unsigned gen = old / nloc;
    if (old + 1u == (gen + 1u) * nloc) {
      __builtin_amdgcn_fence(__ATOMIC_RELEASE, "agent");
      asm volatile("s_waitcnt vmcnt(0)" ::: "memory");
      const unsigned og = xb_add(&bar[XB_TOP], 1u);
      const unsigned tg = og / nx;
      if (og + 1u == (tg + 1u) * nx) xb_add(&bar[XB_TOPGEN], 1u);
      else XB_SPIN(xb_ld(&bar[XB_TOPGEN]) == tg, bar);
      __builtin_amdgcn_fence(__ATOMIC_ACQUIRE, "agent");
      xb_add(&bar[XB_XGEN(b.x)], 1u);
      asm volatile("s_waitcnt vmcnt(0)" ::: "memory");
    } else {
      XB_SPIN(xb_ld(&bar[XB_XGEN(b.x)]) == gen, bar);
      __builtin_amdgcn_fence(__ATOMIC_ACQUIRE, "agent");
      asm volatile("s_waitcnt vmcnt(0)" ::: "memory");
    }
  }
  __syncthreads();
}
#ifndef DBL_MASK
#define DBL_MASK 0
#endif
#ifndef TIMING_PROBE
#define TIMING_PROBE 0
#endif
#ifndef TP_MASK_A
#define TP_MASK_A 0
#endif
#ifndef TP_MASK_B
#define TP_MASK_B 0
#endif
__global__ void __launch_bounds__(256, 2) mega_kernel(Params p, int ph_lo, int ph_hi) {
  if (ph_hi - ph_lo == 1) { run_phase(p, ph_lo); return; }
  cg::grid_group grid = cg::this_grid();
  volatile LAS unsigned* xst = (volatile LAS unsigned*)(g_smem + LDS_BYTES - 16);
  if (threadIdx.x == 0) { xst[0] = 0u; xst[1] = 0u; xst[2] = 0u; xst[3] = 0u; }
  __syncthreads();
  XcdBarrier xb = xcd_barrier_post((unsigned*)(p.ws + OFF_BAR), xst);
  for (int ph = ph_lo; ph < ph_hi; ++ph) {
    run_phase(p, ph);
#if DBL_MASK
    if (ph > 0 && ph < NPHASE - 1 && ((DBL_MASK >> ((ph - 1) % NPL)) & 1)) { xcd_barrier(xb); run_phase(p, ph); }
#endif
    if (ph + 1 < ph_hi) {
      if (ph == ph_lo) grid.sync();
      else xcd_barrier(xb);
    }
  }
}

extern "C" void kernel_launch(void* const* d_in, const int* in_sizes, int n_in, void* d_out, int out_size, void* d_ws, size_t ws_size,
                              hipStream_t stream) {
  static int grid_blocks = 0;
  if (!grid_blocks) {
    int dev = 0, cus = 0, per_cu = 0;
    hipGetDevice(&dev);
    hipDeviceGetAttribute(&cus, hipDeviceAttributeMultiprocessorCount, dev);
    hipFuncSetAttribute((const void*)mega_kernel, hipFuncAttributeMaxDynamicSharedMemorySize, LDS_BYTES);
    hipOccupancyMaxActiveBlocksPerMultiprocessor(&per_cu, mega_kernel, 256, LDS_BYTES);
    if (per_cu > 2) per_cu = 2;
    if (per_cu < 1) per_cu = 1;
    grid_blocks = cus * per_cu;
  }
  if (ws_size < WS_NEEDED) { fprintf(stderr, "workspace too small: %zu < %zu\n", ws_size, WS_NEEDED); return; }
  Params p{};
  for (int i = 0; i < 31; ++i) p.in[i] = (const float*)d_in[i];
  p.out = (float*)d_out;
  p.ws = (char*)d_ws;
#if MULTI_LAUNCH
  for (int ph = 0; ph < NPHASE; ++ph) {
    hipLaunchKernelGGL(mega_kernel, dim3(grid_blocks), dim3(256), LDS_BYTES, stream, p, ph, ph + 1);
  }
#else
  int lo = 0, hi = NPHASE;
  hipMemsetAsync((char*)d_ws + OFF_BAR, 0, 16384, stream);
  void* args[] = {&p, &lo, &hi};
  hipError_t e = hipLaunchCooperativeKernel((void*)mega_kernel, dim3(grid_blocks), dim3(256), args, LDS_BYTES, stream);
  if (e != hipSuccess) fprintf(stderr, "cooperative launch failed: %s (grid %d)\n", hipGetErrorString(e), grid_blocks);
#endif
}
```

```cpp
#include <hip/hip_runtime.h>
#include <hip/hip_cooperative_groups.h>
#include <cstdio>
namespace cg = cooperative_groups;

typedef unsigned short bfu;
using bf16x8 = __attribute__((ext_vector_type(8))) short;
using f32x4 = __attribute__((ext_vector_type(4))) float;
using u16x4 = __attribute__((ext_vector_type(4))) unsigned short;
using u16x8 = __attribute__((ext_vector_type(8))) unsigned short;
#define DI __device__ __forceinline__
#define MFMA16(a, b, c) __builtin_amdgcn_mfma_f32_16x16x32_bf16((a), (b), (c), 0, 0, 0)

#ifndef PH_MASK
#define PH_MASK 0xFFFFFF
#endif
#ifndef MULTI_LAUNCH
#define MULTI_LAUNCH 0
#endif

constexpr int TR = 32896;
constexpr int NCHK = 257;
constexpr int LBATCH = 16448;
constexpr int LDS_BYTES = 73728;
constexpr int NPL = 18;
constexpr int NPHASE = 1 + 4 * NPL + 1;

constexpr size_t OFF_H32 = 0;
constexpr size_t OFF_H16 = 134742016;
constexpr size_t OFF_Y = 202113024;
constexpr size_t OFF_P = 336855040;
constexpr size_t OFF_X = 471597056;
constexpr size_t OFF_SC = 623181824;
constexpr size_t OFF_PS = 627392512;
constexpr size_t OFF_W = 629497856;
constexpr size_t OFF_WIN = OFF_W;
constexpr size_t OFF_WS = OFF_WIN + 22020096;
constexpr size_t OFF_WGLU = OFF_WS + 32768;
constexpr size_t OFF_WB = OFF_WGLU + 1048576;
constexpr size_t OFF_WO = OFF_WB + 4194304;
constexpr size_t OFF_MS = OFF_WO + 2097152;
constexpr size_t OFF_MC = OFF_MS + 2097152;
constexpr size_t OFF_LB = OFF_MC + 6291456;
constexpr size_t OFF_LP = OFF_LB + 2048;
constexpr size_t OFF_BB = OFF_LP + 1114112;
constexpr size_t OFF_BAR = OFF_BB + 1048576;
constexpr size_t OFF_Z = OFF_BAR + 16384;
constexpr size_t WS_NEEDED = OFF_Z + 33685504;
constexpr size_t OFF_PZ = OFF_P;
constexpr size_t OFF_U2 = OFF_P + 33685504;
constexpr size_t OFF_YS5 = OFF_U2 + 35651584;
constexpr size_t OFF_XLOC = OFF_X;
constexpr size_t OFF_XST = OFF_X + 35651584;

struct Params {
  const float* in[31];
  float* out;
  char* ws;
};

extern __shared__ __attribute__((aligned(16))) char g_smem[];
DI int tid_laundered() { int t = threadIdx.x; asm volatile("" : "+v"(t)); return t; }
DI int bid_laundered() { int b = blockIdx.x; asm volatile("" : "+s"(b)); return b; }
#define TIDX tid_laundered()
#define BIDX bid_laundered()


DI bfu f2bf(float x) { unsigned u = __float_as_uint(x); u += 0x7fffu + ((u >> 16) & 1u); return (bfu)(u >> 16); }
DI float bf2f(bfu b) { return __uint_as_float(((unsigned)b) << 16); }
DI float sigm(float x) { return 1.f / (1.f + __expf(-x)); }
DI float siluf(float x) { return x / (1.f + __expf(-x)); }
DI float softplusf(float x) { return x > 20.f ? x : log1pf(expf(x)); }
DI float wave_sum(float v) {
#pragma unroll
  for (int m = 32; m >= 1; m >>= 1) v += __shfl_xor(v, m);
  return v;
}
DI float wave_scan_incl(float s, int lane) {
#pragma unroll
  for (int d = 1; d < 64; d <<= 1) { float o = __shfl_up(s, d); if (lane >= d) s += o; }
  return s;
}

template <int NREP>
DI void gemm_stage(const bfu* __restrict__ A, int lda, const bfu* __restrict__ Bt, int ldb, int kt, char* buf, int tid) {
#pragma unroll
  for (int i = 0; i < 2; ++i) {
    int b = tid * 16 + i * 4096; int r = b >> 6, c = (b & 63) >> 1;
    __builtin_amdgcn_global_load_lds((const unsigned*)(A + (long)r * lda + kt + c), (unsigned*)(buf + b), 16, 0, 0);
  }
#pragma unroll
  for (int i = 0; i < NREP / 2; ++i) {
    int b = tid * 16 + i * 4096; int r = b >> 6, c = (b & 63) >> 1;
    __builtin_amdgcn_global_load_lds((const unsigned*)(Bt + (long)r * ldb + kt + c), (unsigned*)(buf + 8192 + b), 16, 0, 0);
  }
}
template <int NREP>
DI void gemm_tile(f32x4 (&acc)[4][NREP], const bfu* __restrict__ A, int lda, const bfu* __restrict__ Bt, int ldb, int K) {
  const int tid = TIDX, lane = tid & 63, wid = tid >> 6, wr = wid >> 1, wc = wid & 1, fr = lane & 15, fq = lane >> 4;
  __syncthreads();
  gemm_stage<NREP>(A, lda, Bt, ldb, 0, g_smem, tid);
  int cur = 0;
  for (int kt = 0; kt < K; kt += 32) {
    asm volatile("s_waitcnt vmcnt(0)" ::: "memory");
    __syncthreads();
    if (kt + 32 < K) gemm_stage<NREP>(A, lda, Bt, ldb, kt + 32, g_smem + (cur ^ 1) * 16384, tid);
    const char* SA = g_smem + cur * 16384;
    const char* SB = SA + 8192;
    bf16x8 af[4], bfr[NREP];
#pragma unroll
    for (int m = 0; m < 4; ++m) af[m] = *(const bf16x8*)(SA + (wr * 64 + m * 16 + fr) * 64 + fq * 16);
#pragma unroll
    for (int n = 0; n < NREP; ++n) bfr[n] = *(const bf16x8*)(SB + (wc * (NREP * 16) + n * 16 + fr) * 64 + fq * 16);
#pragma unroll
    for (int m = 0; m < 4; ++m)
#pragma unroll
      for (int n = 0; n < NREP; ++n) acc[m][n] = MFMA16(af[m], bfr[n], acc[m][n]);
    cur ^= 1;
  }
}
template <int NREP>
DI void zero_acc(f32x4 (&acc)[4][NREP]) {
#pragma unroll
  for (int m = 0; m < 4; ++m)
#pragma unroll
    for (int n = 0; n < NREP; ++n) acc[m][n] = f32x4{0.f, 0.f, 0.f, 0.f};
}
#define ACC_FOREACH(NREP_, ...)                                                                \
  {                                                                                              \
    const int lane_ = TIDX & 63, wid_ = TIDX >> 6, wr_ = wid_ >> 1, wc_ = wid_ & 1; \
    const int fr_ = lane_ & 15, fq_ = lane_ >> 4;                                                \
    _Pragma("unroll") for (int m = 0; m < 4; ++m) _Pragma("unroll") for (int n = 0; n < NREP_; ++n) \
        _Pragma("unroll") for (int j = 0; j < 4; ++j) {                                          \
      const int trow = wr_ * 64 + m * 16 + fq_ * 4 + j;                                          \
      const int tcol = wc_ * (NREP_ * 16) + n * 16 + fr_;                                        \
      __VA_ARGS__                                                                                \
    }                                                                                            \
  }

DI void phase_tables(const Params& p) {
  const int gtid = BIDX * 256 + TIDX, gth = gridDim.x * 256;
  float2* LP = (float2*)(p.ws + OFF_LP);
  float2* BB = (float2*)(p.ws + OFF_BB);
  for (int idx = gtid; idx < 4 * 32 * 64; idx += gth) {
    int l = idx >> 11, g = (idx >> 6) & 31;
    float dt = expf(p.in[24][l * 32 + g]);
    float are = p.in[17][idx], aim = p.in[18][idx];
    float e1 = are * dt, a1 = aim * dt;
    for (int d = 0; d <= 16; ++d) {
      float mag = expf((float)d * e1), ang = (float)d * a1;
      LP[(long)idx * 17 + d] = make_float2(mag * cosf(ang), mag * sinf(ang));
    }
    float mag = expf(e1);
    float lre = mag * cosf(a1), lim = mag * sinf(a1);
    float den = are * are + aim * aim;
    float nr = lre - 1.f, ni = lim;
    float zre = (nr * are + ni * aim) / den, zim = (ni * are - nr * aim) / den;
    for (int c = 0; c < 16; ++c) {
      float bre = p.in[19][(long)idx * 16 + c], bim = p.in[20][(long)idx * 16 + c];
      BB[(long)idx * 16 + c] = make_float2(zre * bre - zim * bim, zre * bim + zim * bre);
    }
  }
}

DI void ln_rows(const Params& p, int layer, bool final_) {
  float* h32 = (float*)(p.ws + OFF_H32);
  bfu* h16 = (bfu*)(p.ws + OFF_H16);
  const int lane = TIDX & 63;
  const int gw = BIDX * 4 + (TIDX >> 6), nw = gridDim.x * 4;
  const float* gam = layer < 0 ? p.in[2] : p.in[29] + layer * 1024;
  const float* bet = layer < 0 ? p.in[3] : p.in[30] + layer * 1024;
  for (int r = gw; r < TR; r += nw) {
    int b = r / LBATCH, pos = r - b * LBATCH;
    float* d32 = h32 + (long)r * 1024;
    bfu* d16 = h16 + (long)r * 1024;
    if (pos < 48) {
      if (!final_) {
#pragma unroll
        for (int i = 0; i < 4; ++i) {
          *(float4*)(d32 + i * 256 + lane * 4) = make_float4(0.f, 0.f, 0.f, 0.f);
          *(u16x4*)(d16 + i * 256 + lane * 4) = u16x4{0, 0, 0, 0};
        }
      }
      continue;
    }
    const float* src;
    if (layer < 0) src = pos < 64 ? p.in[1] + (pos - 48) * 1024 : p.in[0] + ((long)b * 16384 + (pos - 64)) * 1024;
    else src = d32;
    float4 v[4];
    float s = 0.f;
#pragma unroll
    for (int i = 0; i < 4; ++i) { v[i] = *(const float4*)(src + i * 256 + lane * 4); s += v[i].x + v[i].y + v[i].z + v[i].w; }
    float mu = wave_sum(s) * (1.f / 1024.f);
    float q = 0.f;
#pragma unroll
    for (int i = 0; i < 4; ++i) {
      v[i].x -= mu; v[i].y -= mu; v[i].z -= mu; v[i].w -= mu;
      q += v[i].x * v[i].x + v[i].y * v[i].y + v[i].z * v[i].z + v[i].w * v[i].w;
    }
    float rs = rsqrtf(wave_sum(q) * (1.f / 1024.f) + 1e-5f);
#pragma unroll
    for (int i = 0; i < 4; ++i) {
      float4 g4 = *(const float4*)(gam + i * 256 + lane * 4), b4 = *(const float4*)(bet + i * 256 + lane * 4);
      float4 o = make_float4(v[i].x * rs * g4.x + b4.x, v[i].y * rs * g4.y + b4.y, v[i].z * rs * g4.z + b4.z, v[i].w * rs * g4.w + b4.w);
      if (final_) {
        if (pos >= 64) *(float4*)(p.out + ((long)b * 16384 + (pos - 64)) * 1024 + i * 256 + lane * 4) = o;
      } else {
        *(float4*)(d32 + i * 256 + lane * 4) = o;
        *(u16x4*)(d16 + i * 256 + lane * 4) = u16x4{f2bf(o.x), f2bf(o.y), f2bf(o.z), f2bf(o.w)};
      }
    }
  }
}

template <class F>
DI void conv_T(bfu* dst, int N, int K, F src) {
  const long gtid = BIDX * 256 + TIDX, gth = (long)gridDim.x * 256;
  const long total = (long)N * (K / 8);
  for (long idx = gtid; idx < total; idx += gth) {
    int n = (int)(idx % N); int kg = (int)(idx / N);
    u16x8 o;
#pragma unroll
    for (int j = 0; j < 8; ++j) o[j] = f2bf(src(kg * 8 + j, n));
    *(u16x8*)(dst + (long)n * K + kg * 8) = o;
  }
}

DI void phase_convert(const Params& p, int l) {
  const float* win = p.in[4] + (long)l * 1024 * 10768;
  conv_T((bfu*)(p.ws + OFF_WIN), 10752, 1024, [&](int k, int n) {
    int sc = n < 2048 ? n : n < 3584 ? n + 8 : n < 5632 ? n + 16 : n < 6656 ? n + 16 : n + 16;
    return win[(long)k * 10768 + sc];
  });
  conv_T((bfu*)(p.ws + OFF_WS), 16, 1024, [&](int k, int n) { int sc = n < 8 ? 2048 + n : 3592 + (n - 8); return win[(long)k * 10768 + sc]; });
  const float* w1 = p.in[25] + (long)l * 512 * 512;
  const float* w2 = p.in[26] + (long)l * 512 * 512;
  conv_T((bfu*)(p.ws + OFF_WGLU), 1024, 512, [&](int k, int r) {
    int j = r >> 7, wc = (r >> 6) & 1, n = (r >> 4) & 3, fr = r & 15;
    int oc = j * 64 + wc * 32 + (n & 1) * 16 + fr;
    return (n >> 1) ? w2[k * 512 + oc] : w1[k * 512 + oc];
  });
  const float* wb = p.in[27] + (long)l * 4 * 512 * 1024;
  conv_T((bfu*)(p.ws + OFF_WB), 4096, 512, [&](int k, int r) { int b = r >> 10, n = r & 1023; return wb[((long)b * 512 + k) * 1024 + n]; });
  const float* wo = p.in[28] + (long)l * 1024 * 1024;
  conv_T((bfu*)(p.ws + OFF_WO), 1024, 1024, [&](int k, int n) { return wo[(long)k * 1024 + n]; });
  const int gtid = BIDX * 256 + TIDX, gth = gridDim.x * 256;
  float* lbv = (float*)(p.ws + OFF_LB);
  for (int c = gtid; c < 512; c += gth) {
    float v0 = p.in[15][c], v1 = p.in[15][512 + c], v2 = p.in[15][1024 + c], v3 = p.in[15][1536 + c];
    float mx = fmaxf(fmaxf(v0, v1), fmaxf(v2, v3));
    float e0 = expf(v0 - mx), e1 = expf(v1 - mx), e2 = expf(v2 - mx), e3 = expf(v3 - mx);
    float inv = 1.f / (e0 + e1 + e2 + e3);
    float acc = 0.f;
    if (l >= 1) acc += e1 * inv;
    if (l >= 2) acc += e2 * inv;
    if (l >= 3) acc += e3 * inv;
    lbv[c] = acc;
  }
  const float2* LP = (const float2*)(p.ws + OFF_LP) + (long)l * 32 * 64 * 17;
  const float2* BB = (const float2*)(p.ws + OFF_BB) + (long)l * 32 * 64 * 16;
  const float* cre = p.in[21] + (long)l * 32 * 16 * 64;
  const float* cim = p.in[22] + (long)l * 32 * 16 * 64;
  const float* dd = p.in[23] + l * 512;
  bfu* Ms = (bfu*)(p.ws + OFF_MS);
  bfu* Mc = (bfu*)(p.ws + OFF_MC);
  for (int idx = gtid; idx < 32 * 128 * 256; idx += gth) {
    int g = idx >> 15, pp = (idx >> 8) & 127, kk = idx & 255;
    int s = kk >> 4, c2 = kk & 15, pr = pp & 63;
    float2 lp = LP[((long)g * 64 + pr) * 17 + (15 - s)];
    float2 bb = BB[((long)g * 64 + pr) * 16 + c2];
    float v = pp < 64 ? lp.x * bb.x - lp.y * bb.y : lp.x * bb.y + lp.y * bb.x;
    Ms[idx] = f2bf(v);
  }
  for (int idx = gtid; idx < 32 * 256 * 384; idx += gth) {
    int g = idx / (256 * 384); int rem = idx - g * (256 * 384);
    int o = rem / 384, kk = rem - o * 384;
    int t = o >> 4, c = o & 15;
    float v = 0.f;
    const float* cr = cre + ((long)g * 16 + c) * 64;
    const float* ci = cim + ((long)g * 16 + c) * 64;
    if (kk < 256) {
      int s = kk >> 4, c2 = kk & 15;
      if (t >= s) {
        int d = t - s;
        for (int pr = 0; pr < 64; ++pr) {
          float2 lp = LP[((long)g * 64 + pr) * 17 + d];
          float2 bb = BB[((long)g * 64 + pr) * 16 + c2];
          float ere = lp.x * bb.x - lp.y * bb.y, eim = lp.x * bb.y + lp.y * bb.x;
          v += cr[pr] * ere - ci[pr] * eim;
        }
        if (kk == o) v += dd[g * 16 + c];
      }
    } else {
      int pp = kk - 256, pr = pp & 63;
      float2 lp = LP[((long)g * 64 + pr) * 17 + (t + 1)];
      v = pp < 64 ? cr[pr] * lp.x - ci[pr] * lp.y : -(cr[pr] * lp.y + ci[pr] * lp.x);
    }
    Mc[idx] = f2bf(v);
  }
}

DI void phase_proj(const Params& p, int wrow0, int ncols, int mode, bool with_small, int boff) {
  const bfu* h16 = (const bfu*)(p.ws + OFF_H16);
  const bfu* WT = (const bfu*)(p.ws + OFF_WIN);
  bfu* P = (bfu*)(p.ws + OFF_P);
  bfu* U2 = (bfu*)(p.ws + OFF_U2);
  const int ntn = ncols >> 7;
  const int ntiles = 257 * ntn;
  const int total = ntiles + (with_small ? 257 : 0);
  for (int t = BIDX - boff; t < total; t += gridDim.x - boff) {
    if (t < ntiles) {
      int tm = t / ntn, tn = t - tm * ntn;
      f32x4 acc[4][4];
      zero_acc<4>(acc);
      gemm_tile<4>(acc, h16 + (long)tm * 128 * 1024, 1024, WT + (long)(wrow0 + tn * 128) * 1024, 1024, 1024);
      if (mode == 0) {
        ACC_FOREACH(4, { P[(long)(tm * 128 + trow) * ncols + tn * 128 + tcol] = f2bf(acc[m][n][j]); })
      } else {
        ACC_FOREACH(4, {
          int row = tm * 128 + trow, col = tn * 128 + tcol;
          if (col < 512) { int g = col >> 4, c2 = col & 15; U2[((long)g * 2176 + (row >> 4)) * 256 + (row & 15) * 16 + c2] = f2bf(acc[m][n][j]); }
          else P[(long)row * 512 + (col - 512)] = f2bf(acc[m][n][j]);
        })
      }
    } else {
      int tm = t - ntiles;
      const int lane = TIDX & 63, w = TIDX >> 6, fr = lane & 15, fq = lane >> 4;
      const bfu* WsT = (const bfu*)(p.ws + OFF_WS);
      float* Ps = (float*)(p.ws + OFF_PS);
      f32x4 a0 = {0.f, 0.f, 0.f, 0.f}, a1 = {0.f, 0.f, 0.f, 0.f};
      const bfu* pa0 = h16 + (long)(tm * 128 + w * 32 + fr) * 1024 + fq * 8;
      const bfu* pa1 = pa0 + 16 * 1024;
      const bfu* pb = WsT + fr * 1024 + fq * 8;
      for (int k = 0; k < 1024; k += 32) {
        bf16x8 x0 = *(const bf16x8*)(pa0 + k), x1 = *(const bf16x8*)(pa1 + k), y = *(const bf16x8*)(pb + k);
        a0 = MFMA16(x0, y, a0);
        a1 = MFMA16(x1, y, a1);
      }
#pragma unroll
      for (int j = 0; j < 4; ++j) {
        Ps[(long)(tm * 128 + w * 32 + fq * 4 + j) * 16 + fr] = a0[j];
        Ps[(long)(tm * 128 + w * 32 + 16 + fq * 4 + j) * 16 + fr] = a1[j];
      }
    }
  }
}

DI void copy_z(const Params& p, const bfu* src, int sld, bfu* dst, int pieces_per_row) {
  const int tid = TIDX;
  const int total = 64 * pieces_per_row;
  for (int i = tid; i < total; i += 256) {
    int r = i / pieces_per_row, c = i - r * pieces_per_row;
    *(u16x8*)(dst + (long)r * 512 + c * 8) = *(const u16x8*)(src + (long)r * sld + c * 8);
  }
}
DI void gdn_prep_item(const Params& p, int layer, int item) {
  const int tid = TIDX, lane = tid & 63, w = tid >> 6, fr = lane & 15, fq = lane >> 4;
  const int h = item & 3, cn = item >> 2, n = cn % NCHK;
  const long r0 = (long)cn * 64;
  const bfu* P = (const bfu*)(p.ws + OFF_P);
  const float* Ps = (const float*)(p.ws + OFF_PS);
  bfu* Xb = (bfu*)(p.ws + OFF_X) + (long)item * 36864;
  float* SC = (float*)(p.ws + OFF_SC) + (long)item * 256;
  bfu* rawQ = (bfu*)g_smem;
  bfu* rawK = rawQ + 64 * 136;
  bfu* rawV = rawK + 64 * 136;
  float* aL = (float*)(g_smem + 52224);
  float* sm = (float*)(g_smem + 69632);
  const float* cw = p.in[5] + layer * 4 * 1536;
  copy_z(p, P + r0 * 2048 + 1536 + h * 128, 2048, (bfu*)(p.ws + OFF_Z) + r0 * 512 + h * 128, 16);
  if (w < 3) {
    const int cgp = tid % 48, seg = tid / 48;
    const int which = cgp >> 4, c8 = (cgp & 15) * 8;
    const int col = which * 512 + h * 128 + c8;
    const int t0 = seg * 16;
    u16x8 xr[19];
    const bool nohist = (seg == 0 && n == 0);
#pragma unroll
    for (int i = 0; i < 19; ++i) {
      const bool valid = !(nohist && i < 3);
      const long rr = valid ? (r0 + t0 - 3 + i) : r0;
      u16x8 v = *(const u16x8*)(P + rr * 2048 + col);
      xr[i] = valid ? v : u16x8{0, 0, 0, 0, 0, 0, 0, 0};
    }
    float wt[4][8];
#pragma unroll
    for (int j = 0; j < 4; ++j) {
      float4 a4 = *(const float4*)(cw + j * 1536 + col), b4 = *(const float4*)(cw + j * 1536 + col + 4);
      wt[j][0] = a4.x; wt[j][1] = a4.y; wt[j][2] = a4.z; wt[j][3] = a4.w; wt[j][4] = b4.x; wt[j][5] = b4.y; wt[j][6] = b4.z; wt[j][7] = b4.w;
    }
    bfu* dst = rawQ + which * (64 * 136) + c8;
#pragma unroll
    for (int r = 0; r < 16; ++r) {
      u16x8 o;
#pragma unroll
      for (int c = 0; c < 8; ++c) {
        float v = wt[0][c] * bf2f(xr[r][c]) + wt[1][c] * bf2f(xr[r + 1][c]) + wt[2][c] * bf2f(xr[r + 2][c]) + wt[3][c] * bf2f(xr[r + 3][c]);
        o[c] = f2bf(siluf(v));
      }
      *(u16x8*)(dst + (t0 + r) * 136) = o;
    }
  }
  if (w == 3) {
    const float* ps = Ps + (r0 + lane) * 16;
    float be = sigm(ps[h]);
    float gl = -expf(p.in[6][layer * 4 + h]) * softplusf(ps[4 + h] + p.in[7][layer * 4 + h]);
    float s = wave_scan_incl(gl, lane);
    sm[128 + lane] = be;
    sm[192 + lane] = s;
  }
  __syncthreads();
  if (tid < 128) {
    int row = tid & 63, mat = tid >> 6;
    const bfu* rp = rawQ + mat * (64 * 136) + row * 136;
    float ss = 0.f;
    for (int c = 0; c < 128; ++c) { float v = bf2f(rp[c]); ss += v * v; }
    float sc = rsqrtf(ss + 1e-6f);
    if (mat == 0) sc *= 0.08838834764831845f;
    sm[mat * 64 + row] = sc;
  }
  __syncthreads();
  if (tid < 64) { float be = sm[128 + tid]; sm[256 + tid] = be; sm[320 + tid] = be * sm[64 + tid] * expf(sm[192 + tid]); }
  {
    bf16x8 kf[4], qf[4];
#pragma unroll
    for (int ks = 0; ks < 4; ++ks) {
      kf[ks] = *(const bf16x8*)(rawK + (16 * w + fr) * 136 + ks * 32 + fq * 8);
      qf[ks] = *(const bf16x8*)(rawQ + (16 * w + fr) * 136 + ks * 32 + fq * 8);
    }
    bfu* AMg = Xb + 32768;
    for (int tj = 0; tj < 4; ++tj) {
      if (tj <= w) {
        f32x4 akk = {0.f, 0.f, 0.f, 0.f}, aqk = {0.f, 0.f, 0.f, 0.f};
#pragma unroll
        for (int ks = 0; ks < 4; ++ks) {
          bf16x8 bk = *(const bf16x8*)(rawK + (16 * tj + fr) * 136 + ks * 32 + fq * 8);
          akk = MFMA16(kf[ks], bk, akk);
          aqk = MFMA16(qf[ks], bk, aqk);
        }
        int j = 16 * tj + fr;
        float rkj = sm[64 + j], gcj = sm[192 + j];
#pragma unroll
        for (int r = 0; r < 4; ++r) {
          int i = 16 * w + fq * 4 + r;
          float dec = (i >= j) ? expf(sm[192 + i] - gcj) : 0.f;
          aL[i * 68 + j] = (i > j) ? sm[128 + i] * sm[64 + i] * rkj * akk[r] * dec : 0.f;
          AMg[i * 64 + j] = f2bf((i >= j) ? sm[i] * rkj * aqk[r] * dec : 0.f);
        }
      } else {
#pragma unroll
        for (int r = 0; r < 4; ++r) AMg[(16 * w + fq * 4 + r) * 64 + 16 * tj + fr] = 0;
      }
    }
  }
  __syncthreads();
  {
    const bfu* src = (tid < 128) ? (rawV + tid) : (rawK + (tid - 128));
    const float* rs = sm + ((tid < 128) ? 256 : 320);
    float x[64];
#pragma unroll
    for (int i = 0; i < 64; ++i) {
      float a = bf2f(src[i * 136]) * rs[i];
#pragma unroll
      for (int j = 0; j < i; ++j) a -= aL[i * 68 + j] * x[j];
      x[i] = a;
    }
    if (tid < 128) {
      bfu* UT = Xb + 24576 + tid * 64;
#pragma unroll
      for (int i = 0; i < 64; i += 8) {
        u16x8 o;
#pragma unroll
        for (int j = 0; j < 8; ++j) o[j] = f2bf(x[i + j]);
        *(u16x8*)(UT + i) = o;
      }
    } else {
      bfu* Wg = Xb + 8192 + (tid - 128);
#pragma unroll
      for (int i = 0; i < 64; ++i) Wg[i * 128] = f2bf(x[i]);
    }
  }
  {
    bfu* QDg = Xb;
    bfu* KDTg = Xb + 16384;
    float gl_last = sm[192 + 63];
    for (int idx = tid; idx < 8192; idx += 256) { int i = idx >> 7, c = idx & 127; QDg[idx] = f2bf(bf2f(rawQ[i * 136 + c]) * sm[i] * expf(sm[192 + i])); }
    for (int idx = tid; idx < 8192; idx += 256) { int c = idx >> 6, i = idx & 63; KDTg[idx] = f2bf(bf2f(rawK[i * 136 + c]) * sm[64 + i] * expf(gl_last - sm[192 + i])); }
    if (tid < 128) SC[128 + tid] = expf(gl_last);
  }
  __syncthreads();
}

DI void ssd_prep_item(const Params& p, int layer, int item) {
  const int tid = TIDX, lane = tid & 63, w = tid >> 6, fr = lane & 15, fq = lane >> 4;
  const int g = item & 1, cn = item >> 1, n = cn % NCHK;
  const long r0 = (long)cn * 64;
  const bfu* P = (const bfu*)(p.ws + OFF_P);
  const float* Ps = (const float*)(p.ws + OFF_PS);
  bfu* Xb = (bfu*)(p.ws + OFF_X) + (long)cn * 131072;
  float* SCb = (float*)(p.ws + OFF_SC) + (long)cn * 8 * 256;
  bfu* Bm = (bfu*)g_smem;
  bfu* Cm = Bm + 64 * 136;
  float* cb = (float*)(g_smem + 34816);
  float* sm = (float*)(g_smem + 34816 + 17408);
  {
    int hd = g * 4 + w;
    float dtv = softplusf(Ps[(r0 + lane) * 16 + 8 + hd] + p.in[11][layer * 8 + hd]);
    float a = -dtv * expf(p.in[12][layer * 8 + hd]);
    float ac = wave_scan_incl(a, lane);
    sm[w * 64 + lane] = dtv;
    sm[256 + w * 64 + lane] = ac;
  }
  __syncthreads();
  const float* cw = p.in[9] + layer * 4 * 1024;
  const float* cbias = p.in[10] + layer * 1024;
  copy_z(p, P + r0 * 1536 + 1024 + g * 256, 1536, (bfu*)(p.ws + OFF_Z) + r0 * 512 + g * 256, 32);
  {
    const int cg8 = tid & 63, seg = tid >> 6, t0 = seg * 16;
    const int col = (cg8 < 16) ? 512 + g * 128 + cg8 * 8 : (cg8 < 32) ? 768 + g * 128 + (cg8 - 16) * 8 : g * 256 + (cg8 - 32) * 8;
    u16x8 xr[19];
    const bool nohist = (seg == 0 && n == 0);
#pragma unroll
    for (int i = 0; i < 19; ++i) {
      const bool valid = !(nohist && i < 3);
      const long rr = valid ? (r0 + t0 - 3 + i) : r0;
      u16x8 v = *(const u16x8*)(P + rr * 1536 + col);
      xr[i] = valid ? v : u16x8{0, 0, 0, 0, 0, 0, 0, 0};
    }
    float wt[4][8], bias[8];
#pragma unroll
    for (int j = 0; j < 4; ++j) {
      float4 a4 = *(const float4*)(cw + j * 1024 + col), b4 = *(const float4*)(cw + j * 1024 + col + 4);
      wt[j][0] = a4.x; wt[j][1] = a4.y; wt[j][2] = a4.z; wt[j][3] = a4.w; wt[j][4] = b4.x; wt[j][5] = b4.y; wt[j][6] = b4.z; wt[j][7] = b4.w;
    }
    {
      float4 a4 = *(const float4*)(cbias + col), b4 = *(const float4*)(cbias + col + 4);
      bias[0] = a4.x; bias[1] = a4.y; bias[2] = a4.z; bias[3] = a4.w; bias[4] = b4.x; bias[5] = b4.y; bias[6] = b4.z; bias[7] = b4.w;
    }
    if (cg8 < 32) {
      bfu* dst = (cg8 < 16) ? (Bm + cg8 * 8) : (Cm + (cg8 - 16) * 8);
#pragma unroll
      for (int r = 0; r < 16; ++r) {
        u16x8 o;
        const bool padrow = (n == 0 && t0 + r < 48);
#pragma unroll
        for (int c = 0; c < 8; ++c) {
          float v = wt[0][c] * bf2f(xr[r][c]) + wt[1][c] * bf2f(xr[r + 1][c]) + wt[2][c] * bf2f(xr[r + 2][c]) + wt[3][c] * bf2f(xr[r + 3][c]) + bias[c];
          o[c] = padrow ? (bfu)0 : f2bf(siluf(v));
        }
        *(u16x8*)(dst + (t0 + r) * 136) = o;
      }
    } else {
      const int hh = (cg8 - 32) >> 3, pp8 = ((cg8 - 32) & 7) * 8;
      bfu* vtb = Xb + 32768 + (g * 4 + hh) * 12288 + 4096;
      const float alast = sm[256 + hh * 64 + 63];
#pragma unroll
      for (int q4 = 0; q4 < 4; ++q4) {
        float dtv[4], ksv[4];
#pragma unroll
        for (int rr = 0; rr < 4; ++rr) {
          int t = t0 + q4 * 4 + rr;
          const bool padrow = (n == 0 && t < 48);
          dtv[rr] = padrow ? 0.f : sm[hh * 64 + t];
          ksv[rr] = expf(alast - sm[256 + hh * 64 + t]);
        }
#pragma unroll
        for (int c = 0; c < 8; ++c) {
          u16x4 oa, ob;
#pragma unroll
          for (int rr = 0; rr < 4; ++rr) {
            int r = q4 * 4 + rr;
            float v = wt[0][c] * bf2f(xr[r][c]) + wt[1][c] * bf2f(xr[r + 1][c]) + wt[2][c] * bf2f(xr[r + 2][c]) + wt[3][c] * bf2f(xr[r + 3][c]) + bias[c];
            float xd = siluf(v) * dtv[rr];
            oa[rr] = f2bf(xd);
            ob[rr] = f2bf(xd * ksv[rr]);
          }
          *(u16x4*)(vtb + (pp8 + c) * 64 + t0 + q4 * 4) = oa;
          *(u16x4*)(vtb + 4096 + (pp8 + c) * 64 + t0 + q4 * 4) = ob;
        }
      }
    }
  }
  __syncthreads();
  {
    bf16x8 cf[4];
#pragma unroll
    for (int ks = 0; ks < 4; ++ks) cf[ks] = *(const bf16x8*)(Cm + (16 * w + fr) * 136 + ks * 32 + fq * 8);
    for (int tj = 0; tj < 4; ++tj) {
      if (tj <= w) {
        f32x4 a = {0.f, 0.f, 0.f, 0.f};
#pragma unroll
        for (int ks = 0; ks < 4; ++ks) {
          bf16x8 bk = *(const bf16x8*)(Bm + (16 * tj + fr) * 136 + ks * 32 + fq * 8);
          a = MFMA16(cf[ks], bk, a);
        }
#pragma unroll
        for (int r = 0; r < 4; ++r) cb[(16 * w + fq * 4 + r) * 68 + 16 * tj + fr] = a[r];
      }
    }
    bfu* Cg = Xb + g * 16384;
    bfu* BTg = Cg + 8192;
    for (int idx = tid; idx < 8192; idx += 256) Cg[idx] = Cm[(idx >> 7) * 136 + (idx & 127)];
    for (int idx = tid; idx < 8192; idx += 256) BTg[idx] = Bm[(idx & 63) * 136 + (idx >> 6)];
  }
  __syncthreads();
  for (int hh = 0; hh < 4; ++hh) {
    int hd = g * 4 + hh;
    bfu* AMg = Xb + 32768 + hd * 12288;
    float Dh = p.in[13][layer * 8 + hd];
    const float* dtp = sm + hh * 64;
    const float* acp = sm + 256 + hh * 64;
    for (int idx = tid; idx < 4096; idx += 256) {
      int l = idx >> 6, m = idx & 63;
      float v = (m <= l) ? cb[l * 68 + m] * expf(acp[l] - acp[m]) : 0.f;
      if (m == l) v += Dh / dtp[l];
      AMg[idx] = f2bf(v);
    }
    float* sc = SCb + hd * 256;
    float alast = acp[63];
    if (tid < 64) { sc[tid] = expf(acp[tid]); sc[64 + tid] = expf(alast - acp[tid]); }
    else if (tid < 192) sc[128 + (tid - 64)] = expf(alast);
  }
  __syncthreads();
}

DI void hg_prep_item(const Params& p, int layer, int item) {
  const int tid = TIDX, lane = tid & 63, w = tid >> 6, fr = lane & 15, fq = lane >> 4;
  const int h = item & 3, cn = item >> 2;
  const long r0 = (long)cn * 64;
  const bfu* P = (const bfu*)(p.ws + OFF_P);
  const float* lbv = (const float*)(p.ws + OFF_LB);
  bfu* Xb = (bfu*)(p.ws + OFF_X) + (long)item * 28672;
  float* SC = (float*)(p.ws + OFF_SC) + (long)item * 256;
  bfu* Qall = (bfu*)g_smem;
  bfu* Ks = Qall + 160 * 136;
  float* segs = (float*)(g_smem + 60928);
  bfu* QDg = Xb;
  bfu* KDTg = Xb + 8192;
  bfu* AMg = Xb + 16384;
  bfu* VTg = Xb + 20480;
  copy_z(p, P + r0 * 2048 + 1536 + h * 128, 2048, (bfu*)(p.ws + OFF_Z) + r0 * 512 + h * 128, 16);
  {
    const int k8 = (tid & 15) * 8, rs = tid >> 4, t0 = rs * 4;
    u16x8 fr4[4], qr4[4], ir4[4];
    const bfu* base = P + (r0 + t0) * 2048 + h * 128 + k8;
#pragma unroll
    for (int r = 0; r < 4; ++r) {
      qr4[r] = *(const u16x8*)(base + (long)r * 2048);
      fr4[r] = *(const u16x8*)(base + (long)r * 2048 + 512);
      ir4[r] = *(const u16x8*)(base + (long)r * 2048 + 1024);
    }
    float lb[8];
    {
      float4 a4 = *(const float4*)(lbv + h * 128 + k8), b4 = *(const float4*)(lbv + h * 128 + k8 + 4);
      lb[0] = a4.x; lb[1] = a4.y; lb[2] = a4.z; lb[3] = a4.w; lb[4] = b4.x; lb[5] = b4.y; lb[6] = b4.z; lb[7] = b4.w;
    }
    float lf[4][8];
    float ssum[8];
#pragma unroll
    for (int c = 0; c < 8; ++c) ssum[c] = 0.f;
#pragma unroll
    for (int r = 0; r < 4; ++r)
#pragma unroll
      for (int c = 0; c < 8; ++c) {
        float zf = bf2f(fr4[r][c]);
        float f = lb[c] + (1.f - lb[c]) * (1.f / (1.f + expf(-zf)));
        lf[r][c] = logf(f);
        ssum[c] += lf[r][c];
      }
    *(float4*)(segs + rs * 128 + k8) = make_float4(ssum[0], ssum[1], ssum[2], ssum[3]);
    *(float4*)(segs + rs * 128 + k8 + 4) = make_float4(ssum[4], ssum[5], ssum[6], ssum[7]);
#pragma unroll
    for (int c = 0; c < 8; ++c) {
      u16x4 o = {ir4[0][c], ir4[1][c], ir4[2][c], ir4[3][c]};
      *(u16x4*)(VTg + (k8 + c) * 64 + t0) = o;
    }
    __syncthreads();
    float Gb[8], G1[8], G2[8], G3[8], GL[8];
#pragma unroll
    for (int c = 0; c < 8; ++c) { Gb[c] = 0.f; G1[c] = 0.f; G2[c] = 0.f; G3[c] = 0.f; GL[c] = 0.f; }
    for (int s2 = 0; s2 < 16; ++s2) {
      float4 a4 = *(const float4*)(segs + s2 * 128 + k8), b4 = *(const float4*)(segs + s2 * 128 + k8 + 4);
      float v[8] = {a4.x, a4.y, a4.z, a4.w, b4.x, b4.y, b4.z, b4.w};
#pragma unroll
      for (int c = 0; c < 8; ++c) {
        if (s2 < rs) Gb[c] += v[c];
        if (s2 < 4) G1[c] += v[c];
        if (s2 < 8) G2[c] += v[c];
        if (s2 < 12) G3[c] += v[c];
        GL[c] += v[c];
      }
    }
    const int Jt = rs >> 2;
    float G[8];
#pragma unroll
    for (int c = 0; c < 8; ++c) G[c] = Gb[c];
#pragma unroll
    for (int r = 0; r < 4; ++r) {
      const int t = t0 + r;
      u16x8 oq, oq1, oq2, oq3, ok;
#pragma unroll
      for (int c = 0; c < 8; ++c) {
        G[c] += lf[r][c];
        float zf = bf2f(fr4[r][c]);
        float kk = (1.f - lb[c]) * (1.f / (1.f + expf(zf)));
        float q = siluf(bf2f(qr4[r][c]));
        oq[c] = f2bf(q * expf(G[c]));
        oq1[c] = f2bf(q * expf(G[c] - G1[c]));
        oq2[c] = f2bf(q * expf(G[c] - G2[c]));
        oq3[c] = f2bf(q * expf(G[c] - G3[c]));
        float GJ = (Jt == 0) ? 0.f : (Jt == 1) ? G1[c] : (Jt == 2) ? G2[c] : G3[c];
        ok[c] = f2bf(kk * expf(fminf(GJ - G[c], 80.f)));
      }
      *(u16x8*)(QDg + t * 128 + k8) = oq;
      *(u16x8*)(Qall + t * 136 + k8) = oq;
      if (t >= 16) *(u16x8*)(Qall + (64 + t - 16) * 136 + k8) = oq1;
      if (t >= 32) *(u16x8*)(Qall + (112 + t - 32) * 136 + k8) = oq2;
      if (t >= 48) *(u16x8*)(Qall + (144 + t - 48) * 136 + k8) = oq3;
      *(u16x8*)(Ks + t * 136 + k8) = ok;
    }
#pragma unroll
    for (int c = 0; c < 8; ++c) {
      float Gc = Gb[c];
      u16x4 o;
#pragma unroll
      for (int r = 0; r < 4; ++r) {
        Gc += lf[r][c];
        float zf = bf2f(fr4[r][c]);
        float kk = (1.f - lb[c]) * (1.f / (1.f + expf(zf)));
        o[r] = f2bf(kk * expf(GL[c] - Gc));
      }
      *(u16x4*)(KDTg + (k8 + c) * 64 + t0) = o;
    }
    if (rs == 0) {
#pragma unroll
      for (int c = 0; c < 8; ++c) SC[128 + k8 + c] = expf(GL[c]);
    }
  }
  __syncthreads();
  for (int J = 0; J < 4; ++J) {
    if (J <= w) {
      int rowbase = (J == 0 ? 0 : J == 1 ? 64 : J == 2 ? 112 : 144) + 16 * (w - J);
      f32x4 a = {0.f, 0.f, 0.f, 0.f};
#pragma unroll
      for (int ks = 0; ks < 4; ++ks) {
        bf16x8 af = *(const bf16x8*)(Qall + (rowbase + fr) * 136 + ks * 32 + fq * 8);
        bf16x8 bk = *(const bf16x8*)(Ks + (16 * J + fr) * 136 + ks * 32 + fq * 8);
        a = MFMA16(af, bk, a);
      }
#pragma unroll
      for (int r = 0; r < 4; ++r) {
        int t = 16 * w + fq * 4 + r, s = 16 * J + fr;
        AMg[t * 64 + s] = f2bf((s <= t) ? a[r] : 0.f);
      }
    } else {
#pragma unroll
      for (int r = 0; r < 4; ++r) AMg[(16 * w + fq * 4 + r) * 64 + 16 * J + fr] = 0;
    }
  }
  __syncthreads();
}

struct LinArgs {
  const bfu* kdt; long kdt_cs;
  const bfu* vt; long vt_cs;
  const float* sc; long sc_cs;
  bfu* ss; long ss_cs;
};
struct LinFrags { bf16x8 kf[2][2]; bf16x8 vf[2][2]; f32x4 dv[2]; };
DI void lin_load(LinFrags& f, const LinArgs& e, int n, int w, int fr, int fq) {
#pragma unroll
  for (int a = 0; a < 2; ++a)
#pragma unroll
    for (int ks = 0; ks < 2; ++ks) f.kf[a][ks] = *(const bf16x8*)(e.kdt + n * e.kdt_cs + ((2 * w + a) * 16 + fr) * 64 + ks * 32 + fq * 8);
#pragma unroll
  for (int jv = 0; jv < 2; ++jv)
#pragma unroll
    for (int ks = 0; ks < 2; ++ks) f.vf[jv][ks] = *(const bf16x8*)(e.vt + n * e.vt_cs + (jv * 16 + fr) * 64 + ks * 32 + fq * 8);
#pragma unroll
  for (int a = 0; a < 2; ++a) f.dv[a] = *(const f32x4*)(e.sc + n * e.sc_cs + 128 + (2 * w + a) * 16 + fq * 4);
}
template <int NST>
DI void engine_lin(const LinArgs& e) {
  const int tid = TIDX, lane = tid & 63, w = tid >> 6, fr = lane & 15, fq = lane >> 4;
  f32x4 S[2][2];
#pragma unroll
  for (int a = 0; a < 2; ++a)
#pragma unroll
    for (int jv = 0; jv < 2; ++jv) S[a][jv] = f32x4{0.f, 0.f, 0.f, 0.f};
  LinFrags f[NST];
#pragma unroll
  for (int s = 0; s < NST - 1; ++s) lin_load(f[s], e, s, w, fr, fq);
  for (int n0 = 0; n0 < NCHK; n0 += NST) {
#pragma unroll
    for (int s = 0; s < NST; ++s) {
      const int n = n0 + s;
      if (n < NCHK) {
        int nl = n + NST - 1; if (nl > NCHK - 1) nl = NCHK - 1;
        lin_load(f[(s + NST - 1) % NST], e, nl, w, fr, fq);
        const LinFrags& c = f[s];
#pragma unroll
        for (int a = 0; a < 2; ++a)
#pragma unroll
          for (int jv = 0; jv < 2; ++jv) {
            u16x4 pk = {f2bf(S[a][jv][0]), f2bf(S[a][jv][1]), f2bf(S[a][jv][2]), f2bf(S[a][jv][3])};
            *(u16x4*)(e.ss + n * e.ss_cs + (jv * 16 + fr) * 128 + (2 * w + a) * 16 + fq * 4) = pk;
          }
#pragma unroll
        for (int a = 0; a < 2; ++a) {
#pragma unroll
          for (int jv = 0; jv < 2; ++jv)
#pragma unroll
            for (int r = 0; r < 4; ++r) S[a][jv][r] *= c.dv[a][r];
#pragma unroll
          for (int ks = 0; ks < 2; ++ks)
#pragma unroll
            for (int jv = 0; jv < 2; ++jv) S[a][jv] = MFMA16(c.kf[a][ks], c.vf[jv][ks], S[a][jv]);
        }
      }
    }
  }
}

struct GdnArgs {
  const bfu* w; const bfu* kdt; bfu* ut; long cs;
  const float* sc; long sc_cs;
  bfu* ss; long ss_cs;
};
struct GdnFrags { bf16x8 wf[4]; bf16x8 kf[2][2]; u16x4 v[2]; float dv; };
DI void gdn_load(GdnFrags& f, const GdnArgs& e, int n, int w, int fr, int fq) {
#pragma unroll
  for (int ks = 0; ks < 4; ++ks) f.wf[ks] = *(const bf16x8*)(e.w + n * e.cs + (16 * w + fr) * 128 + ks * 32 + fq * 8);
#pragma unroll
  for (int a = 0; a < 2; ++a)
#pragma unroll
    for (int ks = 0; ks < 2; ++ks) f.kf[a][ks] = *(const bf16x8*)(e.kdt + n * e.cs + ((2 * w + a) * 16 + fr) * 64 + ks * 32 + fq * 8);
#pragma unroll
  for (int jv = 0; jv < 2; ++jv) f.v[jv] = *(const u16x4*)(e.ut + n * e.cs + (jv * 16 + fr) * 64 + 16 * w + fq * 4);
  f.dv = e.sc[n * e.sc_cs + 128];
}
template <int NST>
DI void engine_gdn(const GdnArgs& e) {
  const int tid = TIDX, lane = tid & 63, w = tid >> 6, fr = lane & 15, fq = lane >> 4;
  char* VT = g_smem + 17408;
  f32x4 S[2][2];
#pragma unroll
  for (int a = 0; a < 2; ++a)
#pragma unroll
    for (int jv = 0; jv < 2; ++jv) S[a][jv] = f32x4{0.f, 0.f, 0.f, 0.f};
  GdnFrags f[NST];
#pragma unroll
  for (int s = 0; s < NST - 1; ++s) gdn_load(f[s], e, s, w, fr, fq);
  for (int n0 = 0; n0 < NCHK; n0 += NST) {
#pragma unroll
    for (int s = 0; s < NST; ++s) {
      const int n = n0 + s;
      if (n < NCHK) {
        int nl = n + NST - 1; if (nl > NCHK - 1) nl = NCHK - 1;
        gdn_load(f[(s + NST - 1) % NST], e, nl, w, fr, fq);
        const GdnFrags& c = f[s];
        char* STc = g_smem + (n & 1) * 8704;
#pragma unroll
        for (int a = 0; a < 2; ++a)
#pragma unroll
          for (int jv = 0; jv < 2; ++jv) {
            u16x4 pk = {f2bf(S[a][jv][0]), f2bf(S[a][jv][1]), f2bf(S[a][jv][2]), f2bf(S[a][jv][3])};
            *(u16x4*)(STc + ((jv * 16 + fr) * 136 + (2 * w + a) * 16 + fq * 4) * 2) = pk;
            *(u16x4*)(e.ss + n * e.ss_cs + (jv * 16 + fr) * 128 + (2 * w + a) * 16 + fq * 4) = pk;
          }
        __syncthreads();
        f32x4 av[2] = {f32x4{0.f, 0.f, 0.f, 0.f}, f32x4{0.f, 0.f, 0.f, 0.f}};
#pragma unroll
        for (int ks = 0; ks < 4; ++ks)
#pragma unroll
          for (int jv = 0; jv < 2; ++jv) {
            bf16x8 sf = *(const bf16x8*)(STc + ((jv * 16 + fr) * 136 + ks * 32 + fq * 8) * 2);
            av[jv] = MFMA16(c.wf[ks], sf, av[jv]);
          }
#pragma unroll
        for (int jv = 0; jv < 2; ++jv) {
          u16x4 pk;
#pragma unroll
          for (int r = 0; r < 4; ++r) pk[r] = f2bf(bf2f(c.v[jv][r]) - av[jv][r]);
          *(u16x4*)(VT + ((jv * 16 + fr) * 72 + 16 * w + fq * 4) * 2) = pk;
          *(u16x4*)(e.ut + n * e.cs + (jv * 16 + fr) * 64 + 16 * w + fq * 4) = pk;
        }
        __syncthreads();
#pragma unroll
        for (int a = 0; a < 2; ++a) {
#pragma unroll
          for (int jv = 0; jv < 2; ++jv)
#pragma unroll
            for (int r = 0; r < 4; ++r) S[a][jv][r] *= c.dv;
#pragma unroll
          for (int ks = 0; ks < 2; ++ks)
#pragma unroll
            for (int jv = 0; jv < 2; ++jv) {
              bf16x8 vf = *(const bf16x8*)(VT + ((jv * 16 + fr) * 72 + ks * 32 + fq * 8) * 2);
              S[a][jv] = MFMA16(c.kf[a][ks], vf, S[a][jv]);
            }
        }
      }
    }
  }
  __syncthreads();
}

template <int NVT, bool USE_RS>
DI void oproj_core(f32x4 (&acc)[NVT], const bfu* qd, const bfu* am, const bfu* st, const bfu* vt, const float* rsp, int w, int fr, int fq) {
#pragma unroll
  for (int jv = 0; jv < NVT; ++jv) acc[jv] = f32x4{0.f, 0.f, 0.f, 0.f};
#pragma unroll
  for (int ks = 0; ks < 4; ++ks) {
    bf16x8 qf = *(const bf16x8*)(qd + (16 * w + fr) * 128 + ks * 32 + fq * 8);
#pragma unroll
    for (int jv = 0; jv < NVT; ++jv) {
      bf16x8 sf = *(const bf16x8*)(st + (jv * 16 + fr) * 128 + ks * 32 + fq * 8);
      acc[jv] = MFMA16(qf, sf, acc[jv]);
    }
  }
  if (USE_RS) {
    f32x4 rs = *(const f32x4*)(rsp + 16 * w + fq * 4);
#pragma unroll
    for (int jv = 0; jv < NVT; ++jv)
#pragma unroll
      for (int r = 0; r < 4; ++r) acc[jv][r] *= rs[r];
  }
#pragma unroll
  for (int ks = 0; ks < 2; ++ks) {
    bf16x8 af = *(const bf16x8*)(am + (16 * w + fr) * 64 + ks * 32 + fq * 8);
#pragma unroll
    for (int jv = 0; jv < NVT; ++jv) {
      bf16x8 vf = *(const bf16x8*)(vt + (jv * 16 + fr) * 64 + ks * 32 + fq * 8);
      acc[jv] = MFMA16(af, vf, acc[jv]);
    }
  }
}
DI void oproj_head128(const bfu* qd, const bfu* am, const bfu* st, const bfu* vt, const bfu* zP, int zld, const float* nw, bfu* Yo) {
  const int tid = TIDX, lane = tid & 63, w = tid >> 6, fr = lane & 15, fq = lane >> 4;
  f32x4 acc[8];
  oproj_core<8, false>(acc, qd, am, st, vt, nullptr, w, fr, fq);
  float ss[4] = {0.f, 0.f, 0.f, 0.f};
#pragma unroll
  for (int jv = 0; jv < 8; ++jv)
#pragma unroll
    for (int r = 0; r < 4; ++r) ss[r] += acc[jv][r] * acc[jv][r];
#pragma unroll
  for (int r = 0; r < 4; ++r) {
    float s = ss[r];
    s += __shfl_xor(s, 1); s += __shfl_xor(s, 2); s += __shfl_xor(s, 4); s += __shfl_xor(s, 8);
    ss[r] = rsqrtf(s * (1.f / 128.f) + 1e-6f);
  }
#pragma unroll
  for (int jv = 0; jv < 8; ++jv) {
    float wv = nw[jv * 16 + fr];
#pragma unroll
    for (int r = 0; r < 4; ++r) {
      int tok = 16 * w + fq * 4 + r;
      float z = bf2f(zP[(long)tok * zld + jv * 16 + fr]);
      Yo[(long)tok * 512 + jv * 16 + fr] = f2bf(acc[jv][r] * ss[r] * wv * siluf(z));
    }
  }
}
DI void oproj_ssd(const bfu* Xb  , int g, const float* SCb, const bfu* SSb, const bfu* zP, const float* nw, bfu* Yo) {
  const int tid = TIDX, lane = tid & 63, w = tid >> 6, fr = lane & 15, fq = lane >> 4;
  f32x4 acc[4][4];
#pragma unroll
  for (int hh = 0; hh < 4; ++hh) {
    int hd = g * 4 + hh;
    oproj_core<4, true>(acc[hh], Xb + g * 16384, Xb + 32768 + hd * 12288, SSb + hd * 8192, Xb + 32768 + hd * 12288 + 4096, SCb + hd * 256, w, fr, fq);
  }
  float ss[4] = {0.f, 0.f, 0.f, 0.f};
#pragma unroll
  for (int hh = 0; hh < 4; ++hh)
#pragma unroll
    for (int jv = 0; jv < 4; ++jv)
#pragma unroll
      for (int r = 0; r < 4; ++r) {
        int tok = 16 * w + fq * 4 + r;
        float z = bf2f(zP[(long)tok * 512 + hh * 64 + jv * 16 + fr]);
        float y = acc[hh][jv][r] * siluf(z);
        acc[hh][jv][r] = y;
        ss[r] += y * y;
      }
#pragma unroll
  for (int r = 0; r < 4; ++r) {
    float s = ss[r];
    s += __shfl_xor(s, 1); s += __shfl_xor(s, 2); s += __shfl_xor(s, 4); s += __shfl_xor(s, 8);
    ss[r] = rsqrtf(s * (1.f / 256.f) + 1e-6f);
  }
#pragma unroll
  for (int hh = 0; hh < 4; ++hh)
#pragma unroll
    for (int jv = 0; jv < 4; ++jv) {
      float wv = nw[hh * 64 + jv * 16 + fr];
#pragma unroll
      for (int r = 0; r < 4; ++r) {
        int tok = 16 * w + fq * 4 + r;
        Yo[(long)tok * 512 + hh * 64 + jv * 16 + fr] = f2bf(acc[hh][jv][r] * ss[r] * wv);
      }
    }
}

DI float geluf(float x) { float u = 0.7978845608028654f * (x + 0.044715f * x * x * x); return 0.5f * x * (1.f + tanhf(u)); }

DI void phase_s5_gemm1(const Params& p) {
  const bfu* U2 = (const bfu*)(p.ws + OFF_U2);
  const bfu* Ms = (const bfu*)(p.ws + OFF_MS);
  float* Xloc = (float*)(p.ws + OFF_XLOC);
  for (int t = BIDX; t < 32 * 17; t += gridDim.x) {
    int g = t / 17, tm = t - g * 17;
    f32x4 acc[4][4];
    zero_acc<4>(acc);
    gemm_tile<4>(acc, U2 + ((long)g * 2176 + tm * 128) * 256, 256, Ms + (long)g * 128 * 256, 256, 256);
    ACC_FOREACH(4, { Xloc[((long)g * 2176 + tm * 128 + trow) * 128 + tcol] = acc[m][n][j]; })
  }
}
DI void phase_s5_scan(const Params& p, int layer) {
  float* Xloc = (float*)(p.ws + OFF_XLOC);
  bfu* Xst = (bfu*)(p.ws + OFF_XST);
  const int tid = TIDX;
  const int seg = tid >> 4, p16 = tid & 15;
  float* ex = (float*)g_smem;
  for (int it = BIDX; it < 256; it += gridDim.x) {
    const int g = it >> 3, b = (it >> 2) & 1, pq = it & 3;
    const int pr = pq * 16 + p16;
    const int idx = (layer * 32 + g) * 64 + pr;
    const float dt = expf(p.in[24][layer * 32 + g]);
    const float e1 = p.in[17][idx] * dt * 16.f, a1 = p.in[18][idx] * dt * 16.f;
    const float m16 = expf(e1);
    const float l16x = m16 * cosf(a1), l16y = m16 * sinf(a1);
    const int n0 = seg * 65, n1 = (n0 + 65 < 1028) ? n0 + 65 : 1028;
    const float* xl = Xloc + ((long)g * 2176 + b * 1028) * 128;
    bfu* xs = Xst + ((long)g * 2176 + b * 1028) * 128;
    float sre = 0.f, sim = 0.f;
#pragma unroll 13
    for (int n = n0; n < n1; ++n) {
      float lre = xl[(long)n * 128 + pr], lim = xl[(long)n * 128 + 64 + pr];
      float nre = l16x * sre - l16y * sim + lre;
      float nim = l16x * sim + l16y * sre + lim;
      sre = nre; sim = nim;
    }
    __syncthreads();
    ex[(seg * 16 + p16) * 2] = sre; ex[(seg * 16 + p16) * 2 + 1] = sim;
    __syncthreads();
    float cre = 0.f, cim = 0.f;
    {
      const float mL = expf(e1 * 65.f), aL = a1 * 65.f;
      const float lLx = mL * cosf(aL), lLy = mL * sinf(aL);
      for (int s2 = 0; s2 < seg; ++s2) {
        float ere = ex[(s2 * 16 + p16) * 2], eim = ex[(s2 * 16 + p16) * 2 + 1];
        float nre = lLx * cre - lLy * cim + ere;
        float nim = lLx * cim + lLy * cre + eim;
        cre = nre; cim = nim;
      }
    }
    sre = cre; sim = cim;
#pragma unroll 13
    for (int n = n0; n < n1; ++n) {
      float lre = xl[(long)n * 128 + pr], lim = xl[(long)n * 128 + 64 + pr];
      xs[(long)n * 128 + pr] = f2bf(sre);
      xs[(long)n * 128 + 64 + pr] = f2bf(sim);
      float nre = l16x * sre - l16y * sim + lre;
      float nim = l16x * sim + l16y * sre + lim;
      sre = nre; sim = nim;
    }
  }
}
DI void phase_s5_gemm2(const Params& p) {
  const bfu* U2 = (const bfu*)(p.ws + OFF_U2);
  const bfu* Xst = (const bfu*)(p.ws + OFF_XST);
  const bfu* Mc = (const bfu*)(p.ws + OFF_MC);
  bfu* Ys5 = (bfu*)(p.ws + OFF_YS5);
  for (int t = BIDX; t < 32 * 17 * 2; t += gridDim.x) {
    int g = t / 34, rem = t - g * 34, tm = rem >> 1, tn = rem & 1;
    f32x4 acc[4][4];
    zero_acc<4>(acc);
    const bfu* Bt = Mc + ((long)g * 256 + tn * 128) * 384;
    gemm_tile<4>(acc, U2 + ((long)g * 2176 + tm * 128) * 256, 256, Bt, 384, 256);
    gemm_tile<4>(acc, Xst + ((long)g * 2176 + tm * 128) * 128, 128, Bt + 256, 384, 128);
    ACC_FOREACH(4, {
      int nc = tm * 128 + trow, o = tn * 128 + tcol;
      if (nc < 2056) Ys5[((long)nc * 16 + (o >> 4)) * 512 + g * 16 + (o & 15)] = f2bf(geluf(acc[m][n][j]));
    })
  }
}
DI void phase_glu(const Params& p) {
  const bfu* Ys5 = (const bfu*)(p.ws + OFF_YS5);
  const bfu* Wg = (const bfu*)(p.ws + OFF_WGLU);
  const bfu* Pz = (const bfu*)(p.ws + OFF_PZ);
  bfu* Yd = (bfu*)(p.ws + OFF_Y) + (long)3 * TR * 512;
  for (int t = BIDX; t < 257 * 8; t += gridDim.x) {
    int tm = t >> 3, tn = t & 7;
    f32x4 acc[4][4];
    zero_acc<4>(acc);
    gemm_tile<4>(acc, Ys5 + (long)tm * 128 * 512, 512, Wg + (long)tn * 128 * 512, 512, 512);
    const int lane = TIDX & 63, wid = TIDX >> 6, wr = wid >> 1, wc = wid & 1, fr = lane & 15, fq = lane >> 4;
#pragma unroll
    for (int m = 0; m < 4; ++m)
#pragma unroll
      for (int n = 0; n < 2; ++n)
#pragma unroll
        for (int j = 0; j < 4; ++j) {
          int row = tm * 128 + wr * 64 + m * 16 + fq * 4 + j;
          int oc = tn * 64 + wc * 32 + n * 16 + fr;
          float z = bf2f(Pz[(long)row * 512 + oc]);
          Yd[(long)row * 512 + oc] = f2bf(acc[m][n][j] * sigm(acc[m][n + 2][j]) * siluf(z));
        }
  }
}
DI void phase_gates(const Params& p) {
  const bfu* h16 = (const bfu*)(p.ws + OFF_H16);
  const bfu* WT = (const bfu*)(p.ws + OFF_WIN);
  bfu* G = (bfu*)(p.ws + OFF_P);
  for (int t = BIDX; t < 257 * 32; t += gridDim.x) {
    int tm = t >> 5, tn = t & 31;
    f32x4 acc[4][4];
    zero_acc<4>(acc);
    gemm_tile<4>(acc, h16 + (long)tm * 128 * 1024, 1024, WT + (long)(6656 + tn * 128) * 1024, 1024, 1024);
    ACC_FOREACH(4, { G[(long)(tm * 128 + trow) * 4096 + tn * 128 + tcol] = f2bf(sigm(acc[m][n][j])); })
  }
}
DI void phase_merge(const Params& p) {
  const bfu* WbT = (const bfu*)(p.ws + OFF_WB);
  const bfu* Y = (const bfu*)(p.ws + OFF_Y);
  const bfu* G = (const bfu*)(p.ws + OFF_P);
  bfu* mixed = (bfu*)(p.ws + OFF_H16);
  for (int t = BIDX; t < 257 * 8; t += gridDim.x) {
    int tm = t >> 3, tn = t & 7;
    f32x4 tot[4][4];
    zero_acc<4>(tot);
    for (int b = 0; b < 4; ++b) {
      f32x4 acc[4][4];
      zero_acc<4>(acc);
      gemm_tile<4>(acc, Y + ((long)b * TR + tm * 128) * 512, 512, WbT + (long)(b * 1024 + tn * 128) * 512, 512, 512);
      ACC_FOREACH(4, { tot[m][n][j] += bf2f(G[(long)(tm * 128 + trow) * 4096 + b * 1024 + tn * 128 + tcol]) * acc[m][n][j]; })
    }
    ACC_FOREACH(4, { mixed[(long)(tm * 128 + trow) * 1024 + tn * 128 + tcol] = f2bf(tot[m][n][j]); })
  }
}
DI void phase_out(const Params& p) {
  const bfu* mixed = (const bfu*)(p.ws + OFF_H16);
  const bfu* WoT = (const bfu*)(p.ws + OFF_WO);
  float* h32 = (float*)(p.ws + OFF_H32);
  const float ALPHA = 1.6817928305074290f;
  for (int t = BIDX; t < 257 * 8; t += gridDim.x) {
    int tm = t >> 3, tn = t & 7;
    f32x4 acc[4][4];
    zero_acc<4>(acc);
    gemm_tile<4>(acc, mixed + (long)tm * 128 * 1024, 1024, WoT + (long)tn * 128 * 1024, 1024, 1024);
    ACC_FOREACH(4, {
      long a = (long)(tm * 128 + trow) * 1024 + tn * 128 + tcol;
      h32[a] = ALPHA * h32[a] + acc[m][n][j];
    })
  }
}

DI void run_phase(const Params& p, int ph) {
  if (ph == 0) { phase_tables(p); return; }
  if (ph == NPHASE - 1) { ln_rows(p, 3, true); return; }
  const int layer = (ph - 1) / NPL, sub = (ph - 1) % NPL;
  bfu* Xb = (bfu*)(p.ws + OFF_X);
  float* SC = (float*)(p.ws + OFF_SC);
  bfu* Y = (bfu*)(p.ws + OFF_Y);
  const bfu* Zb = (const bfu*)(p.ws + OFF_Z);
  const int bid = BIDX;
  switch (sub) {
    case 0: ln_rows(p, layer - 1, false); phase_convert(p, layer); break;
    case 1: phase_proj(p, 0, 2048, 0, true, 0); break;
    case 2: for (int it = bid; it < 2056; it += gridDim.x) gdn_prep_item(p, layer, it); break;
    case 3:
      if (bid < 32) {
        int b = bid >> 4, h = (bid >> 2) & 3, sl = bid & 3;
        GdnArgs e;
        bfu* base = Xb + ((long)(b * NCHK) * 4 + h) * 36864;
        e.w = base + 8192; e.kdt = base + 16384; e.ut = base + 24576 + sl * 32 * 64; e.cs = 4 * 36864;
        e.sc = SC + ((long)(b * NCHK) * 4 + h) * 256; e.sc_cs = 4 * 256;
        e.ss = Y + (long)TR * 512 + ((long)(b * NCHK) * 4 + h) * 16384 + sl * 32 * 128; e.ss_cs = 4 * 16384;
        engine_gdn<3>(e);
      } else phase_proj(p, 2048, 1536, 0, false, 32);
      break;
    case 4:
      for (int it = bid; it < 2056; it += gridDim.x) {
        int h = it & 3; long r0 = (long)(it >> 2) * 64;
        const bfu* base = Xb + (long)it * 36864;
        oproj_head128(base, base + 32768, Y + (long)TR * 512 + (long)it * 16384, base + 24576,
                      Zb + r0 * 512 + h * 128, 512, p.in[8] + layer * 128, Y + r0 * 512 + h * 128);
      }
      break;
    case 5: for (int it = bid; it < 1028; it += gridDim.x) ssd_prep_item(p, layer, it); break;
    case 6:
      if (bid < 32) {
        int b = bid >> 4, hd = (bid >> 1) & 7, sl = bid & 1, g = hd >> 2;
        LinArgs e;
        const bfu* base = Xb + (long)(b * NCHK) * 131072;
        e.kdt = base + g * 16384 + 8192; e.kdt_cs = 131072;
        e.vt = base + 32768 + hd * 12288 + 8192 + sl * 32 * 64; e.vt_cs = 131072;
        e.sc = SC + ((long)(b * NCHK) * 8 + hd) * 256; e.sc_cs = 8 * 256;
        e.ss = Y + (long)2 * TR * 512 + ((long)(b * NCHK) * 8 + hd) * 8192 + sl * 32 * 128; e.ss_cs = 8 * 8192;
        engine_lin<4>(e);
      } else phase_proj(p, 3584, 2048, 0, false, 32);
      break;
    case 7:
      for (int it = bid; it < 1028; it += gridDim.x) {
        int g = it & 1; long cn = it >> 1; long r0 = cn * 64;
        oproj_ssd(Xb + cn * 131072, g, SC + cn * 8 * 256, Y + (long)2 * TR * 512 + cn * 8 * 8192,
                  Zb + r0 * 512 + g * 256, p.in[14] + layer * 512 + g * 256, Y + (long)TR * 512 + r0 * 512 + g * 256);
      }
      break;
    case 8: for (int it = bid; it < 2056; it += gridDim.x) hg_prep_item(p, layer, it); break;
    case 9:
      if (bid < 32) {
        int b = bid >> 4, h = (bid >> 2) & 3, sl = bid & 3;
        LinArgs e;
        const bfu* base = Xb + ((long)(b * NCHK) * 4 + h) * 28672;
        e.kdt = base + 8192; e.kdt_cs = 4 * 28672;
        e.vt = base + 20480 + sl * 32 * 64; e.vt_cs = 4 * 28672;
        e.sc = SC + ((long)(b * NCHK) * 4 + h) * 256; e.sc_cs = 4 * 256;
        bfu* ssb = b == 0 ? (Y + (long)3 * TR * 512) : (Xb + (long)2056 * 28672);
        e.ss = ssb + (long)h * 16384 + sl * 32 * 128; e.ss_cs = 4 * 16384;
        engine_lin<4>(e);
      } else phase_proj(p, 5632, 1024, 1, false, 32);
      break;
    case 10:
      for (int it = bid; it < 2056; it += gridDim.x) {
        int h = it & 3; int cn = it >> 2; long r0 = (long)cn * 64;
        int b = cn / NCHK, n = cn - b * NCHK;
        const bfu* base = Xb + (long)it * 28672;
        const bfu* ssb = b == 0 ? (Y + (long)3 * TR * 512) : (Xb + (long)2056 * 28672);
        oproj_head128(base, base + 16384, ssb + ((long)n * 4 + h) * 16384, base + 20480,
                      Zb + r0 * 512 + h * 128, 512, p.in[16] + layer * 128, Y + (long)2 * TR * 512 + r0 * 512 + h * 128);
      }
      break;
    case 11: phase_s5_gemm1(p); break;
    case 12: phase_s5_scan(p, layer); break;
    case 13: phase_s5_gemm2(p); break;
    case 14: phase_glu(p); break;
    case 15: phase_gates(p); break;
    case 16: phase_merge(p); break;
    case 17: phase_out(p); break;
  }
}


#define XB_TMO      128
#define XB_XCNT(j)  (256  + 64 * (j))
#define XB_XSUB(j)  (1280 + 64 * (j))
#define XB_XGEN(j)  (2304 + 64 * (j))
#define XB_TOP      3328
#define XB_TOPGEN   3392
#define XCD_BAR_WORDS 3456
#define XB_SPIN_CAP (1u << 20)
#define LAS __attribute__((address_space(3)))
DI unsigned xb_ld(unsigned* p) { return __hip_atomic_load(p, __ATOMIC_RELAXED, __HIP_MEMORY_SCOPE_AGENT); }
DI unsigned xb_add(unsigned* p, unsigned v) { return __hip_atomic_fetch_add(p, v, __ATOMIC_RELAXED, __HIP_MEMORY_SCOPE_AGENT); }
DI unsigned xb_xcc_id() { return (unsigned)__builtin_amdgcn_s_getreg((3 << 11) | 20) & 0xFu; }
#define XB_SPIN(cond, bar) do { unsigned _sp = 0; while (cond) { __builtin_amdgcn_s_sleep(1); \
    if ((++_sp & 255u) == 0u) { if (xb_ld(&(bar)[XB_TMO])) break; if (_sp > XB_SPIN_CAP) { atomicAdd(&(bar)[XB_TMO], 1u); break; } } } } while (0)
struct XcdBarrier { unsigned* bar; unsigned x; volatile LAS unsigned* st; };
DI XcdBarrier xcd_barrier_post(unsigned* bar, volatile LAS unsigned* st) {
  XcdBarrier b; b.bar = bar; b.x = xb_xcc_id(); b.st = st;
  if (threadIdx.x == 0) (void)xb_add(&bar[XB_XCNT(b.x)], 1u);
  return b;
}
DI void xcd_barrier_complete(unsigned* bar, unsigned x, unsigned& nloc, unsigned& nx) {
  const unsigned G = gridDim.x * gridDim.y * gridDim.z;
  unsigned sum, cnt, mine, sp = 0u;
  for (;;) {
    sum = 0u; cnt = 0u; mine = 0u;
#pragma unroll
    for (unsigned j = 0; j < 16; ++j) { const unsigned c = xb_ld(&bar[XB_XCNT(j)]); sum += c; cnt += (c > 0u) ? 1u : 0u; mine = (j == x) ? c : mine; }
    if (sum == G) break;
    __builtin_amdgcn_s_sleep(1);
    if ((++sp & 255u) == 0u) { if (xb_ld(&bar[XB_TMO])) break; if (sp > XB_SPIN_CAP) { atomicAdd(&bar[XB_TMO], 1u); break; } }
  }
  nloc = mine > 0u ? mine : 1u; nx = cnt > 0u ? cnt : 1u;
}
DI void xcd_barrier(const XcdBarrier& b) {
  asm volatile("s_waitcnt vmcnt(0)" ::: "memory");
  __syncthreads();
  if (threadIdx.x == 0) {
    unsigned* bar = b.bar;
    __builtin_amdgcn_s_waitcnt(0);
    unsigned nloc = b.st[0], nx = b.st[1];
    if (nloc == 0u) { xcd_barrier_complete(bar, b.x, nloc, nx); b.st[0] = nloc; b.st[1] = nx; }
    const unsigned old = xb_add(&bar[XB_XSUB(b.x)], 1u);
    const unsigned gen = old / nloc;
    if (old + 1u == (gen + 1u) * nloc) {
      __builtin_amdgcn_fence(__ATOMIC_RELEASE, "agent");
      asm volatile("s_waitcnt vmcnt(0)" ::: "memory");
      const unsigned og = xb_add(&bar[XB_TOP], 1u);
      const unsigned tg = og / nx;
      if (og + 1u == (tg + 1u) * nx) xb_add(&bar[XB_TOPGEN], 1u);
      else XB_SPIN(xb_ld(&bar[XB_TOPGEN]) == tg, bar);
      __builtin_amdgcn_fence(__ATOMIC_ACQUIRE, "agent");
      xb_add(&bar[XB_XGEN(b.x)], 1u);
      asm volatile("s_waitcnt vmcnt(0)" ::: "memory");
    } else {
      XB_SPIN(xb_ld(&bar[XB_XGEN(b.x)]) == gen, bar);
      __builtin_amdgcn_fence(__ATOMIC_ACQUIRE, "agent");
      asm volatile("s_waitcnt vmcnt(0)" ::: "memory");
    }
  }
  __syncthreads();
}
#ifndef DBL_MASK
#define DBL_MASK 0
#endif
#ifndef TIMING_PROBE
#define TIMING_PROBE 0
#endif
#ifndef TP_MASK_A
#define TP_MASK_A 0
#endif
#ifndef TP_MASK_B
#define TP_MASK_B 0
#endif
__global__ void __launch_bounds__(256, 2) mega_kernel(Params p, int ph_lo, int ph_hi) {
  if (ph_hi - ph_lo == 1) { run_phase(p, ph_lo); return; }
  cg::grid_group grid = cg::this_grid();
  volatile LAS unsigned* xst = (volatile LAS unsigned*)(g_smem + LDS_BYTES - 16);
  if (threadIdx.x == 0) { xst[0] = 0u; xst[1] = 0u; xst[2] = 0u; xst[3] = 0u; }
  __syncthreads();
  XcdBarrier xb = xcd_barrier_post((unsigned*)(p.ws + OFF_BAR), xst);
  for (int ph = ph_lo; ph < ph_hi; ++ph) {
    run_phase(p, ph);
#if DBL_MASK
    if (ph > 0 && ph < NPHASE - 1 && ((DBL_MASK >> ((ph - 1) % NPL)) & 1)) { xcd_barrier(xb); run_phase(p, ph); }
#endif
    if (ph + 1 < ph_hi) {
      if (ph == ph_lo) grid.sync();
      else xcd_barrier(xb);
    }
  }
}

extern "C" void kernel_launch(void* const* d_in, const int* in_sizes, int n_in, void* d_out, int out_size, void* d_ws, size_t ws_size,
                              hipStream_t stream) {
  static int grid_blocks = 0;
  if (!grid_blocks) {
    int dev = 0, cus = 0, per_cu = 0;
    hipGetDevice(&dev);
    hipDeviceGetAttribute(&cus, hipDeviceAttributeMultiprocessorCount, dev);
    hipFuncSetAttribute((const void*)mega_kernel, hipFuncAttributeMaxDynamicSharedMemorySize, LDS_BYTES);
    hipOccupancyMaxActiveBlocksPerMultiprocessor(&per_cu, mega_kernel, 256, LDS_BYTES);
    if (per_cu > 2) per_cu = 2;
    if (per_cu < 1) per_cu = 1;
    grid_blocks = cus * per_cu;
  }
  if (ws_size < WS_NEEDED) { fprintf(stderr, "workspace too small: %zu < %zu\n", ws_size, WS_NEEDED); return; }
  Params p{};
  for (int i = 0; i < 31; ++i) p.in[i] = (const float*)d_in[i];
  p.out = (float*)d_out;
  p.ws = (char*)d_ws;
#if MULTI_LAUNCH
  for (int ph = 0; ph < NPHASE; ++ph) {
    hipLaunchKernelGGL(mega_kernel, dim3(grid_blocks), dim3(256), LDS_BYTES, stream, p, ph, ph + 1);
  }
#else
  int lo = 0, hi = NPHASE;
  hipMemsetAsync((char*)d_ws + OFF_BAR, 0, 16384, stream);
  void* args[] = {&p, &lo, &hi};
  hipError_t e = hipLaunchCooperativeKernel((void*)mega_kernel, dim3(grid_blocks), dim3(256), args, LDS_BYTES, stream);
  if (e != hipSuccess) fprintf(stderr, "cooperative launch failed: %s (grid %d)\n", hipGetErrorString(e), grid_blocks);
#endif
}
```

```cpp
#include <hip/hip_runtime.h>
#include <hip/hip_cooperative_groups.h>
#include <cstdio>
namespace cg = cooperative_groups;

typedef unsigned short bfu;
using bf16x8 = __attribute__((ext_vector_type(8))) short;
using f32x4 = __attribute__((ext_vector_type(4))) float;
using u16x4 = __attribute__((ext_vector_type(4))) unsigned short;
using u16x8 = __attribute__((ext_vector_type(8))) unsigned short;
#define DI __device__ __forceinline__
#define MFMA16(a, b, c) __builtin_amdgcn_mfma_f32_16x16x32_bf16((a), (b), (c), 0, 0, 0)

#ifndef PH_MASK
#define PH_MASK 0xFFFFFF
#endif
#ifndef MULTI_LAUNCH
#define MULTI_LAUNCH 0
#endif

constexpr int TR = 32896;
constexpr int NCHK = 257;
constexpr int LBATCH = 16448;
constexpr int LDS_BYTES = 73728;
constexpr int NPL = 18;
constexpr int NPHASE = 1 + 4 * NPL + 1;

constexpr size_t OFF_H32 = 0;
constexpr size_t OFF_H16 = 134742016;
constexpr size_t OFF_Y = 202113024;
constexpr size_t OFF_P = 336855040;
constexpr size_t OFF_X = 471597056;
constexpr size_t OFF_SC = 623181824;
constexpr size_t OFF_PS = 627392512;
constexpr size_t OFF_W = 629497856;
constexpr size_t OFF_WIN = OFF_W;
constexpr size_t OFF_WS = OFF_WIN + 22020096;
constexpr size_t OFF_WGLU = OFF_WS + 32768;
constexpr size_t OFF_WB = OFF_WGLU + 1048576;
constexpr size_t OFF_WO = OFF_WB + 4194304;
constexpr size_t OFF_MS = OFF_WO + 2097152;
constexpr size_t OFF_MC = OFF_MS + 2097152;
constexpr size_t OFF_LB = OFF_MC + 6291456;
constexpr size_t OFF_LP = OFF_LB + 2048;
constexpr size_t OFF_BB = OFF_LP + 1114112;
constexpr size_t OFF_BAR = OFF_BB + 1048576;
constexpr size_t OFF_Z = OFF_BAR + 16384;
constexpr size_t WS_NEEDED = OFF_Z + 33685504;
constexpr size_t OFF_PZ = OFF_P;
constexpr size_t OFF_U2 = OFF_P + 33685504;
constexpr size_t OFF_YS5 = OFF_U2 + 35651584;
constexpr size_t OFF_XLOC = OFF_X;
constexpr size_t OFF_XST = OFF_X + 35651584;

struct Params {
  const float* in[31];
  float* out;
  char* ws;
};

extern __shared__ __attribute__((aligned(16))) char g_smem[];
DI int tid_laundered() { int t = threadIdx.x; asm volatile("" : "+v"(t)); return t; }
DI int bid_laundered() { int b = blockIdx.x; asm volatile("" : "+s"(b)); return b; }
#define TIDX tid_laundered()
#define BIDX bid_laundered()


DI bfu f2bf(float x) { unsigned u = __float_as_uint(x); u += 0x7fffu + ((u >> 16) & 1u); return (bfu)(u >> 16); }
DI float bf2f(bfu b) { return __uint_as_float(((unsigned)b) << 16); }
DI float sigm(float x) { return 1.f / (1.f + __expf(-x)); }
DI float siluf(float x) { return x / (1.f + __expf(-x)); }
DI float softplusf(float x) { return x > 20.f ? x : log1pf(expf(x)); }
DI float wave_sum(float v) {
#pragma unroll
  for (int m = 32; m >= 1; m >>= 1) v += __shfl_xor(v, m);
  return v;
}
DI float wave_scan_incl(float s, int lane) {
#pragma unroll
  for (int d = 1; d < 64; d <<= 1) { float o = __shfl_up(s, d); if (lane >= d) s += o; }
  return s;
}

template <int NREP>
DI void gemm_stage(const bfu* __restrict__ A, int lda, const bfu* __restrict__ Bt, int ldb, int kt, char* buf, int tid) {
#pragma unroll
  for (int i = 0; i < 2; ++i) {
    int b = tid * 16 + i * 4096; int r = b >> 6, c = (b & 63) >> 1;
    __builtin_amdgcn_global_load_lds((const unsigned*)(A + (long)r * lda + kt + c), (unsigned*)(buf + b), 16, 0, 0);
  }
#pragma unroll
  for (int i = 0; i < NREP / 2; ++i) {
    int b = tid * 16 + i * 4096; int r = b >> 6, c = (b & 63) >> 1;
    __builtin_amdgcn_global_load_lds((const unsigned*)(Bt + (long)r * ldb + kt + c), (unsigned*)(buf + 8192 + b), 16, 0, 0);
  }
}
template <int NREP>
DI void gemm_tile(f32x4 (&acc)[4][NREP], const bfu* __restrict__ A, int lda, const bfu* __restrict__ Bt, int ldb, int K) {
  const int tid = TIDX, lane = tid & 63, wid = tid >> 6, wr = wid >> 1, wc = wid & 1, fr = lane & 15, fq = lane >> 4;
  constexpr int GL = 2 + NREP / 2;
  const int nk = K >> 5;
  __syncthreads();
#pragma unroll
  for (int s = 0; s < 3; ++s)
    if (s < nk) gemm_stage<NREP>(A, lda, Bt, ldb, s * 32, g_smem + s * 16384, tid);
  for (int i = 0; i < nk; ++i) {
    const int younger = nk - 1 - i;
    if (younger >= 2) asm volatile("s_waitcnt vmcnt(%0)" ::"n"(2 * GL) : "memory");
    else if (younger == 1) asm volatile("s_waitcnt vmcnt(%0)" ::"n"(GL) : "memory");
    else asm volatile("s_waitcnt vmcnt(0)" ::: "memory");
    __builtin_amdgcn_s_barrier();
    if (i + 3 < nk) gemm_stage<NREP>(A, lda, Bt, ldb, (i + 3) * 32, g_smem + ((i + 3) & 3) * 16384, tid);
    const char* SA = g_smem + (i & 3) * 16384;
    const char* SB = SA + 8192;
    bf16x8 af[4], bfr[NREP];
#pragma unroll
    for (int m = 0; m < 4; ++m) af[m] = *(const bf16x8*)(SA + (wr * 64 + m * 16 + fr) * 64 + fq * 16);
#pragma unroll
    for (int n = 0; n < NREP; ++n) bfr[n] = *(const bf16x8*)(SB + (wc * (NREP * 16) + n * 16 + fr) * 64 + fq * 16);
#pragma unroll
    for (int m = 0; m < 4; ++m)
#pragma unroll
      for (int n = 0; n < NREP; ++n) acc[m][n] = MFMA16(af[m], bfr[n], acc[m][n]);
  }
}
template <int NREP>
DI void zero_acc(f32x4 (&acc)[4][NREP]) {
#pragma unroll
  for (int m = 0; m < 4; ++m)
#pragma unroll
    for (int n = 0; n < NREP; ++n) acc[m][n] = f32x4{0.f, 0.f, 0.f, 0.f};
}
#define ACC_FOREACH(NREP_, ...)                                                                \
  {                                                                                              \
    const int lane_ = TIDX & 63, wid_ = TIDX >> 6, wr_ = wid_ >> 1, wc_ = wid_ & 1; \
    const int fr_ = lane_ & 15, fq_ = lane_ >> 4;                                                \
    _Pragma("unroll") for (int m = 0; m < 4; ++m) _Pragma("unroll") for (int n = 0; n < NREP_; ++n) \
        _Pragma("unroll") for (int j = 0; j < 4; ++j) {                                          \
      const int trow = wr_ * 64 + m * 16 + fq_ * 4 + j;                                          \
      const int tcol = wc_ * (NREP_ * 16) + n * 16 + fr_;                                        \
      __VA_ARGS__                                                                                \
    }                                                                                            \
  }

DI void phase_tables(const Params& p) {
  const int gtid = BIDX * 256 + TIDX, gth = gridDim.x * 256;
  float2* LP = (float2*)(p.ws + OFF_LP);
  float2* BB = (float2*)(p.ws + OFF_BB);
  for (int idx = gtid; idx < 4 * 32 * 64; idx += gth) {
    int l = idx >> 11, g = (idx >> 6) & 31;
    float dt = expf(p.in[24][l * 32 + g]);
    float are = p.in[17][idx], aim = p.in[18][idx];
    float e1 = are * dt, a1 = aim * dt;
    for (int d = 0; d <= 16; ++d) {
      float mag = expf((float)d * e1), ang = (float)d * a1;
      LP[(long)idx * 17 + d] = make_float2(mag * cosf(ang), mag * sinf(ang));
    }
    float mag = expf(e1);
    float lre = mag * cosf(a1), lim = mag * sinf(a1);
    float den = are * are + aim * aim;
    float nr = lre - 1.f, ni = lim;
    float zre = (nr * are + ni * aim) / den, zim = (ni * are - nr * aim) / den;
    for (int c = 0; c < 16; ++c) {
      float bre = p.in[19][(long)idx * 16 + c], bim = p.in[20][(long)idx * 16 + c];
      BB[(long)idx * 16 + c] = make_float2(zre * bre - zim * bim, zre * bim + zim * bre);
    }
  }
}

DI void ln_rows(const Params& p, int layer, bool final_) {
  float* h32 = (float*)(p.ws + OFF_H32);
  bfu* h16 = (bfu*)(p.ws + OFF_H16);
  const int lane = TIDX & 63;
  const int gw = BIDX * 4 + (TIDX >> 6), nw = gridDim.x * 4;
  const float* gam = layer < 0 ? p.in[2] : p.in[29] + layer * 1024;
  const float* bet = layer < 0 ? p.in[3] : p.in[30] + layer * 1024;
  for (int r = gw; r < TR; r += nw) {
    int b = r / LBATCH, pos = r - b * LBATCH;
    float* d32 = h32 + (long)r * 1024;
    bfu* d16 = h16 + (long)r * 1024;
    if (pos < 48) {
      if (!final_) {
#pragma unroll
        for (int i = 0; i < 4; ++i) {
          *(float4*)(d32 + i * 256 + lane * 4) = make_float4(0.f, 0.f, 0.f, 0.f);
          *(u16x4*)(d16 + i * 256 + lane * 4) = u16x4{0, 0, 0, 0};
        }
      }
      continue;
    }
    const float* src;
    if (layer < 0) src = pos < 64 ? p.in[1] + (pos - 48) * 1024 : p.in[0] + ((long)b * 16384 + (pos - 64)) * 1024;
    else src = d32;
    float4 v[4];
    float s = 0.f;
#pragma unroll
    for (int i = 0; i < 4; ++i) { v[i] = *(const float4*)(src + i * 256 + lane * 4); s += v[i].x + v[i].y + v[i].z + v[i].w; }
    float mu = wave_sum(s) * (1.f / 1024.f);
    float q = 0.f;
#pragma unroll
    for (int i = 0; i < 4; ++i) {
      v[i].x -= mu; v[i].y -= mu; v[i].z -= mu; v[i].w -= mu;
      q += v[i].x * v[i].x + v[i].y * v[i].y + v[i].z * v[i].z + v[i].w * v[i].w;
    }
    float rs = rsqrtf(wave_sum(q) * (1.f / 1024.f) + 1e-5f);
#pragma unroll
    for (int i = 0; i < 4; ++i) {
      float4 g4 = *(const float4*)(gam + i * 256 + lane * 4), b4 = *(const float4*)(bet + i * 256 + lane * 4);
      float4 o = make_float4(v[i].x * rs * g4.x + b4.x, v[i].y * rs * g4.y + b4.y, v[i].z * rs * g4.z + b4.z, v[i].w * rs * g4.w + b4.w);
      if (final_) {
        if (pos >= 64) *(float4*)(p.out + ((long)b * 16384 + (pos - 64)) * 1024 + i * 256 + lane * 4) = o;
      } else {
        *(float4*)(d32 + i * 256 + lane * 4) = o;
        *(u16x4*)(d16 + i * 256 + lane * 4) = u16x4{f2bf(o.x), f2bf(o.y), f2bf(o.z), f2bf(o.w)};
      }
    }
  }
}

template <class F>
DI void conv_T(bfu* dst, int N, int K, F src) {
  const long gtid = BIDX * 256 + TIDX, gth = (long)gridDim.x * 256;
  const long total = (long)N * (K / 8);
  for (long idx = gtid; idx < total; idx += gth) {
    int n = (int)(idx % N); int kg = (int)(idx / N);
    u16x8 o;
#pragma unroll
    for (int j = 0; j < 8; ++j) o[j] = f2bf(src(kg * 8 + j, n));
    *(u16x8*)(dst + (long)n * K + kg * 8) = o;
  }
}

DI void phase_convert(const Params& p, int l) {
  const float* win = p.in[4] + (long)l * 1024 * 10768;
  conv_T((bfu*)(p.ws + OFF_WIN), 10752, 1024, [&](int k, int n) {
    int sc = n < 2048 ? n : n < 3584 ? n + 8 : n < 5632 ? n + 16 : n < 6656 ? n + 16 : n + 16;
    return win[(long)k * 10768 + sc];
  });
  conv_T((bfu*)(p.ws + OFF_WS), 16, 1024, [&](int k, int n) { int sc = n < 8 ? 2048 + n : 3592 + (n - 8); return win[(long)k * 10768 + sc]; });
  const float* w1 = p.in[25] + (long)l * 512 * 512;
  const float* w2 = p.in[26] + (long)l * 512 * 512;
  conv_T((bfu*)(p.ws + OFF_WGLU), 1024, 512, [&](int k, int r) {
    int j = r >> 7, wc = (r >> 6) & 1, n = (r >> 4) & 3, fr = r & 15;
    int oc = j * 64 + wc * 32 + (n & 1) * 16 + fr;
    return (n >> 1) ? w2[k * 512 + oc] : w1[k * 512 + oc];
  });
  const float* wb = p.in[27] + (long)l * 4 * 512 * 1024;
  conv_T((bfu*)(p.ws + OFF_WB), 4096, 512, [&](int k, int r) { int b = r >> 10, n = r & 1023; return wb[((long)b * 512 + k) * 1024 + n]; });
  const float* wo = p.in[28] + (long)l * 1024 * 1024;
  conv_T((bfu*)(p.ws + OFF_WO), 1024, 1024, [&](int k, int n) { return wo[(long)k * 1024 + n]; });
  const int gtid = BIDX * 256 + TIDX, gth = gridDim.x * 256;
  float* lbv = (float*)(p.ws + OFF_LB);
  for (int c = gtid; c < 512; c += gth) {
    float v0 = p.in[15][c], v1 = p.in[15][512 + c], v2 = p.in[15][1024 + c], v3 = p.in[15][1536 + c];
    float mx = fmaxf(fmaxf(v0, v1), fmaxf(v2, v3));
    float e0 = expf(v0 - mx), e1 = expf(v1 - mx), e2 = expf(v2 - mx), e3 = expf(v3 - mx);
    float inv = 1.f / (e0 + e1 + e2 + e3);
    float acc = 0.f;
    if (l >= 1) acc += e1 * inv;
    if (l >= 2) acc += e2 * inv;
    if (l >= 3) acc += e3 * inv;
    lbv[c] = acc;
  }
  const float2* LP = (const float2*)(p.ws + OFF_LP) + (long)l * 32 * 64 * 17;
  const float2* BB = (const float2*)(p.ws + OFF_BB) + (long)l * 32 * 64 * 16;
  const float* cre = p.in[21] + (long)l * 32 * 16 * 64;
  const float* cim = p.in[22] + (long)l * 32 * 16 * 64;
  const float* dd = p.in[23] + l * 512;
  bfu* Ms = (bfu*)(p.ws + OFF_MS);
  bfu* Mc = (bfu*)(p.ws + OFF_MC);
  for (int idx = gtid; idx < 32 * 128 * 256; idx += gth) {
    int g = idx >> 15, pp = (idx >> 8) & 127, kk = idx & 255;
    int s = kk >> 4, c2 = kk & 15, pr = pp & 63;
    float2 lp = LP[((long)g * 64 + pr) * 17 + (15 - s)];
    float2 bb = BB[((long)g * 64 + pr) * 16 + c2];
    float v = pp < 64 ? lp.x * bb.x - lp.y * bb.y : lp.x * bb.y + lp.y * bb.x;
    Ms[idx] = f2bf(v);
  }
  for (int idx = gtid; idx < 32 * 256 * 384; idx += gth) {
    int g = idx / (256 * 384); int rem = idx - g * (256 * 384);
    int o = rem / 384, kk = rem - o * 384;
    int t = o >> 4, c = o & 15;
    float v = 0.f;
    const float* cr = cre + ((long)g * 16 + c) * 64;
    const float* ci = cim + ((long)g * 16 + c) * 64;
    if (kk < 256) {
      int s = kk >> 4, c2 = kk & 15;
      if (t >= s) {
        int d = t - s;
        for (int pr = 0; pr < 64; ++pr) {
          float2 lp = LP[((long)g * 64 + pr) * 17 + d];
          float2 bb = BB[((long)g * 64 + pr) * 16 + c2];
          float ere = lp.x * bb.x - lp.y * bb.y, eim = lp.x * bb.y + lp.y * bb.x;
          v += cr[pr] * ere - ci[pr] * eim;
        }
        if (kk == o) v += dd[g * 16 + c];
      }
    } else {
      int pp = kk - 256, pr = pp & 63;
      float2 lp = LP[((long)g * 64 + pr) * 17 + (t + 1)];
      v = pp < 64 ? cr[pr] * lp.x - ci[pr] * lp.y : -(cr[pr] * lp.y + ci[pr] * lp.x);
    }
    Mc[idx] = f2bf(v);
  }
}

DI bool tile_map(int v, int ntn, int& tm, int& tn) {
  const int x = v & 7, j = v >> 3, sidx = j >> 5, within = j & 31, ntng = ntn >> 2;
  const int gq = sidx / ntng, tng = sidx - gq * ntng;
  tm = (gq * 8 + x) * 8 + (within >> 2);
  tn = tng * 4 + (within & 3);
  return tm < 257;
}
DI void phase_proj(const Params& p, int wrow0, int ncols, int mode, bool with_small, int boff) {
  const bfu* h16 = (const bfu*)(p.ws + OFF_H16);
  const bfu* WT = (const bfu*)(p.ws + OFF_WIN);
  bfu* P = (bfu*)(p.ws + OFF_P);
  bfu* U2 = (bfu*)(p.ws + OFF_U2);
  const int ntn = ncols >> 7;
  const int G = gridDim.x - boff;
  for (int v = BIDX - boff; v < 320 * ntn; v += G) {
    int tm, tn;
    if (!tile_map(v, ntn, tm, tn)) continue;
    {
      f32x4 acc[4][4];
      zero_acc<4>(acc);
      gemm_tile<4>(acc, h16 + (long)tm * 128 * 1024, 1024, WT + (long)(wrow0 + tn * 128) * 1024, 1024, 1024);
      if (mode == 0) {
        ACC_FOREACH(4, { P[(long)(tm * 128 + trow) * ncols + tn * 128 + tcol] = f2bf(acc[m][n][j]); })
      } else {
        ACC_FOREACH(4, {
          int row = tm * 128 + trow, col = tn * 128 + tcol;
          if (col < 512) { int g = col >> 4, c2 = col & 15; U2[((long)g * 2176 + (row >> 4)) * 256 + (row & 15) * 16 + c2] = f2bf(acc[m][n][j]); }
          else P[(long)row * 512 + (col - 512)] = f2bf(acc[m][n][j]);
        })
      }
    }
  }
  if (with_small) for (int tm = BIDX - boff; tm < 257; tm += G) {
    {
      const int lane = TIDX & 63, w = TIDX >> 6, fr = lane & 15, fq = lane >> 4;
      const bfu* WsT = (const bfu*)(p.ws + OFF_WS);
      float* Ps = (float*)(p.ws + OFF_PS);
      f32x4 a0 = {0.f, 0.f, 0.f, 0.f}, a1 = {0.f, 0.f, 0.f, 0.f};
      const bfu* pa0 = h16 + (long)(tm * 128 + w * 32 + fr) * 1024 + fq * 8;
      const bfu* pa1 = pa0 + 16 * 1024;
      const bfu* pb = WsT + fr * 1024 + fq * 8;
      for (int k = 0; k < 1024; k += 32) {
        bf16x8 x0 = *(const bf16x8*)(pa0 + k), x1 = *(const bf16x8*)(pa1 + k), y = *(const bf16x8*)(pb + k);
        a0 = MFMA16(x0, y, a0);
        a1 = MFMA16(x1, y, a1);
      }
#pragma unroll
      for (int j = 0; j < 4; ++j) {
        Ps[(long)(tm * 128 + w * 32 + fq * 4 + j) * 16 + fr] = a0[j];
        Ps[(long)(tm * 128 + w * 32 + 16 + fq * 4 + j) * 16 + fr] = a1[j];
      }
    }
  }
}

DI void copy_z(const Params& p, const bfu* src, int sld, bfu* dst, int pieces_per_row) {
  const int tid = TIDX;
  const int total = 64 * pieces_per_row;
  for (int i = tid; i < total; i += 256) {
    int r = i / pieces_per_row, c = i - r * pieces_per_row;
    *(u16x8*)(dst + (long)r * 512 + c * 8) = *(const u16x8*)(src + (long)r * sld + c * 8);
  }
}
DI void gdn_prep_item(const Params& p, int layer, int item) {
  const int tid = TIDX, lane = tid & 63, w = tid >> 6, fr = lane & 15, fq = lane >> 4;
  const int h = item & 3, cn = item >> 2, n = cn % NCHK;
  const long r0 = (long)cn * 64;
  const bfu* P = (const bfu*)(p.ws + OFF_P);
  const float* Ps = (const float*)(p.ws + OFF_PS);
  bfu* Xb = (bfu*)(p.ws + OFF_X) + (long)item * 36864;
  float* SC = (float*)(p.ws + OFF_SC) + (long)item * 256;
  bfu* rawQ = (bfu*)g_smem;
  bfu* rawK = rawQ + 64 * 136;
  bfu* rawV = rawK + 64 * 136;
  float* aL = (float*)(g_smem + 52224);
  float* sm = (float*)(g_smem + 69632);
  const float* cw = p.in[5] + layer * 4 * 1536;
  copy_z(p, P + r0 * 2048 + 1536 + h * 128, 2048, (bfu*)(p.ws + OFF_Z) + r0 * 512 + h * 128, 16);
  if (w < 3) {
    const int cgp = tid % 48, seg = tid / 48;
    const int which = cgp >> 4, c8 = (cgp & 15) * 8;
    const int col = which * 512 + h * 128 + c8;
    const int t0 = seg * 16;
    u16x8 xr[19];
    const bool nohist = (seg == 0 && n == 0);
#pragma unroll
    for (int i = 0; i < 19; ++i) {
      const bool valid = !(nohist && i < 3);
      const long rr = valid ? (r0 + t0 - 3 + i) : r0;
      u16x8 v = *(const u16x8*)(P + rr * 2048 + col);
      xr[i] = valid ? v : u16x8{0, 0, 0, 0, 0, 0, 0, 0};
    }
    float wt[4][8];
#pragma unroll
    for (int j = 0; j < 4; ++j) {
      float4 a4 = *(const float4*)(cw + j * 1536 + col), b4 = *(const float4*)(cw + j * 1536 + col + 4);
      wt[j][0] = a4.x; wt[j][1] = a4.y; wt[j][2] = a4.z; wt[j][3] = a4.w; wt[j][4] = b4.x; wt[j][5] = b4.y; wt[j][6] = b4.z; wt[j][7] = b4.w;
    }
    bfu* dst = rawQ + which * (64 * 136) + c8;
#pragma unroll
    for (int r = 0; r < 16; ++r) {
      u16x8 o;
#pragma unroll
      for (int c = 0; c < 8; ++c) {
        float v = wt[0][c] * bf2f(xr[r][c]) + wt[1][c] * bf2f(xr[r + 1][c]) + wt[2][c] * bf2f(xr[r + 2][c]) + wt[3][c] * bf2f(xr[r + 3][c]);
        o[c] = f2bf(siluf(v));
      }
      *(u16x8*)(dst + (t0 + r) * 136) = o;
    }
  }
  if (w == 3) {
    const float* ps = Ps + (r0 + lane) * 16;
    float be = sigm(ps[h]);
    float gl = -expf(p.in[6][layer * 4 + h]) * softplusf(ps[4 + h] + p.in[7][layer * 4 + h]);
    float s = wave_scan_incl(gl, lane);
    sm[128 + lane] = be;
    sm[192 + lane] = s;
  }
  __syncthreads();
  if (tid < 128) {
    int row = tid & 63, mat = tid >> 6;
    const bfu* rp = rawQ + mat * (64 * 136) + row * 136;
    float ss = 0.f;
    for (int c = 0; c < 128; ++c) { float v = bf2f(rp[c]); ss += v * v; }
    float sc = rsqrtf(ss + 1e-6f);
    if (mat == 0) sc *= 0.08838834764831845f;
    sm[mat * 64 + row] = sc;
  }
  __syncthreads();
  if (tid < 64) { float be = sm[128 + tid]; sm[256 + tid] = be; sm[320 + tid] = be * sm[64 + tid] * expf(sm[192 + tid]); }
  {
    bf16x8 kf[4], qf[4];
#pragma unroll
    for (int ks = 0; ks < 4; ++ks) {
      kf[ks] = *(const bf16x8*)(rawK + (16 * w + fr) * 136 + ks * 32 + fq * 8);
      qf[ks] = *(const bf16x8*)(rawQ + (16 * w + fr) * 136 + ks * 32 + fq * 8);
    }
    bfu* AMg = Xb + 32768;
    for (int tj = 0; tj < 4; ++tj) {
      if (tj <= w) {
        f32x4 akk = {0.f, 0.f, 0.f, 0.f}, aqk = {0.f, 0.f, 0.f, 0.f};
#pragma unroll
        for (int ks = 0; ks < 4; ++ks) {
          bf16x8 bk = *(const bf16x8*)(rawK + (16 * tj + fr) * 136 + ks * 32 + fq * 8);
          akk = MFMA16(kf[ks], bk, akk);
          aqk = MFMA16(qf[ks], bk, aqk);
        }
        int j = 16 * tj + fr;
        float rkj = sm[64 + j], gcj = sm[192 + j];
#pragma unroll
        for (int r = 0; r < 4; ++r) {
          int i = 16 * w + fq * 4 + r;
          float dec = (i >= j) ? expf(sm[192 + i] - gcj) : 0.f;
          aL[i * 68 + j] = (i > j) ? sm[128 + i] * sm[64 + i] * rkj * akk[r] * dec : 0.f;
          AMg[i * 64 + j] = f2bf((i >= j) ? sm[i] * rkj * aqk[r] * dec : 0.f);
        }
      } else {
#pragma unroll
        for (int r = 0; r < 4; ++r) AMg[(16 * w + fq * 4 + r) * 64 + 16 * tj + fr] = 0;
      }
    }
  }
  __syncthreads();
  {
    const bfu* src = (tid < 128) ? (rawV + tid) : (rawK + (tid - 128));
    const float* rs = sm + ((tid < 128) ? 256 : 320);
    float x[64];
#pragma unroll
    for (int i = 0; i < 64; ++i) {
      float a = bf2f(src[i * 136]) * rs[i];
#pragma unroll
      for (int j = 0; j < i; ++j) a -= aL[i * 68 + j] * x[j];
      x[i] = a;
    }
    if (tid < 128) {
      bfu* UT = Xb + 24576 + tid * 64;
#pragma unroll
      for (int i = 0; i < 64; i += 8) {
        u16x8 o;
#pragma unroll
        for (int j = 0; j < 8; ++j) o[j] = f2bf(x[i + j]);
        *(u16x8*)(UT + i) = o;
      }
    } else {
      bfu* Wg = Xb + 8192 + (tid - 128);
#pragma unroll
      for (int i = 0; i < 64; ++i) Wg[i * 128] = f2bf(x[i]);
    }
  }
  {
    bfu* QDg = Xb;
    bfu* KDTg = Xb + 16384;
    float gl_last = sm[192 + 63];
    for (int idx = tid; idx < 8192; idx += 256) { int i = idx >> 7, c = idx & 127; QDg[idx] = f2bf(bf2f(rawQ[i * 136 + c]) * sm[i] * expf(sm[192 + i])); }
    for (int idx = tid; idx < 8192; idx += 256) { int c = idx >> 6, i = idx & 63; KDTg[idx] = f2bf(bf2f(rawK[i * 136 + c]) * sm[64 + i] * expf(gl_last - sm[192 + i])); }
    if (tid < 128) SC[128 + tid] = expf(gl_last);
  }
  __syncthreads();
}

DI void ssd_prep_item(const Params& p, int layer, int item) {
  const int tid = TIDX, lane = tid & 63, w = tid >> 6, fr = lane & 15, fq = lane >> 4;
  const int g = item & 1, cn = item >> 1, n = cn % NCHK;
  const long r0 = (long)cn * 64;
  const bfu* P = (const bfu*)(p.ws + OFF_P);
  const float* Ps = (const float*)(p.ws + OFF_PS);
  bfu* Xb = (bfu*)(p.ws + OFF_X) + (long)cn * 131072;
  float* SCb = (float*)(p.ws + OFF_SC) + (long)cn * 8 * 256;
  bfu* Bm = (bfu*)g_smem;
  bfu* Cm = Bm + 64 * 136;
  float* cb = (float*)(g_smem + 34816);
  float* sm = (float*)(g_smem + 34816 + 17408);
  {
    int hd = g * 4 + w;
    float dtv = softplusf(Ps[(r0 + lane) * 16 + 8 + hd] + p.in[11][layer * 8 + hd]);
    float a = -dtv * expf(p.in[12][layer * 8 + hd]);
    float ac = wave_scan_incl(a, lane);
    sm[w * 64 + lane] = dtv;
    sm[256 + w * 64 + lane] = ac;
  }
  __syncthreads();
  const float* cw = p.in[9] + layer * 4 * 1024;
  const float* cbias = p.in[10] + layer * 1024;
  copy_z(p, P + r0 * 1536 + 1024 + g * 256, 1536, (bfu*)(p.ws + OFF_Z) + r0 * 512 + g * 256, 32);
  {
    const int cg8 = tid & 63, seg = tid >> 6, t0 = seg * 16;
    const int col = (cg8 < 16) ? 512 + g * 128 + cg8 * 8 : (cg8 < 32) ? 768 + g * 128 + (cg8 - 16) * 8 : g * 256 + (cg8 - 32) * 8;
    u16x8 xr[19];
    const bool nohist = (seg == 0 && n == 0);
#pragma unroll
    for (int i = 0; i < 19; ++i) {
      const bool valid = !(nohist && i < 3);
      const long rr = valid ? (r0 + t0 - 3 + i) : r0;
      u16x8 v = *(const u16x8*)(P + rr * 1536 + col);
      xr[i] = valid ? v : u16x8{0, 0, 0, 0, 0, 0, 0, 0};
    }
    float wt[4][8], bias[8];
#pragma unroll
    for (int j = 0; j < 4; ++j) {
      float4 a4 = *(const float4*)(cw + j * 1024 + col), b4 = *(const float4*)(cw + j * 1024 + col + 4);
      wt[j][0] = a4.x; wt[j][1] = a4.y; wt[j][2] = a4.z; wt[j][3] = a4.w; wt[j][4] = b4.x; wt[j][5] = b4.y; wt[j][6] = b4.z; wt[j][7] = b4.w;
    }
    {
      float4 a4 = *(const float4*)(cbias + col), b4 = *(const float4*)(cbias + col + 4);
      bias[0] = a4.x; bias[1] = a4.y; bias[2] = a4.z; bias[3] = a4.w; bias[4] = b4.x; bias[5] = b4.y; bias[6] = b4.z; bias[7] = b4.w;
    }
    if (cg8 < 32) {
      bfu* dst = (cg8 < 16) ? (Bm + cg8 * 8) : (Cm + (cg8 - 16) * 8);
#pragma unroll
      for (int r = 0; r < 16; ++r) {
        u16x8 o;
        const bool padrow = (n == 0 && t0 + r < 48);
#pragma unroll
        for (int c = 0; c < 8; ++c) {
          float v = wt[0][c] * bf2f(xr[r][c]) + wt[1][c] * bf2f(xr[r + 1][c]) + wt[2][c] * bf2f(xr[r + 2][c]) + wt[3][c] * bf2f(xr[r + 3][c]) + bias[c];
          o[c] = padrow ? (bfu)0 : f2bf(siluf(v));
        }
        *(u16x8*)(dst + (t0 + r) * 136) = o;
      }
    } else {
      const int hh = (cg8 - 32) >> 3, pp8 = ((cg8 - 32) & 7) * 8;
      bfu* vtb = Xb + 32768 + (g * 4 + hh) * 12288 + 4096;
      const float alast = sm[256 + hh * 64 + 63];
#pragma unroll
      for (int q4 = 0; q4 < 4; ++q4) {
        float dtv[4], ksv[4];
#pragma unroll
        for (int rr = 0; rr < 4; ++rr) {
          int t = t0 + q4 * 4 + rr;
          const bool padrow = (n == 0 && t < 48);
          dtv[rr] = padrow ? 0.f : sm[hh * 64 + t];
          ksv[rr] = expf(alast - sm[256 + hh * 64 + t]);
        }
#pragma unroll
        for (int c = 0; c < 8; ++c) {
          u16x4 oa, ob;
#pragma unroll
          for (int rr = 0; rr < 4; ++rr) {
            int r = q4 * 4 + rr;
            float v = wt[0][c] * bf2f(xr[r][c]) + wt[1][c] * bf2f(xr[r + 1][c]) + wt[2][c] * bf2f(xr[r + 2][c]) + wt[3][c] * bf2f(xr[r + 3][c]) + bias[c];
            float xd = siluf(v) * dtv[rr];
            oa[rr] = f2bf(xd);
            ob[rr] = f2bf(xd * ksv[rr]);
          }
          *(u16x4*)(vtb + (pp8 + c) * 64 + t0 + q4 * 4) = oa;
          *(u16x4*)(vtb + 4096 + (pp8 + c) * 64 + t0 + q4 * 4) = ob;
        }
      }
    }
  }
  __syncthreads();
  {
    bf16x8 cf[4];
#pragma unroll
    for (int ks = 0; ks < 4; ++ks) cf[ks] = *(const bf16x8*)(Cm + (16 * w + fr) * 136 + ks * 32 + fq * 8);
    for (int tj = 0; tj < 4; ++tj) {
      if (tj <= w) {
        f32x4 a = {0.f, 0.f, 0.f, 0.f};
#pragma unroll
        for (int ks = 0; ks < 4; ++ks) {
          bf16x8 bk = *(const bf16x8*)(Bm + (16 * tj + fr) * 136 + ks * 32 + fq * 8);
          a = MFMA16(cf[ks], bk, a);
        }
#pragma unroll
        for (int r = 0; r < 4; ++r) cb[(16 * w + fq * 4 + r) * 68 + 16 * tj + fr] = a[r];
      }
    }
    bfu* Cg = Xb + g * 16384;
    bfu* BTg = Cg + 8192;
    for (int idx = tid; idx < 8192; idx += 256) Cg[idx] = Cm[(idx >> 7) * 136 + (idx & 127)];
    for (int idx = tid; idx < 8192; idx += 256) BTg[idx] = Bm[(idx & 63) * 136 + (idx >> 6)];
  }
  __syncthreads();
  for (int hh = 0; hh < 4; ++hh) {
    int hd = g * 4 + hh;
    bfu* AMg = Xb + 32768 + hd * 12288;
    float Dh = p.in[13][layer * 8 + hd];
    const float* dtp = sm + hh * 64;
    const float* acp = sm + 256 + hh * 64;
    for (int idx = tid; idx < 4096; idx += 256) {
      int l = idx >> 6, m = idx & 63;
      float v = (m <= l) ? cb[l * 68 + m] * expf(acp[l] - acp[m]) : 0.f;
      if (m == l) v += Dh / dtp[l];
      AMg[idx] = f2bf(v);
    }
    float* sc = SCb + hd * 256;
    float alast = acp[63];
    if (tid < 64) { sc[tid] = expf(acp[tid]); sc[64 + tid] = expf(alast - acp[tid]); }
    else if (tid < 192) sc[128 + (tid - 64)] = expf(alast);
  }
  __syncthreads();
}

DI void hg_prep_item(const Params& p, int layer, int item) {
  const int tid = TIDX, lane = tid & 63, w = tid >> 6, fr = lane & 15, fq = lane >> 4;
  const int h = item & 3, cn = item >> 2;
  const long r0 = (long)cn * 64;
  const bfu* P = (const bfu*)(p.ws + OFF_P);
  const float* lbv = (const float*)(p.ws + OFF_LB);
  bfu* Xb = (bfu*)(p.ws + OFF_X) + (long)item * 28672;
  float* SC = (float*)(p.ws + OFF_SC) + (long)item * 256;
  bfu* Qall = (bfu*)g_smem;
  bfu* Ks = Qall + 160 * 136;
  float* segs = (float*)(g_smem + 60928);
  bfu* QDg = Xb;
  bfu* KDTg = Xb + 8192;
  bfu* AMg = Xb + 16384;
  bfu* VTg = Xb + 20480;
  copy_z(p, P + r0 * 2048 + 1536 + h * 128, 2048, (bfu*)(p.ws + OFF_Z) + r0 * 512 + h * 128, 16);
  {
    const int k8 = (tid & 15) * 8, rs = tid >> 4, t0 = rs * 4;
    u16x8 fr4[4], qr4[4], ir4[4];
    const bfu* base = P + (r0 + t0) * 2048 + h * 128 + k8;
#pragma unroll
    for (int r = 0; r < 4; ++r) {
      qr4[r] = *(const u16x8*)(base + (long)r * 2048);
      fr4[r] = *(const u16x8*)(base + (long)r * 2048 + 512);
      ir4[r] = *(const u16x8*)(base + (long)r * 2048 + 1024);
    }
    float lb[8];
    {
      float4 a4 = *(const float4*)(lbv + h * 128 + k8), b4 = *(const float4*)(lbv + h * 128 + k8 + 4);
      lb[0] = a4.x; lb[1] = a4.y; lb[2] = a4.z; lb[3] = a4.w; lb[4] = b4.x; lb[5] = b4.y; lb[6] = b4.z; lb[7] = b4.w;
    }
    float lf[4][8];
    float ssum[8];
#pragma unroll
    for (int c = 0; c < 8; ++c) ssum[c] = 0.f;
#pragma unroll
    for (int r = 0; r < 4; ++r)
#pragma unroll
      for (int c = 0; c < 8; ++c) {
        float zf = bf2f(fr4[r][c]);
        float f = lb[c] + (1.f - lb[c]) * (1.f / (1.f + expf(-zf)));
        lf[r][c] = logf(f);
        ssum[c] += lf[r][c];
      }
    *(float4*)(segs + rs * 128 + k8) = make_float4(ssum[0], ssum[1], ssum[2], ssum[3]);
    *(float4*)(segs + rs * 128 + k8 + 4) = make_float4(ssum[4], ssum[5], ssum[6], ssum[7]);
#pragma unroll
    for (int c = 0; c < 8; ++c) {
      u16x4 o = {ir4[0][c], ir4[1][c], ir4[2][c], ir4[3][c]};
      *(u16x4*)(VTg + (k8 + c) * 64 + t0) = o;
    }
    __syncthreads();
    float Gb[8], G1[8], G2[8], G3[8], GL[8];
#pragma unroll
    for (int c = 0; c < 8; ++c) { Gb[c] = 0.f; G1[c] = 0.f; G2[c] = 0.f; G3[c] = 0.f; GL[c] = 0.f; }
    for (int s2 = 0; s2 < 16; ++s2) {
      float4 a4 = *(const float4*)(segs + s2 * 128 + k8), b4 = *(const float4*)(segs + s2 * 128 + k8 + 4);
      float v[8] = {a4.x, a4.y, a4.z, a4.w, b4.x, b4.y, b4.z, b4.w};
#pragma unroll
      for (int c = 0; c < 8; ++c) {
        if (s2 < rs) Gb[c] += v[c];
        if (s2 < 4) G1[c] += v[c];
        if (s2 < 8) G2[c] += v[c];
        if (s2 < 12) G3[c] += v[c];
        GL[c] += v[c];
      }
    }
    const int Jt = rs >> 2;
    float G[8];
#pragma unroll
    for (int c = 0; c < 8; ++c) G[c] = Gb[c];
#pragma unroll
    for (int r = 0; r < 4; ++r) {
      const int t = t0 + r;
      u16x8 oq, oq1, oq2, oq3, ok;
#pragma unroll
      for (int c = 0; c < 8; ++c) {
        G[c] += lf[r][c];
        float zf = bf2f(fr4[r][c]);
        float kk = (1.f - lb[c]) * (1.f / (1.f + expf(zf)));
        float q = siluf(bf2f(qr4[r][c]));
        oq[c] = f2bf(q * expf(G[c]));
        oq1[c] = f2bf(q * expf(G[c] - G1[c]));
        oq2[c] = f2bf(q * expf(G[c] - G2[c]));
        oq3[c] = f2bf(q * expf(G[c] - G3[c]));
        float GJ = (Jt == 0) ? 0.f : (Jt == 1) ? G1[c] : (Jt == 2) ? G2[c] : G3[c];
        ok[c] = f2bf(kk * expf(fminf(GJ - G[c], 80.f)));
      }
      *(u16x8*)(QDg + t * 128 + k8) = oq;
      *(u16x8*)(Qall + t * 136 + k8) = oq;
      if (t >= 16) *(u16x8*)(Qall + (64 + t - 16) * 136 + k8) = oq1;
      if (t >= 32) *(u16x8*)(Qall + (112 + t - 32) * 136 + k8) = oq2;
      if (t >= 48) *(u16x8*)(Qall + (144 + t - 48) * 136 + k8) = oq3;
      *(u16x8*)(Ks + t * 136 + k8) = ok;
    }
#pragma unroll
    for (int c = 0; c < 8; ++c) {
      float Gc = Gb[c];
      u16x4 o;
#pragma unroll
      for (int r = 0; r < 4; ++r) {
        Gc += lf[r][c];
        float zf = bf2f(fr4[r][c]);
        float kk = (1.f - lb[c]) * (1.f / (1.f + expf(zf)));
        o[r] = f2bf(kk * expf(GL[c] - Gc));
      }
      *(u16x4*)(KDTg + (k8 + c) * 64 + t0) = o;
    }
    if (rs == 0) {
#pragma unroll
      for (int c = 0; c < 8; ++c) SC[128 + k8 + c] = expf(GL[c]);
    }
  }
  __syncthreads();
  for (int J = 0; J < 4; ++J) {
    if (J <= w) {
      int rowbase = (J == 0 ? 0 : J == 1 ? 64 : J == 2 ? 112 : 144) + 16 * (w - J);
      f32x4 a = {0.f, 0.f, 0.f, 0.f};
#pragma unroll
      for (int ks = 0; ks < 4; ++ks) {
        bf16x8 af = *(const bf16x8*)(Qall + (rowbase + fr) * 136 + ks * 32 + fq * 8);
        bf16x8 bk = *(const bf16x8*)(Ks + (16 * J + fr) * 136 + ks * 32 + fq * 8);
        a = MFMA16(af, bk, a);
      }
#pragma unroll
      for (int r = 0; r < 4; ++r) {
        int t = 16 * w + fq * 4 + r, s = 16 * J + fr;
        AMg[t * 64 + s] = f2bf((s <= t) ? a[r] : 0.f);
      }
    } else {
#pragma unroll
      for (int r = 0; r < 4; ++r) AMg[(16 * w + fq * 4 + r) * 64 + 16 * J + fr] = 0;
    }
  }
  __syncthreads();
}

struct LinArgs {
  const bfu* kdt; long kdt_cs;
  const bfu* vt; long vt_cs;
  const float* sc; long sc_cs;
  bfu* ss; long ss_cs;
  int kt0;
};
struct LinFrags { bf16x8 kf[2]; bf16x8 vf[2][2]; f32x4 dv; };
DI void lin_load(LinFrags& f, const LinArgs& e, int n, int w, int fr, int fq) {
#pragma unroll
  for (int ks = 0; ks < 2; ++ks) f.kf[ks] = *(const bf16x8*)(e.kdt + n * e.kdt_cs + ((e.kt0 + w) * 16 + fr) * 64 + ks * 32 + fq * 8);
#pragma unroll
  for (int jv = 0; jv < 2; ++jv)
#pragma unroll
    for (int ks = 0; ks < 2; ++ks) f.vf[jv][ks] = *(const bf16x8*)(e.vt + n * e.vt_cs + (jv * 16 + fr) * 64 + ks * 32 + fq * 8);
  f.dv = *(const f32x4*)(e.sc + n * e.sc_cs + 128 + (e.kt0 + w) * 16 + fq * 4);
}
template <int NST>
DI void engine_lin(const LinArgs& e) {
  const int tid = TIDX, lane = tid & 63, w = tid >> 6, fr = lane & 15, fq = lane >> 4;
  f32x4 S[2];
#pragma unroll
  for (int jv = 0; jv < 2; ++jv) S[jv] = f32x4{0.f, 0.f, 0.f, 0.f};
  LinFrags f[NST];
#pragma unroll
  for (int s = 0; s < NST - 1; ++s) lin_load(f[s], e, s, w, fr, fq);
  for (int n0 = 0; n0 < NCHK; n0 += NST) {
#pragma unroll
    for (int s = 0; s < NST; ++s) {
      const int n = n0 + s;
      if (n < NCHK) {
        int nl = n + NST - 1; if (nl > NCHK - 1) nl = NCHK - 1;
        lin_load(f[(s + NST - 1) % NST], e, nl, w, fr, fq);
        const LinFrags& c = f[s];
#pragma unroll
        for (int jv = 0; jv < 2; ++jv) {
          u16x4 pk = {f2bf(S[jv][0]), f2bf(S[jv][1]), f2bf(S[jv][2]), f2bf(S[jv][3])};
          *(u16x4*)(e.ss + n * e.ss_cs + (jv * 16 + fr) * 128 + (e.kt0 + w) * 16 + fq * 4) = pk;
        }
#pragma unroll
        for (int jv = 0; jv < 2; ++jv)
#pragma unroll
          for (int r = 0; r < 4; ++r) S[jv][r] *= c.dv[r];
#pragma unroll
        for (int ks = 0; ks < 2; ++ks)
#pragma unroll
          for (int jv = 0; jv < 2; ++jv) S[jv] = MFMA16(c.kf[ks], c.vf[jv][ks], S[jv]);
      }
    }
  }
}

struct GdnArgs {
  const bfu* w; const bfu* kdt; bfu* ut; long cs;
  const float* sc; long sc_cs;
  bfu* ss; long ss_cs;
};
struct GdnFrags { bf16x8 wf[4]; bf16x8 kf[2][2]; u16x4 v[2]; float dv; };
DI void gdn_load(GdnFrags& f, const GdnArgs& e, int n, int w, int fr, int fq) {
#pragma unroll
  for (int ks = 0; ks < 4; ++ks) f.wf[ks] = *(const bf16x8*)(e.w + n * e.cs + (16 * w + fr) * 128 + ks * 32 + fq * 8);
#pragma unroll
  for (int a = 0; a < 2; ++a)
#pragma unroll
    for (int ks = 0; ks < 2; ++ks) f.kf[a][ks] = *(const bf16x8*)(e.kdt + n * e.cs + ((2 * w + a) * 16 + fr) * 64 + ks * 32 + fq * 8);
#pragma unroll
  for (int jv = 0; jv < 2; ++jv) f.v[jv] = *(const u16x4*)(e.ut + n * e.cs + (jv * 16 + fr) * 64 + 16 * w + fq * 4);
  f.dv = e.sc[n * e.sc_cs + 128];
}
template <int NST>
DI void engine_gdn(const GdnArgs& e) {
  const int tid = TIDX, lane = tid & 63, w = tid >> 6, fr = lane & 15, fq = lane >> 4;
  char* VT = g_smem + 17408;
  f32x4 S[2][2];
#pragma unroll
  for (int a = 0; a < 2; ++a)
#pragma unroll
    for (int jv = 0; jv < 2; ++jv) S[a][jv] = f32x4{0.f, 0.f, 0.f, 0.f};
  GdnFrags f[NST];
#pragma unroll
  for (int s = 0; s < NST - 1; ++s) gdn_load(f[s], e, s, w, fr, fq);
  for (int n0 = 0; n0 < NCHK; n0 += NST) {
#pragma unroll
    for (int s = 0; s < NST; ++s) {
      const int n = n0 + s;
      if (n < NCHK) {
        int nl = n + NST - 1; if (nl > NCHK - 1) nl = NCHK - 1;
        gdn_load(f[(s + NST - 1) % NST], e, nl, w, fr, fq);
        const GdnFrags& c = f[s];
        char* STc = g_smem + (n & 1) * 8704;
#pragma unroll
        for (int a = 0; a < 2; ++a)
#pragma unroll
          for (int jv = 0; jv < 2; ++jv) {
            u16x4 pk = {f2bf(S[a][jv][0]), f2bf(S[a][jv][1]), f2bf(S[a][jv][2]), f2bf(S[a][jv][3])};
            *(u16x4*)(STc + ((jv * 16 + fr) * 136 + (2 * w + a) * 16 + fq * 4) * 2) = pk;
            *(u16x4*)(e.ss + n * e.ss_cs + (jv * 16 + fr) * 128 + (2 * w + a) * 16 + fq * 4) = pk;
          }
        __syncthreads();
        f32x4 av[2] = {f32x4{0.f, 0.f, 0.f, 0.f}, f32x4{0.f, 0.f, 0.f, 0.f}};
#pragma unroll
        for (int ks = 0; ks < 4; ++ks)
#pragma unroll
          for (int jv = 0; jv < 2; ++jv) {
            bf16x8 sf = *(const bf16x8*)(STc + ((jv * 16 + fr) * 136 + ks * 32 + fq * 8) * 2);
            av[jv] = MFMA16(c.wf[ks], sf, av[jv]);
          }
#pragma unroll
        for (int jv = 0; jv < 2; ++jv) {
          u16x4 pk;
#pragma unroll
          for (int r = 0; r < 4; ++r) pk[r] = f2bf(bf2f(c.v[jv][r]) - av[jv][r]);
          *(u16x4*)(VT + ((jv * 16 + fr) * 72 + 16 * w + fq * 4) * 2) = pk;
          *(u16x4*)(e.ut + n * e.cs + (jv * 16 + fr) * 64 + 16 * w + fq * 4) = pk;
        }
        __syncthreads();
#pragma unroll
        for (int a = 0; a < 2; ++a) {
#pragma unroll
          for (int jv = 0; jv < 2; ++jv)
#pragma unroll
            for (int r = 0; r < 4; ++r) S[a][jv][r] *= c.dv;
#pragma unroll
          for (int ks = 0; ks < 2; ++ks)
#pragma unroll
            for (int jv = 0; jv < 2; ++jv) {
              bf16x8 vf = *(const bf16x8*)(VT + ((jv * 16 + fr) * 72 + ks * 32 + fq * 8) * 2);
              S[a][jv] = MFMA16(c.kf[a][ks], vf, S[a][jv]);
            }
        }
      }
    }
  }
  __syncthreads();
}

template <int NVT, bool USE_RS>
DI void oproj_core(f32x4 (&acc)[NVT], const bfu* qd, const bfu* am, const bfu* st, const bfu* vt, const float* rsp, int w, int fr, int fq) {
#pragma unroll
  for (int jv = 0; jv < NVT; ++jv) acc[jv] = f32x4{0.f, 0.f, 0.f, 0.f};
#pragma unroll
  for (int ks = 0; ks < 4; ++ks) {
    bf16x8 qf = *(const bf16x8*)(qd + (16 * w + fr) * 128 + ks * 32 + fq * 8);
#pragma unroll
    for (int jv = 0; jv < NVT; ++jv) {
      bf16x8 sf = *(const bf16x8*)(st + (jv * 16 + fr) * 128 + ks * 32 + fq * 8);
      acc[jv] = MFMA16(qf, sf, acc[jv]);
    }
  }
  if (USE_RS) {
    f32x4 rs = *(const f32x4*)(rsp + 16 * w + fq * 4);
#pragma unroll
    for (int jv = 0; jv < NVT; ++jv)
#pragma unroll
      for (int r = 0; r < 4; ++r) acc[jv][r] *= rs[r];
  }
#pragma unroll
  for (int ks = 0; ks < 2; ++ks) {
    bf16x8 af = *(const bf16x8*)(am + (16 * w + fr) * 64 + ks * 32 + fq * 8);
#pragma unroll
    for (int jv = 0; jv < NVT; ++jv) {
      bf16x8 vf = *(const bf16x8*)(vt + (jv * 16 + fr) * 64 + ks * 32 + fq * 8);
      acc[jv] = MFMA16(af, vf, acc[jv]);
    }
  }
}
DI void oproj_head128(const bfu* qd, const bfu* am, const bfu* st, const bfu* vt, const bfu* zP, int zld, const float* nw, bfu* Yo) {
  const int tid = TIDX, lane = tid & 63, w = tid >> 6, fr = lane & 15, fq = lane >> 4;
  f32x4 acc[8];
  oproj_core<8, false>(acc, qd, am, st, vt, nullptr, w, fr, fq);
  float ss[4] = {0.f, 0.f, 0.f, 0.f};
#pragma unroll
  for (int jv = 0; jv < 8; ++jv)
#pragma unroll
    for (int r = 0; r < 4; ++r) ss[r] += acc[jv][r] * acc[jv][r];
#pragma unroll
  for (int r = 0; r < 4; ++r) {
    float s = ss[r];
    s += __shfl_xor(s, 1); s += __shfl_xor(s, 2); s += __shfl_xor(s, 4); s += __shfl_xor(s, 8);
    ss[r] = rsqrtf(s * (1.f / 128.f) + 1e-6f);
  }
#pragma unroll
  for (int jv = 0; jv < 8; ++jv) {
    float wv = nw[jv * 16 + fr];
#pragma unroll
    for (int r = 0; r < 4; ++r) {
      int tok = 16 * w + fq * 4 + r;
      float z = bf2f(zP[(long)tok * zld + jv * 16 + fr]);
      Yo[(long)tok * 512 + jv * 16 + fr] = f2bf(acc[jv][r] * ss[r] * wv * siluf(z));
    }
  }
}
DI void oproj_ssd(const bfu* Xb  , int g, const float* SCb, const bfu* SSb, const bfu* zP, const float* nw, bfu* Yo) {
  const int tid = TIDX, lane = tid & 63, w = tid >> 6, fr = lane & 15, fq = lane >> 4;
  f32x4 acc[4][4];
#pragma unroll
  for (int hh = 0; hh < 4; ++hh) {
    int hd = g * 4 + hh;
    oproj_core<4, true>(acc[hh], Xb + g * 16384, Xb + 32768 + hd * 12288, SSb + hd * 8192, Xb + 32768 + hd * 12288 + 4096, SCb + hd * 256, w, fr, fq);
  }
  float ss[4] = {0.f, 0.f, 0.f, 0.f};
#pragma unroll
  for (int hh = 0; hh < 4; ++hh)
#pragma unroll
    for (int jv = 0; jv < 4; ++jv)
#pragma unroll
      for (int r = 0; r < 4; ++r) {
        int tok = 16 * w + fq * 4 + r;
        float z = bf2f(zP[(long)tok * 512 + hh * 64 + jv * 16 + fr]);
        float y = acc[hh][jv][r] * siluf(z);
        acc[hh][jv][r] = y;
        ss[r] += y * y;
      }
#pragma unroll
  for (int r = 0; r < 4; ++r) {
    float s = ss[r];
    s += __shfl_xor(s, 1); s += __shfl_xor(s, 2); s += __shfl_xor(s, 4); s += __shfl_xor(s, 8);
    ss[r] = rsqrtf(s * (1.f / 256.f) + 1e-6f);
  }
#pragma unroll
  for (int hh = 0; hh < 4; ++hh)
#pragma unroll
    for (int jv = 0; jv < 4; ++jv) {
      float wv = nw[hh * 64 + jv * 16 + fr];
#pragma unroll
      for (int r = 0; r < 4; ++r) {
        int tok = 16 * w + fq * 4 + r;
        Yo[(long)tok * 512 + hh * 64 + jv * 16 + fr] = f2bf(acc[hh][jv][r] * ss[r] * wv);
      }
    }
}

DI float geluf(float x) { float u = 0.7978845608028654f * (x + 0.044715f * x * x * x); return 0.5f * x * (1.f + tanhf(u)); }

DI void phase_s5_gemm1(const Params& p) {
  const bfu* U2 = (const bfu*)(p.ws + OFF_U2);
  const bfu* Ms = (const bfu*)(p.ws + OFF_MS);
  float* Xloc = (float*)(p.ws + OFF_XLOC);
  for (int t = BIDX; t < 32 * 17; t += gridDim.x) {
    int g = t / 17, tm = t - g * 17;
    f32x4 acc[4][4];
    zero_acc<4>(acc);
    gemm_tile<4>(acc, U2 + ((long)g * 2176 + tm * 128) * 256, 256, Ms + (long)g * 128 * 256, 256, 256);
    ACC_FOREACH(4, { Xloc[((long)g * 2176 + tm * 128 + trow) * 128 + tcol] = acc[m][n][j]; })
  }
}
DI void phase_s5_scan(const Params& p, int layer) {
  float* Xloc = (float*)(p.ws + OFF_XLOC);
  bfu* Xst = (bfu*)(p.ws + OFF_XST);
  const int tid = TIDX;
  const int seg = tid >> 4, p16 = tid & 15;
  float* ex = (float*)g_smem;
  for (int it = BIDX; it < 256; it += gridDim.x) {
    const int g = it >> 3, b = (it >> 2) & 1, pq = it & 3;
    const int pr = pq * 16 + p16;
    const int idx = (layer * 32 + g) * 64 + pr;
    const float dt = expf(p.in[24][layer * 32 + g]);
    const float e1 = p.in[17][idx] * dt * 16.f, a1 = p.in[18][idx] * dt * 16.f;
    const float m16 = expf(e1);
    const float l16x = m16 * cosf(a1), l16y = m16 * sinf(a1);
    const int n0 = seg * 65, n1 = (n0 + 65 < 1028) ? n0 + 65 : 1028;
    const float* xl = Xloc + ((long)g * 2176 + b * 1028) * 128;
    bfu* xs = Xst + ((long)g * 2176 + b * 1028) * 128;
    float sre = 0.f, sim = 0.f;
#pragma unroll 13
    for (int n = n0; n < n1; ++n) {
      float lre = xl[(long)n * 128 + pr], lim = xl[(long)n * 128 + 64 + pr];
      float nre = l16x * sre - l16y * sim + lre;
      float nim = l16x * sim + l16y * sre + lim;
      sre = nre; sim = nim;
    }
    __syncthreads();
    ex[(seg * 16 + p16) * 2] = sre; ex[(seg * 16 + p16) * 2 + 1] = sim;
    __syncthreads();
    float cre = 0.f, cim = 0.f;
    {
      const float mL = expf(e1 * 65.f), aL = a1 * 65.f;
      const float lLx = mL * cosf(aL), lLy = mL * sinf(aL);
      for (int s2 = 0; s2 < seg; ++s2) {
        float ere = ex[(s2 * 16 + p16) * 2], eim = ex[(s2 * 16 + p16) * 2 + 1];
        float nre = lLx * cre - lLy * cim + ere;
        float nim = lLx * cim + lLy * cre + eim;
        cre = nre; cim = nim;
      }
    }
    sre = cre; sim = cim;
#pragma unroll 13
    for (int n = n0; n < n1; ++n) {
      float lre = xl[(long)n * 128 + pr], lim = xl[(long)n * 128 + 64 + pr];
      xs[(long)n * 128 + pr] = f2bf(sre);
      xs[(long)n * 128 + 64 + pr] = f2bf(sim);
      float nre = l16x * sre - l16y * sim + lre;
      float nim = l16x * sim + l16y * sre + lim;
      sre = nre; sim = nim;
    }
  }
}
DI void phase_s5_gemm2(const Params& p) {
  const bfu* U2 = (const bfu*)(p.ws + OFF_U2);
  const bfu* Xst = (const bfu*)(p.ws + OFF_XST);
  const bfu* Mc = (const bfu*)(p.ws + OFF_MC);
  bfu* Ys5 = (bfu*)(p.ws + OFF_YS5);
  for (int t = BIDX; t < 32 * 17 * 2; t += gridDim.x) {
    int g = t / 34, rem = t - g * 34, tm = rem >> 1, tn = rem & 1;
    f32x4 acc[4][4];
    zero_acc<4>(acc);
    const bfu* Bt = Mc + ((long)g * 256 + tn * 128) * 384;
    gemm_tile<4>(acc, U2 + ((long)g * 2176 + tm * 128) * 256, 256, Bt, 384, 256);
    gemm_tile<4>(acc, Xst + ((long)g * 2176 + tm * 128) * 128, 128, Bt + 256, 384, 128);
    ACC_FOREACH(4, {
      int nc = tm * 128 + trow, o = tn * 128 + tcol;
      if (nc < 2056) Ys5[((long)nc * 16 + (o >> 4)) * 512 + g * 16 + (o & 15)] = f2bf(geluf(acc[m][n][j]));
    })
  }
}
DI void phase_glu(const Params& p) {
  const bfu* Ys5 = (const bfu*)(p.ws + OFF_YS5);
  const bfu* Wg = (const bfu*)(p.ws + OFF_WGLU);
  const bfu* Pz = (const bfu*)(p.ws + OFF_PZ);
  bfu* Yd = (bfu*)(p.ws + OFF_Y) + (long)3 * TR * 512;
  for (int v = BIDX; v < 320 * 8; v += gridDim.x) {
    int tm, tn;
    if (!tile_map(v, 8, tm, tn)) continue;
    f32x4 acc[4][4];
    zero_acc<4>(acc);
    gemm_tile<4>(acc, Ys5 + (long)tm * 128 * 512, 512, Wg + (long)tn * 128 * 512, 512, 512);
    const int lane = TIDX & 63, wid = TIDX >> 6, wr = wid >> 1, wc = wid & 1, fr = lane & 15, fq = lane >> 4;
#pragma unroll
    for (int m = 0; m < 4; ++m)
#pragma unroll
      for (int n = 0; n < 2; ++n)
#pragma unroll
        for (int j = 0; j < 4; ++j) {
          int row = tm * 128 + wr * 64 + m * 16 + fq * 4 + j;
          int oc = tn * 64 + wc * 32 + n * 16 + fr;
          float z = bf2f(Pz[(long)row * 512 + oc]);
          Yd[(long)row * 512 + oc] = f2bf(acc[m][n][j] * sigm(acc[m][n + 2][j]) * siluf(z));
        }
  }
}
DI void phase_gates(const Params& p) {
  const bfu* h16 = (const bfu*)(p.ws + OFF_H16);
  const bfu* WT = (const bfu*)(p.ws + OFF_WIN);
  bfu* G = (bfu*)(p.ws + OFF_P);
  for (int v = BIDX; v < 320 * 32; v += gridDim.x) {
    int tm, tn;
    if (!tile_map(v, 32, tm, tn)) continue;
    f32x4 acc[4][4];
    zero_acc<4>(acc);
    gemm_tile<4>(acc, h16 + (long)tm * 128 * 1024, 1024, WT + (long)(6656 + tn * 128) * 1024, 1024, 1024);
    ACC_FOREACH(4, { G[(long)(tm * 128 + trow) * 4096 + tn * 128 + tcol] = f2bf(sigm(acc[m][n][j])); })
  }
}
DI void phase_merge(const Params& p) {
  const bfu* WbT = (const bfu*)(p.ws + OFF_WB);
  const bfu* Y = (const bfu*)(p.ws + OFF_Y);
  const bfu* G = (const bfu*)(p.ws + OFF_P);
  bfu* mixed = (bfu*)(p.ws + OFF_H16);
  for (int v = BIDX; v < 320 * 8; v += gridDim.x) {
    int tm, tn;
    if (!tile_map(v, 8, tm, tn)) continue;
    f32x4 tot[4][4];
    zero_acc<4>(tot);
    for (int b = 0; b < 4; ++b) {
      f32x4 acc[4][4];
      zero_acc<4>(acc);
      gemm_tile<4>(acc, Y + ((long)b * TR + tm * 128) * 512, 512, WbT + (long)(b * 1024 + tn * 128) * 512, 512, 512);
      ACC_FOREACH(4, { tot[m][n][j] += bf2f(G[(long)(tm * 128 + trow) * 4096 + b * 1024 + tn * 128 + tcol]) * acc[m][n][j]; })
    }
    ACC_FOREACH(4, { mixed[(long)(tm * 128 + trow) * 1024 + tn * 128 + tcol] = f2bf(tot[m][n][j]); })
  }
}
DI void phase_out(const Params& p) {
  const bfu* mixed = (const bfu*)(p.ws + OFF_H16);
  const bfu* WoT = (const bfu*)(p.ws + OFF_WO);
  float* h32 = (float*)(p.ws + OFF_H32);
  const float ALPHA = 1.6817928305074290f;
  for (int v = BIDX; v < 320 * 8; v += gridDim.x) {
    int tm, tn;
    if (!tile_map(v, 8, tm, tn)) continue;
    f32x4 acc[4][4];
    zero_acc<4>(acc);
    gemm_tile<4>(acc, mixed + (long)tm * 128 * 1024, 1024, WoT + (long)tn * 128 * 1024, 1024, 1024);
    ACC_FOREACH(4, {
      long a = (long)(tm * 128 + trow) * 1024 + tn * 128 + tcol;
      h32[a] = ALPHA * h32[a] + acc[m][n][j];
    })
  }
}

DI void run_phase(const Params& p, int ph) {
  if (ph == 0) { phase_tables(p); return; }
  if (ph == NPHASE - 1) { ln_rows(p, 3, true); return; }
  const int layer = (ph - 1) / NPL, sub = (ph - 1) % NPL;
  bfu* Xb = (bfu*)(p.ws + OFF_X);
  float* SC = (float*)(p.ws + OFF_SC);
  bfu* Y = (bfu*)(p.ws + OFF_Y);
  const bfu* Zb = (const bfu*)(p.ws + OFF_Z);
  const int bid = BIDX;
  switch (sub) {
    case 0: ln_rows(p, layer - 1, false); phase_convert(p, layer); break;
    case 1: phase_proj(p, 0, 2048, 0, true, 0); break;
    case 2: for (int it = bid; it < 2056; it += gridDim.x) gdn_prep_item(p, layer, it); break;
    case 3:
      if (bid < 32) {
        int b = bid >> 4, h = (bid >> 2) & 3, sl = bid & 3;
        GdnArgs e;
        bfu* base = Xb + ((long)(b * NCHK) * 4 + h) * 36864;
        e.w = base + 8192; e.kdt = base + 16384; e.ut = base + 24576 + sl * 32 * 64; e.cs = 4 * 36864;
        e.sc = SC + ((long)(b * NCHK) * 4 + h) * 256; e.sc_cs = 4 * 256;
        e.ss = Y + (long)TR * 512 + ((long)(b * NCHK) * 4 + h) * 16384 + sl * 32 * 128; e.ss_cs = 4 * 16384;
        engine_gdn<4>(e);
      } else phase_proj(p, 2048, 1536, 0, false, 32);
      break;
    case 4:
      for (int it = bid; it < 2056; it += gridDim.x) {
        int h = it & 3; long r0 = (long)(it >> 2) * 64;
        const bfu* base = Xb + (long)it * 36864;
        oproj_head128(base, base + 32768, Y + (long)TR * 512 + (long)it * 16384, base + 24576,
                      Zb + r0 * 512 + h * 128, 512, p.in[8] + layer * 128, Y + r0 * 512 + h * 128);
      }
      break;
    case 5: for (int it = bid; it < 1028; it += gridDim.x) ssd_prep_item(p, layer, it); break;
    case 6:
      if (bid < 64) {
        int b = bid >> 5, hd = (bid >> 2) & 7, sl = (bid >> 1) & 1, kh = bid & 1, g = hd >> 2;
        LinArgs e;
        const bfu* base = Xb + (long)(b * NCHK) * 131072;
        e.kdt = base + g * 16384 + 8192; e.kdt_cs = 131072;
        e.vt = base + 32768 + hd * 12288 + 8192 + sl * 32 * 64; e.vt_cs = 131072;
        e.sc = SC + ((long)(b * NCHK) * 8 + hd) * 256; e.sc_cs = 8 * 256;
        e.ss = Y + (long)2 * TR * 512 + ((long)(b * NCHK) * 8 + hd) * 8192 + sl * 32 * 128; e.ss_cs = 8 * 8192;
        e.kt0 = kh * 4;
        engine_lin<7>(e);
      } else phase_proj(p, 3584, 2048, 0, false, 64);
      break;
    case 7:
      for (int it = bid; it < 1028; it += gridDim.x) {
        int g = it & 1; long cn = it >> 1; long r0 = cn * 64;
        oproj_ssd(Xb + cn * 131072, g, SC + cn * 8 * 256, Y + (long)2 * TR * 512 + cn * 8 * 8192,
                  Zb + r0 * 512 + g * 256, p.in[14] + layer * 512 + g * 256, Y + (long)TR * 512 + r0 * 512 + g * 256);
      }
      break;
    case 8: for (int it = bid; it < 2056; it += gridDim.x) hg_prep_item(p, layer, it); break;
    case 9:
      if (bid < 64) {
        int b = bid >> 5, h = (bid >> 3) & 3, sl = (bid >> 1) & 3, kh = bid & 1;
        LinArgs e;
        const bfu* base = Xb + ((long)(b * NCHK) * 4 + h) * 28672;
        e.kdt = base + 8192; e.kdt_cs = 4 * 28672;
        e.vt = base + 20480 + sl * 32 * 64; e.vt_cs = 4 * 28672;
        e.sc = SC + ((long)(b * NCHK) * 4 + h) * 256; e.sc_cs = 4 * 256;
        bfu* ssb = b == 0 ? (Y + (long)3 * TR * 512) : (Xb + (long)2056 * 28672);
        e.ss = ssb + (long)h * 16384 + sl * 32 * 128; e.ss_cs = 4 * 16384;
        e.kt0 = kh * 4;
        engine_lin<7>(e);
      } else phase_proj(p, 5632, 1024, 1, false, 64);
      break;
    case 10:
      for (int it = bid; it < 2056; it += gridDim.x) {
        int h = it & 3; int cn = it >> 2; long r0 = (long)cn * 64;
        int b = cn / NCHK, n = cn - b * NCHK;
        const bfu* base = Xb + (long)it * 28672;
        const bfu* ssb = b == 0 ? (Y + (long)3 * TR * 512) : (Xb + (long)2056 * 28672);
        oproj_head128(base, base + 16384, ssb + ((long)n * 4 + h) * 16384, base + 20480,
                      Zb + r0 * 512 + h * 128, 512, p.in[16] + layer * 128, Y + (long)2 * TR * 512 + r0 * 512 + h * 128);
      }
      break;
    case 11: phase_s5_gemm1(p); break;
    case 12: phase_s5_scan(p, layer); break;
    case 13: phase_s5_gemm2(p); break;
    case 14: phase_glu(p); break;
    case 15: phase_gates(p); break;
    case 16: phase_merge(p); break;
    case 17: phase_out(p); break;
  }
}


#define XB_TMO      128
#define XB_XCNT(j)  (256  + 64 * (j))
#define XB_XSUB(j)  (1280 + 64 * (j))
#define XB_XGEN(j)  (2304 + 64 * (j))
#define XB_TOP      3328
#define XB_TOPGEN   3392
#define XCD_BAR_WORDS 3456
#define XB_SPIN_CAP (1u << 20)
#define LAS __attribute__((address_space(3)))
DI unsigned xb_ld(unsigned* p) { return __hip_atomic_load(p, __ATOMIC_RELAXED, __HIP_MEMORY_SCOPE_AGENT); }
DI unsigned xb_add(unsigned* p, unsigned v) { return __hip_atomic_fetch_add(p, v, __ATOMIC_RELAXED, __HIP_MEMORY_SCOPE_AGENT); }
DI unsigned xb_xcc_id() { return (unsigned)__builtin_amdgcn_s_getreg((3 << 11) | 20) & 0xFu; }
#define XB_SPIN(cond, bar) do { unsigned _sp = 0; while (cond) { __builtin_amdgcn_s_sleep(1); \
    if ((++_sp & 255u) == 0u) { if (xb_ld(&(bar)[XB_TMO])) break; if (_sp > XB_SPIN_CAP) { atomicAdd(&(bar)[XB_TMO], 1u); break; } } } } while (0)
struct XcdBarrier { unsigned* bar; unsigned x; volatile LAS unsigned* st; };
DI XcdBarrier xcd_barrier_post(unsigned* bar, volatile LAS unsigned* st) {
  XcdBarrier b; b.bar = bar; b.x = xb_xcc_id(); b.st = st;
  if (threadIdx.x == 0) (void)xb_add(&bar[XB_XCNT(b.x)], 1u);
  return b;
}
DI void xcd_barrier_complete(unsigned* bar, unsigned x, unsigned& nloc, unsigned& nx) {
  const unsigned G = gridDim.x * gridDim.y * gridDim.z;
  unsigned sum, cnt, mine, sp = 0u;
  for (;;) {
    sum = 0u; cnt = 0u; mine = 0u;
#pragma unroll
    for (unsigned j = 0; j < 16; ++j) { const unsigned c = xb_ld(&bar[XB_XCNT(j)]); sum += c; cnt += (c > 0u) ? 1u : 0u; mine = (j == x) ? c : mine; }
    if (sum == G) break;
    __builtin_amdgcn_s_sleep(1);
    if ((++sp & 255u) == 0u) { if (xb_ld(&bar[XB_TMO])) break; if (sp > XB_SPIN_CAP) { atomicAdd(&bar[XB_TMO], 1u); break; } }
  }
  nloc = mine > 0u ? mine : 1u; nx = cnt > 0u ? cnt : 1u;
}
DI void xcd_barrier(const XcdBarrier& b) {
  asm volatile("s_waitcnt vmcnt(0)" ::: "memory");
  __syncthreads();
  if (threadIdx.x == 0) {
    unsigned* bar = b.bar;
    __builtin_amdgcn_s_waitcnt(0);
    unsigned nloc = b.st[0], nx = b.st[1];
    if (nloc == 0u) { xcd_barrier_complete(bar, b.x, nloc, nx); b.st[0] = nloc; b.st[1] = nx; }
    const unsigned old = xb_add(&bar[XB_XSUB(b.x)], 1u);
    const unsigned gen = old / nloc;
    if (old + 1u == (gen + 1u) * nloc) {
      __builtin_amdgcn_fence(__ATOMIC_RELEASE, "agent");
      asm volatile("s_waitcnt vmcnt(0)" ::: "memory");
      const unsigned og = xb_add(&bar[XB_TOP], 1u);
      const unsigned tg = og / nx;
      if (og + 1u == (tg + 1u) * nx) xb_add(&bar[XB_TOPGEN], 1u);
      else XB_SPIN(xb_ld(&bar[XB_TOPGEN]) == tg, bar);
      __builtin_amdgcn_fence(__ATOMIC_ACQUIRE, "agent");
      xb_add(&bar[XB_XGEN(b.x)], 1u);
      asm volatile("s_waitcnt vmcnt(0)" ::: "memory");
    } else {
      XB_SPIN(xb_ld(&bar[XB_XGEN(b.x)]) == gen, bar);
      __builtin_amdgcn_fence(__ATOMIC_ACQUIRE, "agent");
      asm volatile("s_waitcnt vmcnt(0)" ::: "memory");
    }
  }
  __syncthreads();
}
#ifndef DBL_MASK
#define DBL_MASK 0
#endif
#ifndef TIMING_PROBE
#define TIMING_PROBE 0
#endif
#ifndef TP_MASK_A
#define TP_MASK_A 0
#endif
#ifndef TP_MASK_B
#define TP_MASK_B 0
#endif
__global__ void __launch_bounds__(256, 2) mega_kernel(Params p, int ph_lo, int ph_hi) {
  if (ph_hi - ph_lo == 1) { run_phase(p, ph_lo); return; }
  cg::grid_group grid = cg::this_grid();
  volatile LAS unsigned* xst = (volatile LAS unsigned*)(g_smem + LDS_BYTES - 16);
  if (threadIdx.x == 0) { xst[0] = 0u; xst[1] = 0u; xst[2] = 0u; xst[3] = 0u; }
  __syncthreads();
  XcdBarrier xb = xcd_barrier_post((unsigned*)(p.ws + OFF_BAR), xst);
  for (int ph = ph_lo; ph < ph_hi; ++ph) {
    run_phase(p, ph);
#if DBL_MASK
    if (ph > 0 && ph < NPHASE - 1 && ((DBL_MASK >> ((ph - 1) % NPL)) & 1)) { xcd_barrier(xb); run_phase(p, ph); }
#endif
    if (ph + 1 < ph_hi) {
      if (ph == ph_lo) grid.sync();
      else xcd_barrier(xb);
    }
  }
}

extern "C" void kernel_launch(void* const* d_in, const int* in_sizes, int n_in, void* d_out, int out_size, void* d_ws, size_t ws_size,
                              hipStream_t stream) {
  static int grid_blocks = 0;
  if (!grid_blocks) {
    int dev = 0, cus = 0, per_cu = 0;
    hipGetDevice(&dev);
    hipDeviceGetAttribute(&cus, hipDeviceAttributeMultiprocessorCount, dev);
    hipFuncSetAttribute((const void*)mega_kernel, hipFuncAttributeMaxDynamicSharedMemorySize, LDS_BYTES);
    hipOccupancyMaxActiveBlocksPerMultiprocessor(&per_cu, mega_kernel, 256, LDS_BYTES);
    if (per_cu > 2) per_cu = 2;
    if (per_cu < 1) per_cu = 1;
    grid_blocks = cus * per_cu;
  }
  if (ws_size < WS_NEEDED) { fprintf(stderr, "workspace too small: %zu < %zu\n", ws_size, WS_NEEDED); return; }
  Params p{};
  for (int i = 0; i < 31; ++i) p.in[i] = (const float*)d_in[i];
  p.out = (float*)d_out;
  p.ws = (char*)d_ws;
#if MULTI_LAUNCH
  for (int ph = 0; ph < NPHASE; ++ph) {
    hipLaunchKernelGGL(mega_kernel, dim3(grid_blocks), dim3(256), LDS_BYTES, stream, p, ph, ph + 1);
  }
#else
  int lo = 0, hi = NPHASE;
  hipMemsetAsync((char*)d_ws + OFF_BAR, 0, 16384, stream);
  void* args[] = {&p, &lo, &hi};
  hipError_t e = hipLaunchCooperativeKernel((void*)mega_kernel, dim3(grid_blocks), dim3(256), args, LDS_BYTES, stream);
  if (e != hipSuccess) fprintf(stderr, "cooperative launch failed: %s (grid %d)\n", hipGetErrorString(e), grid_blocks);
#endif
}
```

```cpp
#include <hip/hip_runtime.h>
#include <hip/hip_cooperative_groups.h>
#include <cstdio>
namespace cg = cooperative_groups;

typedef unsigned short bfu;
using bf16x8 = __attribute__((ext_vector_type(8))) short;
using f32x4 = __attribute__((ext_vector_type(4))) float;
using u16x4 = __attribute__((ext_vector_type(4))) unsigned short;
using u16x8 = __attribute__((ext_vector_type(8))) unsigned short;
#define DI __device__ __forceinline__
#define MFMA16(a, b, c) __builtin_amdgcn_mfma_f32_16x16x32_bf16((a), (b), (c), 0, 0, 0)

#ifndef PH_MASK
#define PH_MASK 0xFFFFFF
#endif
#ifndef MULTI_LAUNCH
#define MULTI_LAUNCH 0
#endif

constexpr int TR = 32896;
constexpr int NCHK = 257;
constexpr int LBATCH = 16448;
constexpr int LDS_BYTES = 73728;
constexpr int NPL = 18;
constexpr int NPHASE = 1 + 4 * NPL + 1;

constexpr size_t OFF_H32 = 0;
constexpr size_t OFF_H16 = 134742016;
constexpr size_t OFF_Y = 202113024;
constexpr size_t OFF_P = 336855040;
constexpr size_t OFF_X = 471597056;
constexpr size_t OFF_SC = 623181824;
constexpr size_t OFF_PS = 627392512;
constexpr size_t OFF_W = 629497856;
constexpr size_t OFF_WIN = OFF_W;
constexpr size_t OFF_WS = OFF_WIN + 22020096;
constexpr size_t OFF_WGLU = OFF_WS + 32768;
constexpr size_t OFF_WB = OFF_WGLU + 1048576;
constexpr size_t OFF_WO = OFF_WB + 4194304;
constexpr size_t OFF_MS = OFF_WO + 2097152;
constexpr size_t OFF_MC = OFF_MS + 2097152;
constexpr size_t OFF_LB = OFF_MC + 6291456;
constexpr size_t OFF_LP = OFF_LB + 2048;
constexpr size_t OFF_BB = OFF_LP + 1114112;
constexpr size_t OFF_BAR = OFF_BB + 1048576;
constexpr size_t OFF_Z = OFF_BAR + 16384;
constexpr size_t WS_NEEDED = OFF_Z + 33685504;
constexpr size_t OFF_PZ = OFF_P;
constexpr size_t OFF_U2 = OFF_P + 33685504;
constexpr size_t OFF_YS5 = OFF_U2 + 35651584;
constexpr size_t OFF_XLOC = OFF_X;
constexpr size_t OFF_XST = OFF_X + 35651584;

struct Params {
  const float* in[31];
  float* out;
  char* ws;
};

extern __shared__ __attribute__((aligned(16))) char g_smem[];
DI int tid_laundered() { int t = threadIdx.x; asm volatile("" : "+v"(t)); return t; }
DI int bid_laundered() { int b = blockIdx.x; asm volatile("" : "+s"(b)); return b; }
#define TIDX tid_laundered()
#define BIDX bid_laundered()


DI bfu f2bf(float x) { unsigned u = __float_as_uint(x); u += 0x7fffu + ((u >> 16) & 1u); return (bfu)(u >> 16); }
DI float bf2f(bfu b) { return __uint_as_float(((unsigned)b) << 16); }
DI float sigm(float x) { return 1.f / (1.f + __expf(-x)); }
DI float siluf(float x) { return x / (1.f + __expf(-x)); }
DI float softplusf(float x) { return x > 20.f ? x : log1pf(expf(x)); }
DI float wave_sum(float v) {
#pragma unroll
  for (int m = 32; m >= 1; m >>= 1) v += __shfl_xor(v, m);
  return v;
}
DI float wave_scan_incl(float s, int lane) {
#pragma unroll
  for (int d = 1; d < 64; d <<= 1) { float o = __shfl_up(s, d); if (lane >= d) s += o; }
  return s;
}

template <int NREP>
DI void gemm_stage(const bfu* __restrict__ A, int lda, const bfu* __restrict__ Bt, int ldb, int kt, char* buf, int tid) {
#pragma unroll
  for (int i = 0; i < 2; ++i) {
    int b = tid * 16 + i * 4096; int r = b >> 6, c = (b & 63) >> 1;
    __builtin_amdgcn_global_load_lds((const unsigned*)(A + (long)r * lda + kt + c), (unsigned*)(buf + b), 16, 0, 0);
  }
#pragma unroll
  for (int i = 0; i < NREP / 2; ++i) {
    int b = tid * 16 + i * 4096; int r = b >> 6, c = (b & 63) >> 1;
    __builtin_amdgcn_global_load_lds((const unsigned*)(Bt + (long)r * ldb + kt + c), (unsigned*)(buf + 8192 + b), 16, 0, 0);
  }
}
template <int NREP>
DI void gemm_tile(f32x4 (&acc)[4][NREP], const bfu* __restrict__ A, int lda, const bfu* __restrict__ Bt, int ldb, int K) {
  const int tid = TIDX, lane = tid & 63, wid = tid >> 6, wr = wid >> 1, wc = wid & 1, fr = lane & 15, fq = lane >> 4;
  constexpr int GL = 2 + NREP / 2;
  const int nk = K >> 5;
  __syncthreads();
#pragma unroll
  for (int s = 0; s < 3; ++s)
    if (s < nk) gemm_stage<NREP>(A, lda, Bt, ldb, s * 32, g_smem + s * 16384, tid);
  for (int i = 0; i < nk; ++i) {
    const int younger = nk - 1 - i;
    if (younger >= 2) asm volatile("s_waitcnt vmcnt(%0)" ::"n"(2 * GL) : "memory");
    else if (younger == 1) asm volatile("s_waitcnt vmcnt(%0)" ::"n"(GL) : "memory");
    else asm volatile("s_waitcnt vmcnt(0)" ::: "memory");
    __builtin_amdgcn_s_barrier();
    if (i + 3 < nk) gemm_stage<NREP>(A, lda, Bt, ldb, (i + 3) * 32, g_smem + ((i + 3) & 3) * 16384, tid);
    const char* SA = g_smem + (i & 3) * 16384;
    const char* SB = SA + 8192;
    bf16x8 af[4], bfr[NREP];
#pragma unroll
    for (int m = 0; m < 4; ++m) af[m] = *(const bf16x8*)(SA + (wr * 64 + m * 16 + fr) * 64 + fq * 16);
#pragma unroll
    for (int n = 0; n < NREP; ++n) bfr[n] = *(const bf16x8*)(SB + (wc * (NREP * 16) + n * 16 + fr) * 64 + fq * 16);
#pragma unroll
    for (int m = 0; m < 4; ++m)
#pragma unroll
      for (int n = 0; n < NREP; ++n) acc[m][n] = MFMA16(af[m], bfr[n], acc[m][n]);
  }
}
template <int NREP>
DI void zero_acc(f32x4 (&acc)[4][NREP]) {
#pragma unroll
  for (int m = 0; m < 4; ++m)
#pragma unroll
    for (int n = 0; n < NREP; ++n) acc[m][n] = f32x4{0.f, 0.f, 0.f, 0.f};
}
#define ACC_FOREACH(NREP_, ...)                                                                \
  {                                                                                              \
    const int lane_ = TIDX & 63, wid_ = TIDX >> 6, wr_ = wid_ >> 1, wc_ = wid_ & 1; \
    const int fr_ = lane_ & 15, fq_ = lane_ >> 4;                                                \
    _Pragma("unroll") for (int m = 0; m < 4; ++m) _Pragma("unroll") for (int n = 0; n < NREP_; ++n) \
        _Pragma("unroll") for (int j = 0; j < 4; ++j) {                                          \
      const int trow = wr_ * 64 + m * 16 + fq_ * 4 + j;                                          \
      const int tcol = wc_ * (NREP_ * 16) + n * 16 + fr_;                                        \
      __VA_ARGS__                                                                                \
    }                                                                                            \
  }

DI void phase_tables(const Params& p) {
  const int gtid = BIDX * 256 + TIDX, gth = gridDim.x * 256;
  float2* LP = (float2*)(p.ws + OFF_LP);
  float2* BB = (float2*)(p.ws + OFF_BB);
  for (int idx = gtid; idx < 4 * 32 * 64; idx += gth) {
    int l = idx >> 11, g = (idx >> 6) & 31;
    float dt = expf(p.in[24][l * 32 + g]);
    float are = p.in[17][idx], aim = p.in[18][idx];
    float e1 = are * dt, a1 = aim * dt;
    for (int d = 0; d <= 16; ++d) {
      float mag = expf((float)d * e1), ang = (float)d * a1;
      LP[(long)idx * 17 + d] = make_float2(mag * cosf(ang), mag * sinf(ang));
    }
    float mag = expf(e1);
    float lre = mag * cosf(a1), lim = mag * sinf(a1);
    float den = are * are + aim * aim;
    float nr = lre - 1.f, ni = lim;
    float zre = (nr * are + ni * aim) / den, zim = (ni * are - nr * aim) / den;
    for (int c = 0; c < 16; ++c) {
      float bre = p.in[19][(long)idx * 16 + c], bim = p.in[20][(long)idx * 16 + c];
      BB[(long)idx * 16 + c] = make_float2(zre * bre - zim * bim, zre * bim + zim * bre);
    }
  }
}

DI void ln_rows(const Params& p, int layer, bool final_) {
  float* h32 = (float*)(p.ws + OFF_H32);
  bfu* h16 = (bfu*)(p.ws + OFF_H16);
  const int lane = TIDX & 63;
  const int gw = BIDX * 4 + (TIDX >> 6), nw = gridDim.x * 4;
  const float* gam = layer < 0 ? p.in[2] : p.in[29] + layer * 1024;
  const float* bet = layer < 0 ? p.in[3] : p.in[30] + layer * 1024;
  for (int r = gw; r < TR; r += nw) {
    int b = r / LBATCH, pos = r - b * LBATCH;
    float* d32 = h32 + (long)r * 1024;
    bfu* d16 = h16 + (long)r * 1024;
    if (pos < 48) {
      if (!final_) {
#pragma unroll
        for (int i = 0; i < 4; ++i) {
          *(float4*)(d32 + i * 256 + lane * 4) = make_float4(0.f, 0.f, 0.f, 0.f);
          *(u16x4*)(d16 + i * 256 + lane * 4) = u16x4{0, 0, 0, 0};
        }
      }
      continue;
    }
    const float* src;
    if (layer < 0) src = pos < 64 ? p.in[1] + (pos - 48) * 1024 : p.in[0] + ((long)b * 16384 + (pos - 64)) * 1024;
    else src = d32;
    float4 v[4];
    float s = 0.f;
#pragma unroll
    for (int i = 0; i < 4; ++i) { v[i] = *(const float4*)(src + i * 256 + lane * 4); s += v[i].x + v[i].y + v[i].z + v[i].w; }
    float mu = wave_sum(s) * (1.f / 1024.f);
    float q = 0.f;
#pragma unroll
    for (int i = 0; i < 4; ++i) {
      v[i].x -= mu; v[i].y -= mu; v[i].z -= mu; v[i].w -= mu;
      q += v[i].x * v[i].x + v[i].y * v[i].y + v[i].z * v[i].z + v[i].w * v[i].w;
    }
    float rs = rsqrtf(wave_sum(q) * (1.f / 1024.f) + 1e-5f);
#pragma unroll
    for (int i = 0; i < 4; ++i) {
      float4 g4 = *(const float4*)(gam + i * 256 + lane * 4), b4 = *(const float4*)(bet + i * 256 + lane * 4);
      float4 o = make_float4(v[i].x * rs * g4.x + b4.x, v[i].y * rs * g4.y + b4.y, v[i].z * rs * g4.z + b4.z, v[i].w * rs * g4.w + b4.w);
      if (final_) {
        if (pos >= 64) *(float4*)(p.out + ((long)b * 16384 + (pos - 64)) * 1024 + i * 256 + lane * 4) = o;
      } else {
        *(float4*)(d32 + i * 256 + lane * 4) = o;
        *(u16x4*)(d16 + i * 256 + lane * 4) = u16x4{f2bf(o.x), f2bf(o.y), f2bf(o.z), f2bf(o.w)};
      }
    }
  }
}

template <class F>
DI void conv_T(bfu* dst, int N, int K, F src) {
  const long gtid = BIDX * 256 + TIDX, gth = (long)gridDim.x * 256;
  const long total = (long)N * (K / 8);
  for (long idx = gtid; idx < total; idx += gth) {
    int n = (int)(idx % N); int kg = (int)(idx / N);
    u16x8 o;
#pragma unroll
    for (int j = 0; j < 8; ++j) o[j] = f2bf(src(kg * 8 + j, n));
    *(u16x8*)(dst + (long)n * K + kg * 8) = o;
  }
}

DI void phase_convert(const Params& p, int l) {
  const float* win = p.in[4] + (long)l * 1024 * 10768;
  conv_T((bfu*)(p.ws + OFF_WIN), 10752, 1024, [&](int k, int n) {
    int sc = n < 2048 ? n : n < 3584 ? n + 8 : n < 5632 ? n + 16 : n < 6656 ? n + 16 : n + 16;
    return win[(long)k * 10768 + sc];
  });
  conv_T((bfu*)(p.ws + OFF_WS), 16, 1024, [&](int k, int n) { int sc = n < 8 ? 2048 + n : 3592 + (n - 8); return win[(long)k * 10768 + sc]; });
  const float* w1 = p.in[25] + (long)l * 512 * 512;
  const float* w2 = p.in[26] + (long)l * 512 * 512;
  conv_T((bfu*)(p.ws + OFF_WGLU), 1024, 512, [&](int k, int r) {
    int j = r >> 7, wc = (r >> 6) & 1, n = (r >> 4) & 3, fr = r & 15;
    int oc = j * 64 + wc * 32 + (n & 1) * 16 + fr;
    return (n >> 1) ? w2[k * 512 + oc] : w1[k * 512 + oc];
  });
  const float* wb = p.in[27] + (long)l * 4 * 512 * 1024;
  conv_T((bfu*)(p.ws + OFF_WB), 4096, 512, [&](int k, int r) { int b = r >> 10, n = r & 1023; return wb[((long)b * 512 + k) * 1024 + n]; });
  const float* wo = p.in[28] + (long)l * 1024 * 1024;
  conv_T((bfu*)(p.ws + OFF_WO), 1024, 1024, [&](int k, int n) { return wo[(long)k * 1024 + n]; });
  const int gtid = BIDX * 256 + TIDX, gth = gridDim.x * 256;
  float* lbv = (float*)(p.ws + OFF_LB);
  for (int c = gtid; c < 512; c += gth) {
    float v0 = p.in[15][c], v1 = p.in[15][512 + c], v2 = p.in[15][1024 + c], v3 = p.in[15][1536 + c];
    float mx = fmaxf(fmaxf(v0, v1), fmaxf(v2, v3));
    float e0 = expf(v0 - mx), e1 = expf(v1 - mx), e2 = expf(v2 - mx), e3 = expf(v3 - mx);
    float inv = 1.f / (e0 + e1 + e2 + e3);
    float acc = 0.f;
    if (l >= 1) acc += e1 * inv;
    if (l >= 2) acc += e2 * inv;
    if (l >= 3) acc += e3 * inv;
    lbv[c] = acc;
  }
  const float2* LP = (const float2*)(p.ws + OFF_LP) + (long)l * 32 * 64 * 17;
  const float2* BB = (const float2*)(p.ws + OFF_BB) + (long)l * 32 * 64 * 16;
  const float* cre = p.in[21] + (long)l * 32 * 16 * 64;
  const float* cim = p.in[22] + (long)l * 32 * 16 * 64;
  const float* dd = p.in[23] + l * 512;
  bfu* Ms = (bfu*)(p.ws + OFF_MS);
  bfu* Mc = (bfu*)(p.ws + OFF_MC);
  for (int idx = gtid; idx < 32 * 128 * 256; idx += gth) {
    int g = idx >> 15, pp = (idx >> 8) & 127, kk = idx & 255;
    int s = kk >> 4, c2 = kk & 15, pr = pp & 63;
    float2 lp = LP[((long)g * 64 + pr) * 17 + (15 - s)];
    float2 bb = BB[((long)g * 64 + pr) * 16 + c2];
    float v = pp < 64 ? lp.x * bb.x - lp.y * bb.y : lp.x * bb.y + lp.y * bb.x;
    Ms[idx] = f2bf(v);
  }
  for (int idx = gtid; idx < 32 * 256 * 384; idx += gth) {
    int g = idx / (256 * 384); int rem = idx - g * (256 * 384);
    int o = rem / 384, kk = rem - o * 384;
    int t = o >> 4, c = o & 15;
    float v = 0.f;
    const float* cr = cre + ((long)g * 16 + c) * 64;
    const float* ci = cim + ((long)g * 16 + c) * 64;
    if (kk < 256) {
      int s = kk >> 4, c2 = kk & 15;
      if (t >= s) {
        int d = t - s;
        for (int pr = 0; pr < 64; ++pr) {
          float2 lp = LP[((long)g * 64 + pr) * 17 + d];
          float2 bb = BB[((long)g * 64 + pr) * 16 + c2];
          float ere = lp.x * bb.x - lp.y * bb.y, eim = lp.x * bb.y + lp.y * bb.x;
          v += cr[pr] * ere - ci[pr] * eim;
        }
        if (kk == o) v += dd[g * 16 + c];
      }
    } else {
      int pp = kk - 256, pr = pp & 63;
      float2 lp = LP[((long)g * 64 + pr) * 17 + (t + 1)];
      v = pp < 64 ? cr[pr] * lp.x - ci[pr] * lp.y : -(cr[pr] * lp.y + ci[pr] * lp.x);
    }
    Mc[idx] = f2bf(v);
  }
}

DI bool tile_map(int v, int ntn, int& tm, int& tn) {
  const int x = v & 7, j = v >> 3, sidx = j >> 5, within = j & 31, ntng = ntn >> 2;
  const int gq = sidx / ntng, tng = sidx - gq * ntng;
  tm = (gq * 8 + x) * 8 + (within >> 2);
  tn = tng * 4 + (within & 3);
  return tm < 257;
}
DI void phase_proj(const Params& p, int wrow0, int ncols, int mode, bool with_small, int boff) {
  const bfu* h16 = (const bfu*)(p.ws + OFF_H16);
  const bfu* WT = (const bfu*)(p.ws + OFF_WIN);
  bfu* P = (bfu*)(p.ws + OFF_P);
  bfu* U2 = (bfu*)(p.ws + OFF_U2);
  const int ntn = ncols >> 7;
  const int G = gridDim.x - boff;
  for (int v = BIDX - boff; v < 320 * ntn; v += G) {
    int tm, tn;
    if (!tile_map(v, ntn, tm, tn)) continue;
    {
      f32x4 acc[4][4];
      zero_acc<4>(acc);
      gemm_tile<4>(acc, h16 + (long)tm * 128 * 1024, 1024, WT + (long)(wrow0 + tn * 128) * 1024, 1024, 1024);
      if (mode == 0) {
        ACC_FOREACH(4, { P[(long)(tm * 128 + trow) * ncols + tn * 128 + tcol] = f2bf(acc[m][n][j]); })
      } else {
        ACC_FOREACH(4, {
          int row = tm * 128 + trow, col = tn * 128 + tcol;
          if (col < 512) { int g = col >> 4, c2 = col & 15; U2[((long)g * 2176 + (row >> 4)) * 256 + (row & 15) * 16 + c2] = f2bf(acc[m][n][j]); }
          else P[(long)row * 512 + (col - 512)] = f2bf(acc[m][n][j]);
        })
      }
    }
  }
  if (with_small) for (int tm = BIDX - boff; tm < 257; tm += G) {
    {
      const int lane = TIDX & 63, w = TIDX >> 6, fr = lane & 15, fq = lane >> 4;
      const bfu* WsT = (const bfu*)(p.ws + OFF_WS);
      float* Ps = (float*)(p.ws + OFF_PS);
      f32x4 a0 = {0.f, 0.f, 0.f, 0.f}, a1 = {0.f, 0.f, 0.f, 0.f};
      const bfu* pa0 = h16 + (long)(tm * 128 + w * 32 + fr) * 1024 + fq * 8;
      const bfu* pa1 = pa0 + 16 * 1024;
      const bfu* pb = WsT + fr * 1024 + fq * 8;
      for (int k = 0; k < 1024; k += 32) {
        bf16x8 x0 = *(const bf16x8*)(pa0 + k), x1 = *(const bf16x8*)(pa1 + k), y = *(const bf16x8*)(pb + k);
        a0 = MFMA16(x0, y, a0);
        a1 = MFMA16(x1, y, a1);
      }
#pragma unroll
      for (int j = 0; j < 4; ++j) {
        Ps[(long)(tm * 128 + w * 32 + fq * 4 + j) * 16 + fr] = a0[j];
        Ps[(long)(tm * 128 + w * 32 + 16 + fq * 4 + j) * 16 + fr] = a1[j];
      }
    }
  }
}

DI void copy_z(const Params& p, const bfu* src, int sld, bfu* dst, int pieces_per_row) {
  const int tid = TIDX;
  const int total = 64 * pieces_per_row;
  for (int i = tid; i < total; i += 256) {
    int r = i / pieces_per_row, c = i - r * pieces_per_row;
    *(u16x8*)(dst + (long)r * 512 + c * 8) = *(const u16x8*)(src + (long)r * sld + c * 8);
  }
}
DI void gdn_prep_item(const Params& p, int layer, int item) {
  const int tid = TIDX, lane = tid & 63, w = tid >> 6, fr = lane & 15, fq = lane >> 4;
  const int h = item & 3, cn = item >> 2, n = cn % NCHK;
  const long r0 = (long)cn * 64;
  const bfu* P = (const bfu*)(p.ws + OFF_P);
  const float* Ps = (const float*)(p.ws + OFF_PS);
  bfu* Xb = (bfu*)(p.ws + OFF_X) + (long)item * 36864;
  float* SC = (float*)(p.ws + OFF_SC) + (long)item * 256;
  bfu* rawQ = (bfu*)g_smem;
  bfu* rawK = rawQ + 64 * 136;
  bfu* rawV = rawK + 64 * 136;
  float* aL = (float*)(g_smem + 52224);
  float* sm = (float*)(g_smem + 69632);
  const float* cw = p.in[5] + layer * 4 * 1536;
  copy_z(p, P + r0 * 2048 + 1536 + h * 128, 2048, (bfu*)(p.ws + OFF_Z) + r0 * 512 + h * 128, 16);
  if (w < 3) {
    const int cgp = tid % 48, seg = tid / 48;
    const int which = cgp >> 4, c8 = (cgp & 15) * 8;
    const int col = which * 512 + h * 128 + c8;
    const int t0 = seg * 16;
    u16x8 xr[19];
    const bool nohist = (seg == 0 && n == 0);
#pragma unroll
    for (int i = 0; i < 19; ++i) {
      const bool valid = !(nohist && i < 3);
      const long rr = valid ? (r0 + t0 - 3 + i) : r0;
      u16x8 v = *(const u16x8*)(P + rr * 2048 + col);
      xr[i] = valid ? v : u16x8{0, 0, 0, 0, 0, 0, 0, 0};
    }
    float wt[4][8];
#pragma unroll
    for (int j = 0; j < 4; ++j) {
      float4 a4 = *(const float4*)(cw + j * 1536 + col), b4 = *(const float4*)(cw + j * 1536 + col + 4);
      wt[j][0] = a4.x; wt[j][1] = a4.y; wt[j][2] = a4.z; wt[j][3] = a4.w; wt[j][4] = b4.x; wt[j][5] = b4.y; wt[j][6] = b4.z; wt[j][7] = b4.w;
    }
    bfu* dst = rawQ + which * (64 * 136) + c8;
#pragma unroll
    for (int r = 0; r < 16; ++r) {
      u16x8 o;
#pragma unroll
      for (int c = 0; c < 8; ++c) {
        float v = wt[0][c] * bf2f(xr[r][c]) + wt[1][c] * bf2f(xr[r + 1][c]) + wt[2][c] * bf2f(xr[r + 2][c]) + wt[3][c] * bf2f(xr[r + 3][c]);
        o[c] = f2bf(siluf(v));
      }
      *(u16x8*)(dst + (t0 + r) * 136) = o;
    }
  }
  if (w == 3) {
    const float* ps = Ps + (r0 + lane) * 16;
    float be = sigm(ps[h]);
    float gl = -__expf(p.in[6][layer * 4 + h]) * softplusf(ps[4 + h] + p.in[7][layer * 4 + h]);
    float s = wave_scan_incl(gl, lane);
    sm[128 + lane] = be;
    sm[192 + lane] = s;
  }
  __syncthreads();
  if (tid < 128) {
    int row = tid & 63, mat = tid >> 6;
    const bfu* rp = rawQ + mat * (64 * 136) + row * 136;
    float ss = 0.f;
    for (int c = 0; c < 128; ++c) { float v = bf2f(rp[c]); ss += v * v; }
    float sc = rsqrtf(ss + 1e-6f);
    if (mat == 0) sc *= 0.08838834764831845f;
    sm[mat * 64 + row] = sc;
  }
  __syncthreads();
  if (tid < 64) { float be = sm[128 + tid]; sm[256 + tid] = be; sm[320 + tid] = be * sm[64 + tid] * __expf(sm[192 + tid]); }
  {
    bf16x8 kf[4], qf[4];
#pragma unroll
    for (int ks = 0; ks < 4; ++ks) {
      kf[ks] = *(const bf16x8*)(rawK + (16 * w + fr) * 136 + ks * 32 + fq * 8);
      qf[ks] = *(const bf16x8*)(rawQ + (16 * w + fr) * 136 + ks * 32 + fq * 8);
    }
    bfu* AMg = Xb + 32768;
    for (int tj = 0; tj < 4; ++tj) {
      if (tj <= w) {
        f32x4 akk = {0.f, 0.f, 0.f, 0.f}, aqk = {0.f, 0.f, 0.f, 0.f};
#pragma unroll
        for (int ks = 0; ks < 4; ++ks) {
          bf16x8 bk = *(const bf16x8*)(rawK + (16 * tj + fr) * 136 + ks * 32 + fq * 8);
          akk = MFMA16(kf[ks], bk, akk);
          aqk = MFMA16(qf[ks], bk, aqk);
        }
        int j = 16 * tj + fr;
        float rkj = sm[64 + j], gcj = sm[192 + j];
#pragma unroll
        for (int r = 0; r < 4; ++r) {
          int i = 16 * w + fq * 4 + r;
          float dec = (i >= j) ? __expf(sm[192 + i] - gcj) : 0.f;
          aL[i * 68 + j] = (i > j) ? sm[128 + i] * sm[64 + i] * rkj * akk[r] * dec : 0.f;
          AMg[i * 64 + j] = f2bf((i >= j) ? sm[i] * rkj * aqk[r] * dec : 0.f);
        }
      } else {
#pragma unroll
        for (int r = 0; r < 4; ++r) AMg[(16 * w + fq * 4 + r) * 64 + 16 * tj + fr] = 0;
      }
    }
  }
  __syncthreads();
  {
    const bfu* src = (tid < 128) ? (rawV + tid) : (rawK + (tid - 128));
    const float* rs = sm + ((tid < 128) ? 256 : 320);
    float x[64];
#pragma unroll
    for (int i = 0; i < 64; ++i) {
      float a = bf2f(src[i * 136]) * rs[i];
#pragma unroll
      for (int j = 0; j < i; ++j) a -= aL[i * 68 + j] * x[j];
      x[i] = a;
    }
    if (tid < 128) {
      bfu* UT = Xb + 24576 + tid * 64;
#pragma unroll
      for (int i = 0; i < 64; i += 8) {
        u16x8 o;
#pragma unroll
        for (int j = 0; j < 8; ++j) o[j] = f2bf(x[i + j]);
        *(u16x8*)(UT + i) = o;
      }
    } else {
      bfu* Wg = Xb + 8192 + (tid - 128);
#pragma unroll
      for (int i = 0; i < 64; ++i) Wg[i * 128] = f2bf(x[i]);
    }
  }
  {
    bfu* QDg = Xb;
    bfu* KDTg = Xb + 16384;
    float gl_last = sm[192 + 63];
    for (int idx = tid; idx < 8192; idx += 256) { int i = idx >> 7, c = idx & 127; QDg[idx] = f2bf(bf2f(rawQ[i * 136 + c]) * sm[i] * __expf(sm[192 + i])); }
    for (int idx = tid; idx < 8192; idx += 256) { int c = idx >> 6, i = idx & 63; KDTg[idx] = f2bf(bf2f(rawK[i * 136 + c]) * sm[64 + i] * __expf(gl_last - sm[192 + i])); }
    if (tid < 128) SC[128 + tid] = __expf(gl_last);
  }
  __syncthreads();
}

DI void ssd_prep_item(const Params& p, int layer, int item) {
  const int tid = TIDX, lane = tid & 63, w = tid >> 6, fr = lane & 15, fq = lane >> 4;
  const int g = item & 1, cn = item >> 1, n = cn % NCHK;
  const long r0 = (long)cn * 64;
  const bfu* P = (const bfu*)(p.ws + OFF_P);
  const float* Ps = (const float*)(p.ws + OFF_PS);
  bfu* Xb = (bfu*)(p.ws + OFF_X) + (long)cn * 131072;
  float* SCb = (float*)(p.ws + OFF_SC) + (long)cn * 8 * 256;
  bfu* Bm = (bfu*)g_smem;
  bfu* Cm = Bm + 64 * 136;
  float* cb = (float*)(g_smem + 34816);
  float* sm = (float*)(g_smem + 34816 + 17408);
  {
    int hd = g * 4 + w;
    float dtv = softplusf(Ps[(r0 + lane) * 16 + 8 + hd] + p.in[11][layer * 8 + hd]);
    float a = -dtv * __expf(p.in[12][layer * 8 + hd]);
    float ac = wave_scan_incl(a, lane);
    sm[w * 64 + lane] = dtv;
    sm[256 + w * 64 + lane] = ac;
  }
  __syncthreads();
  const float* cw = p.in[9] + layer * 4 * 1024;
  const float* cbias = p.in[10] + layer * 1024;
  copy_z(p, P + r0 * 1536 + 1024 + g * 256, 1536, (bfu*)(p.ws + OFF_Z) + r0 * 512 + g * 256, 32);
  {
    const int cg8 = tid & 63, seg = tid >> 6, t0 = seg * 16;
    const int col = (cg8 < 16) ? 512 + g * 128 + cg8 * 8 : (cg8 < 32) ? 768 + g * 128 + (cg8 - 16) * 8 : g * 256 + (cg8 - 32) * 8;
    u16x8 xr[19];
    const bool nohist = (seg == 0 && n == 0);
#pragma unroll
    for (int i = 0; i < 19; ++i) {
      const bool valid = !(nohist && i < 3);
      const long rr = valid ? (r0 + t0 - 3 + i) : r0;
      u16x8 v = *(const u16x8*)(P + rr * 1536 + col);
      xr[i] = valid ? v : u16x8{0, 0, 0, 0, 0, 0, 0, 0};
    }
    float wt[4][8], bias[8];
#pragma unroll
    for (int j = 0; j < 4; ++j) {
      float4 a4 = *(const float4*)(cw + j * 1024 + col), b4 = *(const float4*)(cw + j * 1024 + col + 4);
      wt[j][0] = a4.x; wt[j][1] = a4.y; wt[j][2] = a4.z; wt[j][3] = a4.w; wt[j][4] = b4.x; wt[j][5] = b4.y; wt[j][6] = b4.z; wt[j][7] = b4.w;
    }
    {
      float4 a4 = *(const float4*)(cbias + col), b4 = *(const float4*)(cbias + col + 4);
      bias[0] = a4.x; bias[1] = a4.y; bias[2] = a4.z; bias[3] = a4.w; bias[4] = b4.x; bias[5] = b4.y; bias[6] = b4.z; bias[7] = b4.w;
    }
    if (cg8 < 32) {
      bfu* dst = (cg8 < 16) ? (Bm + cg8 * 8) : (Cm + (cg8 - 16) * 8);
#pragma unroll
      for (int r = 0; r < 16; ++r) {
        u16x8 o;
        const bool padrow = (n == 0 && t0 + r < 48);
#pragma unroll
        for (int c = 0; c < 8; ++c) {
          float v = wt[0][c] * bf2f(xr[r][c]) + wt[1][c] * bf2f(xr[r + 1][c]) + wt[2][c] * bf2f(xr[r + 2][c]) + wt[3][c] * bf2f(xr[r + 3][c]) + bias[c];
          o[c] = padrow ? (bfu)0 : f2bf(siluf(v));
        }
        *(u16x8*)(dst + (t0 + r) * 136) = o;
      }
    } else {
      const int hh = (cg8 - 32) >> 3, pp8 = ((cg8 - 32) & 7) * 8;
      bfu* vtb = Xb + 32768 + (g * 4 + hh) * 12288 + 4096;
      const float alast = sm[256 + hh * 64 + 63];
#pragma unroll
      for (int q4 = 0; q4 < 4; ++q4) {
        float dtv[4], ksv[4];
#pragma unroll
        for (int rr = 0; rr < 4; ++rr) {
          int t = t0 + q4 * 4 + rr;
          const bool padrow = (n == 0 && t < 48);
          dtv[rr] = padrow ? 0.f : sm[hh * 64 + t];
          ksv[rr] = __expf(alast - sm[256 + hh * 64 + t]);
        }
#pragma unroll
        for (int c = 0; c < 8; ++c) {
          u16x4 oa, ob;
#pragma unroll
          for (int rr = 0; rr < 4; ++rr) {
            int r = q4 * 4 + rr;
            float v = wt[0][c] * bf2f(xr[r][c]) + wt[1][c] * bf2f(xr[r + 1][c]) + wt[2][c] * bf2f(xr[r + 2][c]) + wt[3][c] * bf2f(xr[r + 3][c]) + bias[c];
            float xd = siluf(v) * dtv[rr];
            oa[rr] = f2bf(xd);
            ob[rr] = f2bf(xd * ksv[rr]);
          }
          *(u16x4*)(vtb + (pp8 + c) * 64 + t0 + q4 * 4) = oa;
          *(u16x4*)(vtb + 4096 + (pp8 + c) * 64 + t0 + q4 * 4) = ob;
        }
      }
    }
  }
  __syncthreads();
  {
    bf16x8 cf[4];
#pragma unroll
    for (int ks = 0; ks < 4; ++ks) cf[ks] = *(const bf16x8*)(Cm + (16 * w + fr) * 136 + ks * 32 + fq * 8);
    for (int tj = 0; tj < 4; ++tj) {
      if (tj <= w) {
        f32x4 a = {0.f, 0.f, 0.f, 0.f};
#pragma unroll
        for (int ks = 0; ks < 4; ++ks) {
          bf16x8 bk = *(const bf16x8*)(Bm + (16 * tj + fr) * 136 + ks * 32 + fq * 8);
          a = MFMA16(cf[ks], bk, a);
        }
#pragma unroll
        for (int r = 0; r < 4; ++r) cb[(16 * w + fq * 4 + r) * 68 + 16 * tj + fr] = a[r];
      }
    }
    bfu* Cg = Xb + g * 16384;
    bfu* BTg = Cg + 8192;
    for (int idx = tid; idx < 8192; idx += 256) Cg[idx] = Cm[(idx >> 7) * 136 + (idx & 127)];
    for (int idx = tid; idx < 8192; idx += 256) BTg[idx] = Bm[(idx & 63) * 136 + (idx >> 6)];
  }
  __syncthreads();
  for (int hh = 0; hh < 4; ++hh) {
    int hd = g * 4 + hh;
    bfu* AMg = Xb + 32768 + hd * 12288;
    float Dh = p.in[13][layer * 8 + hd];
    const float* dtp = sm + hh * 64;
    const float* acp = sm + 256 + hh * 64;
    for (int idx = tid; idx < 4096; idx += 256) {
      int l = idx >> 6, m = idx & 63;
      float v = (m <= l) ? cb[l * 68 + m] * __expf(acp[l] - acp[m]) : 0.f;
      if (m == l) v += Dh / dtp[l];
      AMg[idx] = f2bf(v);
    }
    float* sc = SCb + hd * 256;
    float alast = acp[63];
    if (tid < 64) { sc[tid] = __expf(acp[tid]); sc[64 + tid] = __expf(alast - acp[tid]); }
    else if (tid < 192) sc[128 + (tid - 64)] = __expf(alast);
  }
  __syncthreads();
}

DI void hg_prep_item(const Params& p, int layer, int item) {
  const int tid = TIDX, lane = tid & 63, w = tid >> 6, fr = lane & 15, fq = lane >> 4;
  const int h = item & 3, cn = item >> 2;
  const long r0 = (long)cn * 64;
  const bfu* P = (const bfu*)(p.ws + OFF_P);
  const float* lbv = (const float*)(p.ws + OFF_LB);
  bfu* Xb = (bfu*)(p.ws + OFF_X) + (long)item * 28672;
  float* SC = (float*)(p.ws + OFF_SC) + (long)item * 256;
  bfu* Qall = (bfu*)g_smem;
  bfu* Ks = Qall + 160 * 136;
  float* segs = (float*)(g_smem + 60928);
  bfu* QDg = Xb;
  bfu* KDTg = Xb + 8192;
  bfu* AMg = Xb + 16384;
  bfu* VTg = Xb + 20480;
  copy_z(p, P + r0 * 2048 + 1536 + h * 128, 2048, (bfu*)(p.ws + OFF_Z) + r0 * 512 + h * 128, 16);
  {
    const int k8 = (tid & 15) * 8, rs = tid >> 4, t0 = rs * 4;
    u16x8 fr4[4], qr4[4], ir4[4];
    const bfu* base = P + (r0 + t0) * 2048 + h * 128 + k8;
#pragma unroll
    for (int r = 0; r < 4; ++r) {
      qr4[r] = *(const u16x8*)(base + (long)r * 2048);
      fr4[r] = *(const u16x8*)(base + (long)r * 2048 + 512);
      ir4[r] = *(const u16x8*)(base + (long)r * 2048 + 1024);
    }
    float lb[8];
    {
      float4 a4 = *(const float4*)(lbv + h * 128 + k8), b4 = *(const float4*)(lbv + h * 128 + k8 + 4);
      lb[0] = a4.x; lb[1] = a4.y; lb[2] = a4.z; lb[3] = a4.w; lb[4] = b4.x; lb[5] = b4.y; lb[6] = b4.z; lb[7] = b4.w;
    }
    float lf[4][8];
    float ssum[8];
#pragma unroll
    for (int c = 0; c < 8; ++c) ssum[c] = 0.f;
#pragma unroll
    for (int r = 0; r < 4; ++r)
#pragma unroll
      for (int c = 0; c < 8; ++c) {
        float zf = bf2f(fr4[r][c]);
        float f = lb[c] + (1.f - lb[c]) * (1.f / (1.f + __expf(-zf)));
        lf[r][c] = __logf(f);
        ssum[c] += lf[r][c];
      }
    *(float4*)(segs + rs * 128 + k8) = make_float4(ssum[0], ssum[1], ssum[2], ssum[3]);
    *(float4*)(segs + rs * 128 + k8 + 4) = make_float4(ssum[4], ssum[5], ssum[6], ssum[7]);
#pragma unroll
    for (int c = 0; c < 8; ++c) {
      u16x4 o = {ir4[0][c], ir4[1][c], ir4[2][c], ir4[3][c]};
      *(u16x4*)(VTg + (k8 + c) * 64 + t0) = o;
    }
    __syncthreads();
    float Gb[8], G1[8], G2[8], G3[8], GL[8];
#pragma unroll
    for (int c = 0; c < 8; ++c) { Gb[c] = 0.f; G1[c] = 0.f; G2[c] = 0.f; G3[c] = 0.f; GL[c] = 0.f; }
    for (int s2 = 0; s2 < 16; ++s2) {
      float4 a4 = *(const float4*)(segs + s2 * 128 + k8), b4 = *(const float4*)(segs + s2 * 128 + k8 + 4);
      float v[8] = {a4.x, a4.y, a4.z, a4.w, b4.x, b4.y, b4.z, b4.w};
#pragma unroll
      for (int c = 0; c < 8; ++c) {
        if (s2 < rs) Gb[c] += v[c];
        if (s2 < 4) G1[c] += v[c];
        if (s2 < 8) G2[c] += v[c];
        if (s2 < 12) G3[c] += v[c];
        GL[c] += v[c];
      }
    }
    const int Jt = rs >> 2;
    float G[8];
#pragma unroll
    for (int c = 0; c < 8; ++c) G[c] = Gb[c];
#pragma unroll
    for (int r = 0; r < 4; ++r) {
      const int t = t0 + r;
      u16x8 oq, oq1, oq2, oq3, ok;
#pragma unroll
      for (int c = 0; c < 8; ++c) {
        G[c] += lf[r][c];
        float zf = bf2f(fr4[r][c]);
        float kk = (1.f - lb[c]) * (1.f / (1.f + __expf(zf)));
        float q = siluf(bf2f(qr4[r][c]));
        oq[c] = f2bf(q * __expf(G[c]));
        oq1[c] = f2bf(q * __expf(G[c] - G1[c]));
        oq2[c] = f2bf(q * __expf(G[c] - G2[c]));
        oq3[c] = f2bf(q * __expf(G[c] - G3[c]));
        float GJ = (Jt == 0) ? 0.f : (Jt == 1) ? G1[c] : (Jt == 2) ? G2[c] : G3[c];
        ok[c] = f2bf(kk * __expf(fminf(GJ - G[c], 80.f)));
      }
      *(u16x8*)(QDg + t * 128 + k8) = oq;
      *(u16x8*)(Qall + t * 136 + k8) = oq;
      if (t >= 16) *(u16x8*)(Qall + (64 + t - 16) * 136 + k8) = oq1;
      if (t >= 32) *(u16x8*)(Qall + (112 + t - 32) * 136 + k8) = oq2;
      if (t >= 48) *(u16x8*)(Qall + (144 + t - 48) * 136 + k8) = oq3;
      *(u16x8*)(Ks + t * 136 + k8) = ok;
    }
#pragma unroll
    for (int c = 0; c < 8; ++c) {
      float Gc = Gb[c];
      u16x4 o;
#pragma unroll
      for (int r = 0; r < 4; ++r) {
        Gc += lf[r][c];
        float zf = bf2f(fr4[r][c]);
        float kk = (1.f - lb[c]) * (1.f / (1.f + __expf(zf)));
        o[r] = f2bf(kk * __expf(GL[c] - Gc));
      }
      *(u16x4*)(KDTg + (k8 + c) * 64 + t0) = o;
    }
    if (rs == 0) {
#pragma unroll
      for (int c = 0; c < 8; ++c) SC[128 + k8 + c] = __expf(GL[c]);
    }
  }
  __syncthreads();
  for (int J = 0; J < 4; ++J) {
    if (J <= w) {
      int rowbase = (J == 0 ? 0 : J == 1 ? 64 : J == 2 ? 112 : 144) + 16 * (w - J);
      f32x4 a = {0.f, 0.f, 0.f, 0.f};
#pragma unroll
      for (int ks = 0; ks < 4; ++ks) {
        bf16x8 af = *(const bf16x8*)(Qall + (rowbase + fr) * 136 + ks * 32 + fq * 8);
        bf16x8 bk = *(const bf16x8*)(Ks + (16 * J + fr) * 136 + ks * 32 + fq * 8);
        a = MFMA16(af, bk, a);
      }
#pragma unroll
      for (int r = 0; r < 4; ++r) {
        int t = 16 * w + fq * 4 + r, s = 16 * J + fr;
        AMg[t * 64 + s] = f2bf((s <= t) ? a[r] : 0.f);
      }
    } else {
#pragma unroll
      for (int r = 0; r < 4; ++r) AMg[(16 * w + fq * 4 + r) * 64 + 16 * J + fr] = 0;
    }
  }
  __syncthreads();
}

struct LinArgs {
  const bfu* kdt; long kdt_cs;
  const bfu* vt; long vt_cs;
  const float* sc; long sc_cs;
  bfu* ss; long ss_cs;
  int kt0;
};
struct LinFrags { bf16x8 kf[2]; bf16x8 vf[2]; f32x4 dv; };
DI void lin_load(LinFrags& f, const LinArgs& e, int n, int w, int fr, int fq) {
#pragma unroll
  for (int ks = 0; ks < 2; ++ks) f.kf[ks] = *(const bf16x8*)(e.kdt + n * e.kdt_cs + ((e.kt0 + w) * 16 + fr) * 64 + ks * 32 + fq * 8);
#pragma unroll
  for (int ks = 0; ks < 2; ++ks) f.vf[ks] = *(const bf16x8*)(e.vt + n * e.vt_cs + fr * 64 + ks * 32 + fq * 8);
  f.dv = *(const f32x4*)(e.sc + n * e.sc_cs + 128 + (e.kt0 + w) * 16 + fq * 4);
}
template <int NST>
DI void engine_lin(const LinArgs& e) {
  const int tid = TIDX, lane = tid & 63, w = tid >> 6, fr = lane & 15, fq = lane >> 4;
  f32x4 S = f32x4{0.f, 0.f, 0.f, 0.f};
  LinFrags f[NST];
#pragma unroll
  for (int s = 0; s < NST - 1; ++s) lin_load(f[s], e, s, w, fr, fq);
  for (int n0 = 0; n0 < NCHK; n0 += NST) {
#pragma unroll
    for (int s = 0; s < NST; ++s) {
      const int n = n0 + s;
      if (n < NCHK) {
        int nl = n + NST - 1; if (nl > NCHK - 1) nl = NCHK - 1;
        lin_load(f[(s + NST - 1) % NST], e, nl, w, fr, fq);
        const LinFrags& c = f[s];
        u16x4 pk = {f2bf(S[0]), f2bf(S[1]), f2bf(S[2]), f2bf(S[3])};
        *(u16x4*)(e.ss + n * e.ss_cs + fr * 128 + (e.kt0 + w) * 16 + fq * 4) = pk;
#pragma unroll
        for (int r = 0; r < 4; ++r) S[r] *= c.dv[r];
#pragma unroll
        for (int ks = 0; ks < 2; ++ks) S = MFMA16(c.kf[ks], c.vf[ks], S);
      }
    }
  }
}

struct GdnArgs {
  const bfu* w; const bfu* kdt; bfu* ut; long cs;
  const float* sc; long sc_cs;
  bfu* ss; long ss_cs;
};
struct GdnFrags { bf16x8 wf[4]; bf16x8 kf[2][2]; u16x4 v[2]; float dv; };
DI void gdn_load(GdnFrags& f, const GdnArgs& e, int n, int w, int fr, int fq) {
#pragma unroll
  for (int ks = 0; ks < 4; ++ks) f.wf[ks] = *(const bf16x8*)(e.w + n * e.cs + (16 * w + fr) * 128 + ks * 32 + fq * 8);
#pragma unroll
  for (int a = 0; a < 2; ++a)
#pragma unroll
    for (int ks = 0; ks < 2; ++ks) f.kf[a][ks] = *(const bf16x8*)(e.kdt + n * e.cs + ((2 * w + a) * 16 + fr) * 64 + ks * 32 + fq * 8);
#pragma unroll
  for (int jv = 0; jv < 2; ++jv) f.v[jv] = *(const u16x4*)(e.ut + n * e.cs + (jv * 16 + fr) * 64 + 16 * w + fq * 4);
  f.dv = e.sc[n * e.sc_cs + 128];
}
template <int NST>
DI void engine_gdn(const GdnArgs& e) {
  const int tid = TIDX, lane = tid & 63, w = tid >> 6, fr = lane & 15, fq = lane >> 4;
  char* VT = g_smem + 17408;
  f32x4 S[2][2];
#pragma unroll
  for (int a = 0; a < 2; ++a)
#pragma unroll
    for (int jv = 0; jv < 2; ++jv) S[a][jv] = f32x4{0.f, 0.f, 0.f, 0.f};
  GdnFrags f[NST];
#pragma unroll
  for (int s = 0; s < NST - 1; ++s) gdn_load(f[s], e, s, w, fr, fq);
  for (int n0 = 0; n0 < NCHK; n0 += NST) {
#pragma unroll
    for (int s = 0; s < NST; ++s) {
      const int n = n0 + s;
      if (n < NCHK) {
        int nl = n + NST - 1; if (nl > NCHK - 1) nl = NCHK - 1;
        gdn_load(f[(s + NST - 1) % NST], e, nl, w, fr, fq);
        const GdnFrags& c = f[s];
        char* STc = g_smem + (n & 1) * 8704;
#pragma unroll
        for (int a = 0; a < 2; ++a)
#pragma unroll
          for (int jv = 0; jv < 2; ++jv) {
            u16x4 pk = {f2bf(S[a][jv][0]), f2bf(S[a][jv][1]), f2bf(S[a][jv][2]), f2bf(S[a][jv][3])};
            *(u16x4*)(STc + ((jv * 16 + fr) * 136 + (2 * w + a) * 16 + fq * 4) * 2) = pk;
            *(u16x4*)(e.ss + n * e.ss_cs + (jv * 16 + fr) * 128 + (2 * w + a) * 16 + fq * 4) = pk;
          }
        __syncthreads();
        f32x4 av[2] = {f32x4{0.f, 0.f, 0.f, 0.f}, f32x4{0.f, 0.f, 0.f, 0.f}};
#pragma unroll
        for (int ks = 0; ks < 4; ++ks)
#pragma unroll
          for (int jv = 0; jv < 2; ++jv) {
            bf16x8 sf = *(const bf16x8*)(STc + ((jv * 16 + fr) * 136 + ks * 32 + fq * 8) * 2);
            av[jv] = MFMA16(c.wf[ks], sf, av[jv]);
          }
#pragma unroll
        for (int jv = 0; jv < 2; ++jv) {
          u16x4 pk;
#pragma unroll
          for (int r = 0; r < 4; ++r) pk[r] = f2bf(bf2f(c.v[jv][r]) - av[jv][r]);
          *(u16x4*)(VT + ((jv * 16 + fr) * 72 + 16 * w + fq * 4) * 2) = pk;
          *(u16x4*)(e.ut + n * e.cs + (jv * 16 + fr) * 64 + 16 * w + fq * 4) = pk;
        }
        __syncthreads();
#pragma unroll
        for (int a = 0; a < 2; ++a) {
#pragma unroll
          for (int jv = 0; jv < 2; ++jv)
#pragma unroll
            for (int r = 0; r < 4; ++r) S[a][jv][r] *= c.dv;
#pragma unroll
          for (int ks = 0; ks < 2; ++ks)
#pragma unroll
            for (int jv = 0; jv < 2; ++jv) {
              bf16x8 vf = *(const bf16x8*)(VT + ((jv * 16 + fr) * 72 + ks * 32 + fq * 8) * 2);
              S[a][jv] = MFMA16(c.kf[a][ks], vf, S[a][jv]);
            }
        }
      }
    }
  }
  __syncthreads();
}

template <int NVT, bool USE_RS>
DI void oproj_core(f32x4 (&acc)[NVT], const bfu* qd, const bfu* am, const bfu* st, const bfu* vt, const float* rsp, int w, int fr, int fq) {
#pragma unroll
  for (int jv = 0; jv < NVT; ++jv) acc[jv] = f32x4{0.f, 0.f, 0.f, 0.f};
#pragma unroll
  for (int ks = 0; ks < 4; ++ks) {
    bf16x8 qf = *(const bf16x8*)(qd + (16 * w + fr) * 128 + ks * 32 + fq * 8);
#pragma unroll
    for (int jv = 0; jv < NVT; ++jv) {
      bf16x8 sf = *(const bf16x8*)(st + (jv * 16 + fr) * 128 + ks * 32 + fq * 8);
      acc[jv] = MFMA16(qf, sf, acc[jv]);
    }
  }
  if (USE_RS) {
    f32x4 rs = *(const f32x4*)(rsp + 16 * w + fq * 4);
#pragma unroll
    for (int jv = 0; jv < NVT; ++jv)
#pragma unroll
      for (int r = 0; r < 4; ++r) acc[jv][r] *= rs[r];
  }
#pragma unroll
  for (int ks = 0; ks < 2; ++ks) {
    bf16x8 af = *(const bf16x8*)(am + (16 * w + fr) * 64 + ks * 32 + fq * 8);
#pragma unroll
    for (int jv = 0; jv < NVT; ++jv) {
      bf16x8 vf = *(const bf16x8*)(vt + (jv * 16 + fr) * 64 + ks * 32 + fq * 8);
      acc[jv] = MFMA16(af, vf, acc[jv]);
    }
  }
}
DI void oproj_head128(const bfu* qd, const bfu* am, const bfu* st, const bfu* vt, const bfu* zP, int zld, const float* nw, bfu* Yo) {
  const int tid = TIDX, lane = tid & 63, w = tid >> 6, fr = lane & 15, fq = lane >> 4;
  const int row = 16 * w + (lane >> 2), q = lane & 3;
  u16x8 zr[4];
#pragma unroll
  for (int i = 0; i < 4; ++i) zr[i] = *(const u16x8*)(zP + (long)row * zld + q * 32 + i * 8);
  f32x4 acc[8];
  oproj_core<8, false>(acc, qd, am, st, vt, nullptr, w, fr, fq);
  float* T = (float*)g_smem;
#pragma unroll
  for (int jv = 0; jv < 8; ++jv)
#pragma unroll
    for (int r = 0; r < 4; ++r) T[(16 * w + fq * 4 + r) * 132 + jv * 16 + fr] = acc[jv][r];
  float o[32];
  float ss = 0.f;
#pragma unroll
  for (int i = 0; i < 8; ++i) {
    f32x4 v = *(const f32x4*)(T + row * 132 + q * 32 + i * 4);
#pragma unroll
    for (int j = 0; j < 4; ++j) { o[i * 4 + j] = v[j]; ss += v[j] * v[j]; }
  }
  ss += __shfl_xor(ss, 1); ss += __shfl_xor(ss, 2);
  const float rs = rsqrtf(ss * (1.f / 128.f) + 1e-6f);
#pragma unroll
  for (int i = 0; i < 4; ++i) {
    u16x8 res;
    f32x4 w0 = *(const f32x4*)(nw + q * 32 + i * 8), w1 = *(const f32x4*)(nw + q * 32 + i * 8 + 4);
#pragma unroll
    for (int j = 0; j < 8; ++j) {
      float wv = j < 4 ? w0[j & 3] : w1[j & 3];
      res[j] = f2bf(o[i * 8 + j] * rs * wv * siluf(bf2f(zr[i][j])));
    }
    *(u16x8*)(Yo + (long)row * 512 + q * 32 + i * 8) = res;
  }
}
DI void oproj_ssd(const bfu* Xb  , int g, const float* SCb, const bfu* SSb, const bfu* zP, const float* nw, bfu* Yo) {
  const int tid = TIDX, lane = tid & 63, w = tid >> 6, fr = lane & 15, fq = lane >> 4;
  const int row = 16 * w + (lane >> 2), q = lane & 3;
  float* T = (float*)g_smem;
#pragma unroll
  for (int hh = 0; hh < 4; ++hh) {
    int hd = g * 4 + hh;
    f32x4 acc[4];
    oproj_core<4, true>(acc, Xb + g * 16384, Xb + 32768 + hd * 12288, SSb + hd * 8192, Xb + 32768 + hd * 12288 + 4096, SCb + hd * 256, w, fr, fq);
#pragma unroll
    for (int jv = 0; jv < 4; ++jv)
#pragma unroll
      for (int r = 0; r < 4; ++r) T[(16 * w + fq * 4 + r) * 260 + hh * 64 + jv * 16 + fr] = acc[jv][r];
  }
  float ss = 0.f;
  float o[64];
#pragma unroll
  for (int i = 0; i < 8; ++i) {
    u16x8 z = *(const u16x8*)(zP + (long)row * 512 + q * 64 + i * 8);
    f32x4 v0 = *(const f32x4*)(T + row * 260 + q * 64 + i * 8), v1 = *(const f32x4*)(T + row * 260 + q * 64 + i * 8 + 4);
#pragma unroll
    for (int j = 0; j < 8; ++j) {
      float y = (j < 4 ? v0[j & 3] : v1[j & 3]) * siluf(bf2f(z[j]));
      o[i * 8 + j] = y;
      ss += y * y;
    }
  }
  ss += __shfl_xor(ss, 1); ss += __shfl_xor(ss, 2);
  const float rs = rsqrtf(ss * (1.f / 256.f) + 1e-6f);
#pragma unroll
  for (int i = 0; i < 8; ++i) {
    u16x8 res;
    f32x4 w0 = *(const f32x4*)(nw + q * 64 + i * 8), w1 = *(const f32x4*)(nw + q * 64 + i * 8 + 4);
#pragma unroll
    for (int j = 0; j < 8; ++j) res[j] = f2bf(o[i * 8 + j] * rs * (j < 4 ? w0[j & 3] : w1[j & 3]));
    *(u16x8*)(Yo + (long)row * 512 + q * 64 + i * 8) = res;
  }
}

DI float geluf(float x) { float u = 0.7978845608028654f * (x + 0.044715f * x * x * x); return 0.5f * x * (1.f + tanhf(u)); }

DI void phase_s5_gemm1(const Params& p) {
  const bfu* U2 = (const bfu*)(p.ws + OFF_U2);
  const bfu* Ms = (const bfu*)(p.ws + OFF_MS);
  float* Xloc = (float*)(p.ws + OFF_XLOC);
  for (int t = BIDX; t < 32 * 17; t += gridDim.x) {
    int g = t / 17, tm = t - g * 17;
    f32x4 acc[4][4];
    zero_acc<4>(acc);
    gemm_tile<4>(acc, U2 + ((long)g * 2176 + tm * 128) * 256, 256, Ms + (long)g * 128 * 256, 256, 256);
    ACC_FOREACH(4, { Xloc[((long)g * 2176 + tm * 128 + trow) * 128 + tcol] = acc[m][n][j]; })
  }
}
DI void phase_s5_scan(const Params& p, int layer) {
  float* Xloc = (float*)(p.ws + OFF_XLOC);
  bfu* Xst = (bfu*)(p.ws + OFF_XST);
  const int tid = TIDX;
  const int seg = tid >> 4, p16 = tid & 15;
  float* ex = (float*)g_smem;
  for (int it = BIDX; it < 256; it += gridDim.x) {
    const int g = it >> 3, b = (it >> 2) & 1, pq = it & 3;
    const int pr = pq * 16 + p16;
    const int idx = (layer * 32 + g) * 64 + pr;
    const float dt = expf(p.in[24][layer * 32 + g]);
    const float e1 = p.in[17][idx] * dt * 16.f, a1 = p.in[18][idx] * dt * 16.f;
    const float m16 = expf(e1);
    const float l16x = m16 * cosf(a1), l16y = m16 * sinf(a1);
    const int n0 = seg * 65, n1 = (n0 + 65 < 1028) ? n0 + 65 : 1028;
    const float* xl = Xloc + ((long)g * 2176 + b * 1028) * 128;
    bfu* xs = Xst + ((long)g * 2176 + b * 1028) * 128;
    float sre = 0.f, sim = 0.f;
#pragma unroll 13
    for (int n = n0; n < n1; ++n) {
      float lre = xl[(long)n * 128 + pr], lim = xl[(long)n * 128 + 64 + pr];
      float nre = l16x * sre - l16y * sim + lre;
      float nim = l16x * sim + l16y * sre + lim;
      sre = nre; sim = nim;
    }
    __syncthreads();
    ex[(seg * 16 + p16) * 2] = sre; ex[(seg * 16 + p16) * 2 + 1] = sim;
    __syncthreads();
    float cre = 0.f, cim = 0.f;
    {
      const float mL = expf(e1 * 65.f), aL = a1 * 65.f;
      const float lLx = mL * cosf(aL), lLy = mL * sinf(aL);
      for (int s2 = 0; s2 < seg; ++s2) {
        float ere = ex[(s2 * 16 + p16) * 2], eim = ex[(s2 * 16 + p16) * 2 + 1];
        float nre = lLx * cre - lLy * cim + ere;
        float nim = lLx * cim + lLy * cre + eim;
        cre = nre; cim = nim;
      }
    }
    sre = cre; sim = cim;
#pragma unroll 13
    for (int n = n0; n < n1; ++n) {
      float lre = xl[(long)n * 128 + pr], lim = xl[(long)n * 128 + 64 + pr];
      xs[(long)n * 128 + pr] = f2bf(sre);
      xs[(long)n * 128 + 64 + pr] = f2bf(sim);
      float nre = l16x * sre - l16y * sim + lre;
      float nim = l16x * sim + l16y * sre + lim;
      sre = nre; sim = nim;
    }
  }
}
DI void phase_s5_gemm2(const Params& p) {
  const bfu* U2 = (const bfu*)(p.ws + OFF_U2);
  const bfu* Xst = (const bfu*)(p.ws + OFF_XST);
  const bfu* Mc = (const bfu*)(p.ws + OFF_MC);
  bfu* Ys5 = (bfu*)(p.ws + OFF_YS5);
  for (int t = BIDX; t < 32 * 17 * 2; t += gridDim.x) {
    int g = t / 34, rem = t - g * 34, tm = rem >> 1, tn = rem & 1;
    f32x4 acc[4][4];
    zero_acc<4>(acc);
    const bfu* Bt = Mc + ((long)g * 256 + tn * 128) * 384;
    gemm_tile<4>(acc, U2 + ((long)g * 2176 + tm * 128) * 256, 256, Bt, 384, 256);
    gemm_tile<4>(acc, Xst + ((long)g * 2176 + tm * 128) * 128, 128, Bt + 256, 384, 128);
    ACC_FOREACH(4, {
      int nc = tm * 128 + trow, o = tn * 128 + tcol;
      if (nc < 2056) Ys5[((long)nc * 16 + (o >> 4)) * 512 + g * 16 + (o & 15)] = f2bf(geluf(acc[m][n][j]));
    })
  }
}
DI void phase_glu(const Params& p) {
  const bfu* Ys5 = (const bfu*)(p.ws + OFF_YS5);
  const bfu* Wg = (const bfu*)(p.ws + OFF_WGLU);
  const bfu* Pz = (const bfu*)(p.ws + OFF_PZ);
  bfu* Yd = (bfu*)(p.ws + OFF_Y) + (long)3 * TR * 512;
  for (int v = BIDX; v < 320 * 8; v += gridDim.x) {
    int tm, tn;
    if (!tile_map(v, 8, tm, tn)) continue;
    f32x4 acc[4][4];
    zero_acc<4>(acc);
    gemm_tile<4>(acc, Ys5 + (long)tm * 128 * 512, 512, Wg + (long)tn * 128 * 512, 512, 512);
    const int lane = TIDX & 63, wid = TIDX >> 6, wr = wid >> 1, wc = wid & 1, fr = lane & 15, fq = lane >> 4;
#pragma unroll
    for (int m = 0; m < 4; ++m)
#pragma unroll
      for (int n = 0; n < 2; ++n)
#pragma unroll
        for (int j = 0; j < 4; ++j) {
          int row = tm * 128 + wr * 64 + m * 16 + fq * 4 + j;
          int oc = tn * 64 + wc * 32 + n * 16 + fr;
          float z = bf2f(Pz[(long)row * 512 + oc]);
          Yd[(long)row * 512 + oc] = f2bf(acc[m][n][j] * sigm(acc[m][n + 2][j]) * siluf(z));
        }
  }
}
DI void phase_gates(const Params& p) {
  const bfu* h16 = (const bfu*)(p.ws + OFF_H16);
  const bfu* WT = (const bfu*)(p.ws + OFF_WIN);
  bfu* G = (bfu*)(p.ws + OFF_P);
  for (int v = BIDX; v < 320 * 32; v += gridDim.x) {
    int tm, tn;
    if (!tile_map(v, 32, tm, tn)) continue;
    f32x4 acc[4][4];
    zero_acc<4>(acc);
    gemm_tile<4>(acc, h16 + (long)tm * 128 * 1024, 1024, WT + (long)(6656 + tn * 128) * 1024, 1024, 1024);
    {
      const int lane = TIDX & 63, wid = TIDX >> 6, wr = wid >> 1, wc = wid & 1, fr = lane & 15, fq = lane >> 4;
#pragma unroll
      for (int m = 0; m < 4; ++m)
#pragma unroll
        for (int n = 0; n < 4; ++n) {
          const int row4 = (tm * 128 + wr * 64 + m * 16 + fq * 4) >> 2, col = tn * 128 + wc * 64 + n * 16 + fr;
          u16x4 pk = {f2bf(sigm(acc[m][n][0])), f2bf(sigm(acc[m][n][1])), f2bf(sigm(acc[m][n][2])), f2bf(sigm(acc[m][n][3]))};
          *(u16x4*)(G + ((long)row4 * 4096 + col) * 4) = pk;
        }
    }
  }
}
DI void phase_merge(const Params& p) {
  const bfu* WbT = (const bfu*)(p.ws + OFF_WB);
  const bfu* Y = (const bfu*)(p.ws + OFF_Y);
  const bfu* G = (const bfu*)(p.ws + OFF_P);
  bfu* mixed = (bfu*)(p.ws + OFF_H16);
  for (int v = BIDX; v < 320 * 8; v += gridDim.x) {
    int tm, tn;
    if (!tile_map(v, 8, tm, tn)) continue;
    f32x4 tot[4][4];
    zero_acc<4>(tot);
    for (int b = 0; b < 4; ++b) {
      f32x4 acc[4][4];
      zero_acc<4>(acc);
      gemm_tile<4>(acc, Y + ((long)b * TR + tm * 128) * 512, 512, WbT + (long)(b * 1024 + tn * 128) * 512, 512, 512);
      {
        const int lane = TIDX & 63, wid = TIDX >> 6, wr = wid >> 1, wc = wid & 1, fr = lane & 15, fq = lane >> 4;
#pragma unroll
        for (int m = 0; m < 4; ++m)
#pragma unroll
          for (int n = 0; n < 4; ++n) {
            const int row4 = (tm * 128 + wr * 64 + m * 16 + fq * 4) >> 2, col = b * 1024 + tn * 128 + wc * 64 + n * 16 + fr;
            u16x4 gk = *(const u16x4*)(G + ((long)row4 * 4096 + col) * 4);
#pragma unroll
            for (int j = 0; j < 4; ++j) tot[m][n][j] += bf2f(gk[j]) * acc[m][n][j];
          }
      }
    }
    ACC_FOREACH(4, { mixed[(long)(tm * 128 + trow) * 1024 + tn * 128 + tcol] = f2bf(tot[m][n][j]); })
  }
}
DI void phase_out(const Params& p) {
  const bfu* mixed = (const bfu*)(p.ws + OFF_H16);
  const bfu* WoT = (const bfu*)(p.ws + OFF_WO);
  float* h32 = (float*)(p.ws + OFF_H32);
  const float ALPHA = 1.6817928305074290f;
  for (int v = BIDX; v < 320 * 8; v += gridDim.x) {
    int tm, tn;
    if (!tile_map(v, 8, tm, tn)) continue;
    f32x4 acc[4][4];
    zero_acc<4>(acc);
    gemm_tile<4>(acc, mixed + (long)tm * 128 * 1024, 1024, WoT + (long)tn * 128 * 1024, 1024, 1024);
    ACC_FOREACH(4, {
      long a = (long)(tm * 128 + trow) * 1024 + tn * 128 + tcol;
      h32[a] = ALPHA * h32[a] + acc[m][n][j];
    })
  }
}

DI void run_phase(const Params& p, int ph) {
  if (ph == 0) { phase_tables(p); return; }
  if (ph == NPHASE - 1) { ln_rows(p, 3, true); return; }
  const int layer = (ph - 1) / NPL, sub = (ph - 1) % NPL;
  bfu* Xb = (bfu*)(p.ws + OFF_X);
  float* SC = (float*)(p.ws + OFF_SC);
  bfu* Y = (bfu*)(p.ws + OFF_Y);
  const bfu* Zb = (const bfu*)(p.ws + OFF_Z);
  const int bid = BIDX;
  switch (sub) {
    case 0: ln_rows(p, layer - 1, false); phase_convert(p, layer); break;
    case 1: phase_proj(p, 0, 2048, 0, true, 0); break;
    case 2: for (int it = bid; it < 2056; it += gridDim.x) gdn_prep_item(p, layer, it); break;
    case 3:
      if (bid < 32) {
        int b = bid >> 4, h = (bid >> 2) & 3, sl = bid & 3;
        GdnArgs e;
        bfu* base = Xb + ((long)(b * NCHK) * 4 + h) * 36864;
        e.w = base + 8192; e.kdt = base + 16384; e.ut = base + 24576 + sl * 32 * 64; e.cs = 4 * 36864;
        e.sc = SC + ((long)(b * NCHK) * 4 + h) * 256; e.sc_cs = 4 * 256;
        e.ss = Y + (long)TR * 512 + ((long)(b * NCHK) * 4 + h) * 16384 + sl * 32 * 128; e.ss_cs = 4 * 16384;
        engine_gdn<4>(e);
      } else phase_proj(p, 2048, 1536, 0, false, 32);
      break;
    case 4:
      for (int it = bid; it < 2056; it += gridDim.x) {
        int h = it & 3; long r0 = (long)(it >> 2) * 64;
        const bfu* base = Xb + (long)it * 36864;
        oproj_head128(base, base + 32768, Y + (long)TR * 512 + (long)it * 16384, base + 24576,
                      Zb + r0 * 512 + h * 128, 512, p.in[8] + layer * 128, Y + r0 * 512 + h * 128);
      }
      break;
    case 5: for (int it = bid; it < 1028; it += gridDim.x) ssd_prep_item(p, layer, it); break;
    case 6:
      if (bid < 128) {
        int b = bid >> 6, hd = (bid >> 3) & 7, sl = (bid >> 1) & 3, kh = bid & 1, g = hd >> 2;
        LinArgs e;
        const bfu* base = Xb + (long)(b * NCHK) * 131072;
        e.kdt = base + g * 16384 + 8192; e.kdt_cs = 131072;
        e.vt = base + 32768 + hd * 12288 + 8192 + sl * 16 * 64; e.vt_cs = 131072;
        e.sc = SC + ((long)(b * NCHK) * 8 + hd) * 256; e.sc_cs = 8 * 256;
        e.ss = Y + (long)2 * TR * 512 + ((long)(b * NCHK) * 8 + hd) * 8192 + sl * 16 * 128; e.ss_cs = 8 * 8192;
        e.kt0 = kh * 4;
        engine_lin<9>(e);
      } else phase_proj(p, 3584, 2048, 0, false, 128);
      break;
    case 7:
      for (int it = bid; it < 1028; it += gridDim.x) {
        int g = it & 1; long cn = it >> 1; long r0 = cn * 64;
        oproj_ssd(Xb + cn * 131072, g, SC + cn * 8 * 256, Y + (long)2 * TR * 512 + cn * 8 * 8192,
                  Zb + r0 * 512 + g * 256, p.in[14] + layer * 512 + g * 256, Y + (long)TR * 512 + r0 * 512 + g * 256);
      }
      break;
    case 8: for (int it = bid; it < 2056; it += gridDim.x) hg_prep_item(p, layer, it); break;
    case 9:
      if (bid < 128) {
        int b = bid >> 6, h = (bid >> 4) & 3, sl = (bid >> 1) & 7, kh = bid & 1;
        LinArgs e;
        const bfu* base = Xb + ((long)(b * NCHK) * 4 + h) * 28672;
        e.kdt = base + 8192; e.kdt_cs = 4 * 28672;
        e.vt = base + 20480 + sl * 16 * 64; e.vt_cs = 4 * 28672;
        e.sc = SC + ((long)(b * NCHK) * 4 + h) * 256; e.sc_cs = 4 * 256;
        bfu* ssb = b == 0 ? (Y + (long)3 * TR * 512) : (Xb + (long)2056 * 28672);
        e.ss = ssb + (long)h * 16384 + sl * 16 * 128; e.ss_cs = 4 * 16384;
        e.kt0 = kh * 4;
        engine_lin<9>(e);
      } else phase_proj(p, 5632, 1024, 1, false, 128);
      break;
    case 10:
      for (int it = bid; it < 2056; it += gridDim.x) {
        int h = it & 3; int cn = it >> 2; long r0 = (long)cn * 64;
        int b = cn / NCHK, n = cn - b * NCHK;
        const bfu* base = Xb + (long)it * 28672;
        const bfu* ssb = b == 0 ? (Y + (long)3 * TR * 512) : (Xb + (long)2056 * 28672);
        oproj_head128(base, base + 16384, ssb + ((long)n * 4 + h) * 16384, base + 20480,
                      Zb + r0 * 512 + h * 128, 512, p.in[16] + layer * 128, Y + (long)2 * TR * 512 + r0 * 512 + h * 128);
      }
      break;
    case 11: phase_s5_gemm1(p); break;
    case 12: phase_s5_scan(p, layer); break;
    case 13: phase_s5_gemm2(p); break;
    case 14: phase_glu(p); break;
    case 15: phase_gates(p); break;
    case 16: phase_merge(p); break;
    case 17: phase_out(p); break;
  }
}


#define XB_TMO      128
#define XB_XCNT(j)  (256  + 64 * (j))
#define XB_XSUB(j)  (1280 + 64 * (j))
#define XB_XGEN(j)  (2304 + 64 * (j))
#define XB_TOP      3328
#define XB_TOPGEN   3392
#define XCD_BAR_WORDS 3456
#define XB_SPIN_CAP (1u << 20)
#define LAS __attribute__((address_space(3)))
DI unsigned xb_ld(unsigned* p) { return __hip_atomic_load(p, __ATOMIC_RELAXED, __HIP_MEMORY_SCOPE_AGENT); }
DI unsigned xb_add(unsigned* p, unsigned v) { return __hip_atomic_fetch_add(p, v, __ATOMIC_RELAXED, __HIP_MEMORY_SCOPE_AGENT); }
DI unsigned xb_xcc_id() { return (unsigned)__builtin_amdgcn_s_getreg((3 << 11) | 20) & 0xFu; }
#define XB_SPIN(cond, bar) do { unsigned _sp = 0; while (cond) { __builtin_amdgcn_s_sleep(1); \
    if ((++_sp & 255u) == 0u) { if (xb_ld(&(bar)[XB_TMO])) break; if (_sp > XB_SPIN_CAP) { atomicAdd(&(bar)[XB_TMO], 1u); break; } } } } while (0)
struct XcdBarrier { unsigned* bar; unsigned x; volatile LAS unsigned* st; };
DI XcdBarrier xcd_barrier_post(unsigned* bar, volatile LAS unsigned* st) {
  XcdBarrier b; b.bar = bar; b.x = xb_xcc_id(); b.st = st;
  if (threadIdx.x == 0) (void)xb_add(&bar[XB_XCNT(b.x)], 1u);
  return b;
}
DI void xcd_barrier_complete(unsigned* bar, unsigned x, unsigned& nloc, unsigned& nx) {
  const unsigned G = gridDim.x * gridDim.y * gridDim.z;
  unsigned sum, cnt, mine, sp = 0u;
  for (;;) {
    sum = 0u; cnt = 0u; mine = 0u;
#pragma unroll
    for (unsigned j = 0; j < 16; ++j) { const unsigned c = xb_ld(&bar[XB_XCNT(j)]); sum += c; cnt += (c > 0u) ? 1u : 0u; mine = (j == x) ? c : mine; }
    if (sum == G) break;
    __builtin_amdgcn_s_sleep(1);
    if ((++sp & 255u) == 0u) { if (xb_ld(&bar[XB_TMO])) break; if (sp > XB_SPIN_CAP) { atomicAdd(&bar[XB_TMO], 1u); break; } }
  }
  nloc = mine > 0u ? mine : 1u; nx = cnt > 0u ? cnt : 1u;
}
DI void xcd_barrier(const XcdBarrier& b) {
  asm volatile("s_waitcnt vmcnt(0)" ::: "memory");
  __syncthreads();
  if (threadIdx.x == 0) {
    unsigned* bar = b.bar;
    __builtin_amdgcn_s_waitcnt(0);
    unsigned nloc = b.st[0], nx = b.st[1];
    if (nloc == 0u) { xcd_barrier_complete(bar, b.x, nloc, nx); b.st[0] = nloc; b.st[1] = nx; }
    const unsigned old = xb_add(&bar[XB_XSUB(b.x)], 1u);
    const unsigned gen = old / nloc;
    if (old + 1u == (gen + 1u) * nloc) {
      __builtin_amdgcn_fence(__ATOMIC_RELEASE, "agent");
      asm volatile("s_waitcnt vmcnt(0)" ::: "memory");
      const unsigned og = xb_add(&bar[XB_TOP], 1u);
      const unsigned tg = og / nx;
      if (og + 1u == (tg + 1u) * nx) xb_add(&bar[XB_TOPGEN], 1u);
      else XB_SPIN(xb_ld(&bar[XB_TOPGEN]) == tg, bar);
      __builtin_amdgcn_fence(__ATOMIC_ACQUIRE, "agent");
      xb_add(&bar[XB_XGEN(b.x)], 1u);
      asm volatile("s_waitcnt vmcnt(0)" ::: "memory");
    } else {
      XB_SPIN(xb_ld(&bar[XB_XGEN(b.x)]) == gen, bar);
      __builtin_amdgcn_fence(__ATOMIC_ACQUIRE, "agent");
      asm volatile("s_waitcnt vmcnt(0)" ::: "memory");
    }
  }
  __syncthreads();
}
#ifndef DBL_MASK
#define DBL_MASK 0
#endif
#ifndef TIMING_PROBE
#define TIMING_PROBE 0
#endif
#ifndef TP_MASK_A
#define TP_MASK_A 0
#endif
#ifndef TP_MASK_B
#define TP_MASK_B 0
#endif
__global__ void __launch_bounds__(256, 2) mega_kernel(Params p, int ph_lo, int ph_hi) {
  if (ph_hi - ph_lo == 1) { run_phase(p, ph_lo); return; }
  cg::grid_group grid = cg::this_grid();
  volatile LAS unsigned* xst = (volatile LAS unsigned*)(g_smem + LDS_BYTES - 16);
  if (threadIdx.x == 0) { xst[0] = 0u; xst[1] = 0u; xst[2] = 0u; xst[3] = 0u; }
  __syncthreads();
  XcdBarrier xb = xcd_barrier_post((unsigned*)(p.ws + OFF_BAR), xst);
  for (int ph = ph_lo; ph < ph_hi; ++ph) {
    run_phase(p, ph);
#if DBL_MASK
    if (ph > 0 && ph < NPHASE - 1 && ((DBL_MASK >> ((ph - 1) % NPL)) & 1)) { xcd_barrier(xb); run_phase(p, ph); }
#endif
    if (ph + 1 < ph_hi) {
      if (ph == ph_lo) grid.sync();
      else xcd_barrier(xb);
    }
  }
}

extern "C" void kernel_launch(void* const* d_in, const int* in_sizes, int n_in, void* d_out, int out_size, void* d_ws, size_t ws_size,
                              hipStream_t stream) {
  static int grid_blocks = 0;
  if (!grid_blocks) {
    int dev = 0, cus = 0, per_cu = 0;
    hipGetDevice(&dev);
    hipDeviceGetAttribute(&cus, hipDeviceAttributeMultiprocessorCount, dev);
    hipFuncSetAttribute((const void*)mega_kernel, hipFuncAttributeMaxDynamicSharedMemorySize, LDS_BYTES);
    hipOccupancyMaxActiveBlocksPerMultiprocessor(&per_cu, mega_kernel, 256, LDS_BYTES);
    if (per_cu > 2) per_cu = 2;
    if (per_cu < 1) per_cu = 1;
    grid_blocks = cus * per_cu;
  }
  if (ws_size < WS_NEEDED) { fprintf(stderr, "workspace too small: %zu < %zu\n", ws_size, WS_NEEDED); return; }
  Params p{};
  for (int i = 0; i < 31; ++i) p.in[i] = (const float*)d_in[i];
  p.out = (float*)d_out;
  p.ws = (char*)d_ws;
#if MULTI_LAUNCH
  for (int ph = 0; ph < NPHASE; ++ph) {
    hipLaunchKernelGGL(mega_kernel, dim3(grid_blocks), dim3(256), LDS_BYTES, stream, p, ph, ph + 1);
  }
#else
  int lo = 0, hi = NPHASE;
  hipMemsetAsync((char*)d_ws + OFF_BAR, 0, 16384, stream);
  void* args[] = {&p, &lo, &hi};
  hipError_t e = hipLaunchCooperativeKernel((void*)mega_kernel, dim3(grid_blocks), dim3(256), args, LDS_BYTES, stream);
  if (e != hipSuccess) fprintf(stderr, "cooperative launch failed: %s (grid %d)\n", hipGetErrorString(e), grid_blocks);
#endif
}
```

```cpp
#include <hip/hip_runtime.h>
#include <hip/hip_cooperative_groups.h>
#include <cstdio>
namespace cg = cooperative_groups;

typedef unsigned short bfu;
using bf16x8 = __attribute__((ext_vector_type(8))) short;
using f32x4 = __attribute__((ext_vector_type(4))) float;
using u16x4 = __attribute__((ext_vector_type(4))) unsigned short;
using u16x8 = __attribute__((ext_vector_type(8))) unsigned short;
#define DI __device__ __forceinline__
#define MFMA16(a, b, c) __builtin_amdgcn_mfma_f32_16x16x32_bf16((a), (b), (c), 0, 0, 0)

#ifndef PH_MASK
#define PH_MASK 0xFFFFFF
#endif
#ifndef MULTI_LAUNCH
#define MULTI_LAUNCH 0
#endif

constexpr int TR = 32896;
constexpr int NCHK = 257;
constexpr int LBATCH = 16448;
constexpr int LDS_BYTES = 73728;
constexpr int NPL = 18;
constexpr int NPHASE = 1 + 4 * NPL + 1;

constexpr size_t OFF_H32 = 0;
constexpr size_t OFF_H16 = 134742016;
constexpr size_t OFF_Y = 202113024;
constexpr size_t OFF_P = 336855040;
constexpr size_t OFF_X = 471597056;
constexpr size_t OFF_SC = 623181824;
constexpr size_t OFF_PS = 627392512;
constexpr size_t OFF_W = 629497856;
constexpr size_t OFF_WIN = OFF_W;
constexpr size_t OFF_WS = OFF_WIN + 22020096;
constexpr size_t OFF_WGLU = OFF_WS + 32768;
constexpr size_t OFF_WB = OFF_WGLU + 1048576;
constexpr size_t OFF_WO = OFF_WB + 4194304;
constexpr size_t OFF_MS = OFF_WO + 2097152;
constexpr size_t OFF_MC = OFF_MS + 2097152;
constexpr size_t OFF_LB = OFF_MC + 6291456;
constexpr size_t OFF_LP = OFF_LB + 2048;
constexpr size_t OFF_BB = OFF_LP + 1114112;
constexpr size_t OFF_BAR = OFF_BB + 1048576;
constexpr size_t OFF_Z = OFF_BAR + 16384;
constexpr size_t WS_NEEDED = OFF_Z + 33685504;
constexpr size_t OFF_PZ = OFF_P;
constexpr size_t OFF_U2 = OFF_P + 33685504;
constexpr size_t OFF_YS5 = OFF_U2 + 35651584;
constexpr size_t OFF_XLOC = OFF_X;
constexpr size_t OFF_XST = OFF_X + 35651584;

struct Params {
  const float* in[31];
  float* out;
  char* ws;
};

extern __shared__ __attribute__((aligned(16))) char g_smem[];
DI int tid_laundered() { int t = threadIdx.x; asm volatile("" : "+v"(t)); return t; }
DI int bid_laundered() { int b = blockIdx.x; asm volatile("" : "+s"(b)); return b; }
#define TIDX tid_laundered()
#define BIDX bid_laundered()


DI bfu f2bf(float x) { unsigned u = __float_as_uint(x); u += 0x7fffu + ((u >> 16) & 1u); return (bfu)(u >> 16); }
DI float bf2f(bfu b) { return __uint_as_float(((unsigned)b) << 16); }
DI float sigm(float x) { return 1.f / (1.f + __expf(-x)); }
DI float siluf(float x) { return x / (1.f + __expf(-x)); }
DI float softplusf(float x) { return x > 20.f ? x : log1pf(expf(x)); }
DI float wave_sum(float v) {
#pragma unroll
  for (int m = 32; m >= 1; m >>= 1) v += __shfl_xor(v, m);
  return v;
}
DI float wave_scan_incl(float s, int lane) {
#pragma unroll
  for (int d = 1; d < 64; d <<= 1) { float o = __shfl_up(s, d); if (lane >= d) s += o; }
  return s;
}

template <int NREP>
DI void gemm_stage(const bfu* __restrict__ A, int lda, const bfu* __restrict__ Bt, int ldb, int kt, char* buf, int tid) {
#pragma unroll
  for (int i = 0; i < 2; ++i) {
    int b = tid * 16 + i * 4096; int r = b >> 6, c = (b & 63) >> 1;
    __builtin_amdgcn_global_load_lds((const unsigned*)(A + (long)r * lda + kt + c), (unsigned*)(buf + b), 16, 0, 0);
  }
#pragma unroll
  for (int i = 0; i < NREP / 2; ++i) {
    int b = tid * 16 + i * 4096; int r = b >> 6, c = (b & 63) >> 1;
    __builtin_amdgcn_global_load_lds((const unsigned*)(Bt + (long)r * ldb + kt + c), (unsigned*)(buf + 8192 + b), 16, 0, 0);
  }
}
template <int NREP>
DI void gemm_tile(f32x4 (&acc)[4][NREP], const bfu* __restrict__ A, int lda, const bfu* __restrict__ Bt, int ldb, int K) {
  const int tid = TIDX, lane = tid & 63, wid = tid >> 6, wr = wid >> 1, wc = wid & 1, fr = lane & 15, fq = lane >> 4;
  constexpr int GL = 2 + NREP / 2;
  const int nk = K >> 5;
  __syncthreads();
#pragma unroll
  for (int s = 0; s < 3; ++s)
    if (s < nk) gemm_stage<NREP>(A, lda, Bt, ldb, s * 32, g_smem + s * 16384, tid);
  for (int i = 0; i < nk; ++i) {
    const int younger = nk - 1 - i;
    if (younger >= 2) asm volatile("s_waitcnt vmcnt(%0)" ::"n"(2 * GL) : "memory");
    else if (younger == 1) asm volatile("s_waitcnt vmcnt(%0)" ::"n"(GL) : "memory");
    else asm volatile("s_waitcnt vmcnt(0)" ::: "memory");
    __builtin_amdgcn_s_barrier();
    if (i + 3 < nk) gemm_stage<NREP>(A, lda, Bt, ldb, (i + 3) * 32, g_smem + ((i + 3) & 3) * 16384, tid);
    const char* SA = g_smem + (i & 3) * 16384;
    const char* SB = SA + 8192;
    bf16x8 af[4], bfr[NREP];
#pragma unroll
    for (int m = 0; m < 4; ++m) af[m] = *(const bf16x8*)(SA + (wr * 64 + m * 16 + fr) * 64 + fq * 16);
#pragma unroll
    for (int n = 0; n < NREP; ++n) bfr[n] = *(const bf16x8*)(SB + (wc * (NREP * 16) + n * 16 + fr) * 64 + fq * 16);
#pragma unroll
    for (int m = 0; m < 4; ++m)
#pragma unroll
      for (int n = 0; n < NREP; ++n) acc[m][n] = MFMA16(af[m], bfr[n], acc[m][n]);
  }
}
template <int NREP>
DI void zero_acc(f32x4 (&acc)[4][NREP]) {
#pragma unroll
  for (int m = 0; m < 4; ++m)
#pragma unroll
    for (int n = 0; n < NREP; ++n) acc[m][n] = f32x4{0.f, 0.f, 0.f, 0.f};
}
#define ACC_FOREACH(NREP_, ...)                                                                \
  {                                                                                              \
    const int lane_ = TIDX & 63, wid_ = TIDX >> 6, wr_ = wid_ >> 1, wc_ = wid_ & 1; \
    const int fr_ = lane_ & 15, fq_ = lane_ >> 4;                                                \
    _Pragma("unroll") for (int m = 0; m < 4; ++m) _Pragma("unroll") for (int n = 0; n < NREP_; ++n) \
        _Pragma("unroll") for (int j = 0; j < 4; ++j) {                                          \
      const int trow = wr_ * 64 + m * 16 + fq_ * 4 + j;                                          \
      const int tcol = wc_ * (NREP_ * 16) + n * 16 + fr_;                                        \
      __VA_ARGS__                                                                                \
    }                                                                                            \
  }

DI void phase_tables(const Params& p) {
  const int gtid = BIDX * 256 + TIDX, gth = gridDim.x * 256;
  float2* LP = (float2*)(p.ws + OFF_LP);
  float2* BB = (float2*)(p.ws + OFF_BB);
  for (int idx = gtid; idx < 4 * 32 * 64; idx += gth) {
    int l = idx >> 11, g = (idx >> 6) & 31;
    float dt = expf(p.in[24][l * 32 + g]);
    float are = p.in[17][idx], aim = p.in[18][idx];
    float e1 = are * dt, a1 = aim * dt;
    for (int d = 0; d <= 16; ++d) {
      float mag = expf((float)d * e1), ang = (float)d * a1;
      LP[(long)idx * 17 + d] = make_float2(mag * cosf(ang), mag * sinf(ang));
    }
    float mag = expf(e1);
    float lre = mag * cosf(a1), lim = mag * sinf(a1);
    float den = are * are + aim * aim;
    float nr = lre - 1.f, ni = lim;
    float zre = (nr * are + ni * aim) / den, zim = (ni * are - nr * aim) / den;
    for (int c = 0; c < 16; ++c) {
      float bre = p.in[19][(long)idx * 16 + c], bim = p.in[20][(long)idx * 16 + c];
      BB[(long)idx * 16 + c] = make_float2(zre * bre - zim * bim, zre * bim + zim * bre);
    }
  }
}

DI void ln_rows(const Params& p, int layer, bool final_) {
  float* h32 = (float*)(p.ws + OFF_H32);
  bfu* h16 = (bfu*)(p.ws + OFF_H16);
  const int lane = TIDX & 63;
  const int gw = BIDX * 4 + (TIDX >> 6), nw = gridDim.x * 4;
  const float* gam = layer < 0 ? p.in[2] : p.in[29] + layer * 1024;
  const float* bet = layer < 0 ? p.in[3] : p.in[30] + layer * 1024;
  for (int r = gw; r < TR; r += nw) {
    int b = r / LBATCH, pos = r - b * LBATCH;
    float* d32 = h32 + (long)r * 1024;
    bfu* d16 = h16 + (long)r * 1024;
    if (pos < 48) {
      if (!final_) {
#pragma unroll
        for (int i = 0; i < 4; ++i) {
          *(float4*)(d32 + i * 256 + lane * 4) = make_float4(0.f, 0.f, 0.f, 0.f);
          *(u16x4*)(d16 + i * 256 + lane * 4) = u16x4{0, 0, 0, 0};
        }
      }
      continue;
    }
    const float* src;
    if (layer < 0) src = pos < 64 ? p.in[1] + (pos - 48) * 1024 : p.in[0] + ((long)b * 16384 + (pos - 64)) * 1024;
    else src = d32;
    float4 v[4];
    float s = 0.f;
#pragma unroll
    for (int i = 0; i < 4; ++i) { v[i] = *(const float4*)(src + i * 256 + lane * 4); s += v[i].x + v[i].y + v[i].z + v[i].w; }
    float mu = wave_sum(s) * (1.f / 1024.f);
    float q = 0.f;
#pragma unroll
    for (int i = 0; i < 4; ++i) {
      v[i].x -= mu; v[i].y -= mu; v[i].z -= mu; v[i].w -= mu;
      q += v[i].x * v[i].x + v[i].y * v[i].y + v[i].z * v[i].z + v[i].w * v[i].w;
    }
    float rs = rsqrtf(wave_sum(q) * (1.f / 1024.f) + 1e-5f);
#pragma unroll
    for (int i = 0; i < 4; ++i) {
      float4 g4 = *(const float4*)(gam + i * 256 + lane * 4), b4 = *(const float4*)(bet + i * 256 + lane * 4);
      float4 o = make_float4(v[i].x * rs * g4.x + b4.x, v[i].y * rs * g4.y + b4.y, v[i].z * rs * g4.z + b4.z, v[i].w * rs * g4.w + b4.w);
      if (final_) {
        if (pos >= 64) *(float4*)(p.out + ((long)b * 16384 + (pos - 64)) * 1024 + i * 256 + lane * 4) = o;
      } else {
        *(float4*)(d32 + i * 256 + lane * 4) = o;
        *(u16x4*)(d16 + i * 256 + lane * 4) = u16x4{f2bf(o.x), f2bf(o.y), f2bf(o.z), f2bf(o.w)};
      }
    }
  }
}

template <class F>
DI void conv_T(bfu* dst, int N, int K, F src) {
  const long gtid = BIDX * 256 + TIDX, gth = (long)gridDim.x * 256;
  const long total = (long)N * (K / 8);
  for (long idx = gtid; idx < total; idx += gth) {
    int n = (int)(idx % N); int kg = (int)(idx / N);
    u16x8 o;
#pragma unroll
    for (int j = 0; j < 8; ++j) o[j] = f2bf(src(kg * 8 + j, n));
    *(u16x8*)(dst + (long)n * K + kg * 8) = o;
  }
}

DI void phase_convert(const Params& p, int l) {
  const float* win = p.in[4] + (long)l * 1024 * 10768;
  conv_T((bfu*)(p.ws + OFF_WIN), 10752, 1024, [&](int k, int n) {
    int sc = n < 2048 ? n : n < 3584 ? n + 8 : n < 5632 ? n + 16 : n < 6656 ? n + 16 : n + 16;
    return win[(long)k * 10768 + sc];
  });
  conv_T((bfu*)(p.ws + OFF_WS), 16, 1024, [&](int k, int n) { int sc = n < 8 ? 2048 + n : 3592 + (n - 8); return win[(long)k * 10768 + sc]; });
  const float* w1 = p.in[25] + (long)l * 512 * 512;
  const float* w2 = p.in[26] + (long)l * 512 * 512;
  conv_T((bfu*)(p.ws + OFF_WGLU), 1024, 512, [&](int k, int r) {
    int j = r >> 7, wc = (r >> 6) & 1, n = (r >> 4) & 3, fr = r & 15;
    int oc = j * 64 + wc * 32 + (n & 1) * 16 + fr;
    return (n >> 1) ? w2[k * 512 + oc] : w1[k * 512 + oc];
  });
  const float* wb = p.in[27] + (long)l * 4 * 512 * 1024;
  conv_T((bfu*)(p.ws + OFF_WB), 4096, 512, [&](int k, int r) { int b = r >> 10, n = r & 1023; return wb[((long)b * 512 + k) * 1024 + n]; });
  const float* wo = p.in[28] + (long)l * 1024 * 1024;
  conv_T((bfu*)(p.ws + OFF_WO), 1024, 1024, [&](int k, int n) { return wo[(long)k * 1024 + n]; });
  const int gtid = BIDX * 256 + TIDX, gth = gridDim.x * 256;
  float* lbv = (float*)(p.ws + OFF_LB);
  for (int c = gtid; c < 512; c += gth) {
    float v0 = p.in[15][c], v1 = p.in[15][512 + c], v2 = p.in[15][1024 + c], v3 = p.in[15][1536 + c];
    float mx = fmaxf(fmaxf(v0, v1), fmaxf(v2, v3));
    float e0 = expf(v0 - mx), e1 = expf(v1 - mx), e2 = expf(v2 - mx), e3 = expf(v3 - mx);
    float inv = 1.f / (e0 + e1 + e2 + e3);
    float acc = 0.f;
    if (l >= 1) acc += e1 * inv;
    if (l >= 2) acc += e2 * inv;
    if (l >= 3) acc += e3 * inv;
    lbv[c] = acc;
  }
  const float2* LP = (const float2*)(p.ws + OFF_LP) + (long)l * 32 * 64 * 17;
  const float2* BB = (const float2*)(p.ws + OFF_BB) + (long)l * 32 * 64 * 16;
  const float* cre = p.in[21] + (long)l * 32 * 16 * 64;
  const float* cim = p.in[22] + (long)l * 32 * 16 * 64;
  const float* dd = p.in[23] + l * 512;
  bfu* Ms = (bfu*)(p.ws + OFF_MS);
  bfu* Mc = (bfu*)(p.ws + OFF_MC);
  for (int idx = gtid; idx < 32 * 128 * 256; idx += gth) {
    int g = idx >> 15, pp = (idx >> 8) & 127, kk = idx & 255;
    int s = kk >> 4, c2 = kk & 15, pr = pp & 63;
    float2 lp = LP[((long)g * 64 + pr) * 17 + (15 - s)];
    float2 bb = BB[((long)g * 64 + pr) * 16 + c2];
    float v = pp < 64 ? lp.x * bb.x - lp.y * bb.y : lp.x * bb.y + lp.y * bb.x;
    Ms[idx] = f2bf(v);
  }
  for (int idx = gtid; idx < 32 * 256 * 384; idx += gth) {
    int g = idx / (256 * 384); int rem = idx - g * (256 * 384);
    int o = rem / 384, kk = rem - o * 384;
    int t = o >> 4, c = o & 15;
    float v = 0.f;
    const float* cr = cre + ((long)g * 16 + c) * 64;
    const float* ci = cim + ((long)g * 16 + c) * 64;
    if (kk < 256) {
      int s = kk >> 4, c2 = kk & 15;
      if (t >= s) {
        int d = t - s;
        for (int pr = 0; pr < 64; ++pr) {
          float2 lp = LP[((long)g * 64 + pr) * 17 + d];
          float2 bb = BB[((long)g * 64 + pr) * 16 + c2];
          float ere = lp.x * bb.x - lp.y * bb.y, eim = lp.x * bb.y + lp.y * bb.x;
          v += cr[pr] * ere - ci[pr] * eim;
        }
        if (kk == o) v += dd[g * 16 + c];
      }
    } else {
      int pp = kk - 256, pr = pp & 63;
      float2 lp = LP[((long)g * 64 + pr) * 17 + (t + 1)];
      v = pp < 64 ? cr[pr] * lp.x - ci[pr] * lp.y : -(cr[pr] * lp.y + ci[pr] * lp.x);
    }
    Mc[idx] = f2bf(v);
  }
}

DI bool tile_map(int v, int ntn, int& tm, int& tn) {
  const int x = v & 7, j = v >> 3, sidx = j >> 5, within = j & 31, ntng = ntn >> 2;
  const int gq = sidx / ntng, tng = sidx - gq * ntng;
  tm = (gq * 8 + x) * 8 + (within >> 2);
  tn = tng * 4 + (within & 3);
  return tm < 257;
}
DI void phase_proj(const Params& p, int wrow0, int ncols, int mode, bool with_small, int boff, int nskip = 0) {
  const bfu* h16 = (const bfu*)(p.ws + OFF_H16);
  const bfu* WT = (const bfu*)(p.ws + OFF_WIN);
  bfu* P = (bfu*)(p.ws + OFF_P);
  bfu* U2 = (bfu*)(p.ws + OFF_U2);
  const int ntn = ncols >> 7;
  const int G = gridDim.x - boff - nskip;
  const int bsel = BIDX;
  if (nskip && bsel >= 256 && bsel < 256 + nskip) return;
  const int bidx = bsel - boff - ((nskip && bsel >= 256) ? nskip : 0);
  for (int v = bidx; v < 320 * ntn; v += G) {
    int tm, tn;
    if (!tile_map(v, ntn, tm, tn)) continue;
    {
      f32x4 acc[4][4];
      zero_acc<4>(acc);
      gemm_tile<4>(acc, h16 + (long)tm * 128 * 1024, 1024, WT + (long)(wrow0 + tn * 128) * 1024, 1024, 1024);
      if (mode == 0) {
        ACC_FOREACH(4, { P[(long)(tm * 128 + trow) * ncols + tn * 128 + tcol] = f2bf(acc[m][n][j]); })
      } else {
        ACC_FOREACH(4, {
          int row = tm * 128 + trow, col = tn * 128 + tcol;
          if (col < 512) { int g = col >> 4, c2 = col & 15; U2[((long)g * 2176 + (row >> 4)) * 256 + (row & 15) * 16 + c2] = f2bf(acc[m][n][j]); }
          else P[(long)row * 512 + (col - 512)] = f2bf(acc[m][n][j]);
        })
      }
    }
  }
  if (with_small) for (int tm = bidx; tm < 257; tm += G) {
    {
      const int lane = TIDX & 63, w = TIDX >> 6, fr = lane & 15, fq = lane >> 4;
      const bfu* WsT = (const bfu*)(p.ws + OFF_WS);
      float* Ps = (float*)(p.ws + OFF_PS);
      f32x4 a0 = {0.f, 0.f, 0.f, 0.f}, a1 = {0.f, 0.f, 0.f, 0.f};
      const bfu* pa0 = h16 + (long)(tm * 128 + w * 32 + fr) * 1024 + fq * 8;
      const bfu* pa1 = pa0 + 16 * 1024;
      const bfu* pb = WsT + fr * 1024 + fq * 8;
      for (int k = 0; k < 1024; k += 32) {
        bf16x8 x0 = *(const bf16x8*)(pa0 + k), x1 = *(const bf16x8*)(pa1 + k), y = *(const bf16x8*)(pb + k);
        a0 = MFMA16(x0, y, a0);
        a1 = MFMA16(x1, y, a1);
      }
#pragma unroll
      for (int j = 0; j < 4; ++j) {
        Ps[(long)(tm * 128 + w * 32 + fq * 4 + j) * 16 + fr] = a0[j];
        Ps[(long)(tm * 128 + w * 32 + 16 + fq * 4 + j) * 16 + fr] = a1[j];
      }
    }
  }
}

DI void copy_z(const Params& p, const bfu* src, int sld, bfu* dst, int pieces_per_row) {
  const int tid = TIDX;
  const int total = 64 * pieces_per_row;
  for (int i = tid; i < total; i += 256) {
    int r = i / pieces_per_row, c = i - r * pieces_per_row;
    *(u16x8*)(dst + (long)r * 512 + c * 8) = *(const u16x8*)(src + (long)r * sld + c * 8);
  }
}
DI void gdn_prep_item(const Params& p, int layer, int item) {
  const int tid = TIDX, lane = tid & 63, w = tid >> 6, fr = lane & 15, fq = lane >> 4;
  const int h = item & 3, cn = item >> 2, n = cn % NCHK;
  const long r0 = (long)cn * 64;
  const bfu* P = (const bfu*)(p.ws + OFF_P);
  const float* Ps = (const float*)(p.ws + OFF_PS);
  bfu* Xb = (bfu*)(p.ws + OFF_X) + (long)item * 36864;
  float* SC = (float*)(p.ws + OFF_SC) + (long)item * 256;
  bfu* rawQ = (bfu*)g_smem;
  bfu* rawK = rawQ + 64 * 136;
  bfu* rawV = rawK + 64 * 136;
  float* aL = (float*)(g_smem + 52224);
  float* sm = (float*)(g_smem + 69632);
  const float* cw = p.in[5] + layer * 4 * 1536;
  copy_z(p, P + r0 * 2048 + 1536 + h * 128, 2048, (bfu*)(p.ws + OFF_Z) + r0 * 512 + h * 128, 16);
  if (w < 3) {
    const int cgp = tid % 48, seg = tid / 48;
    const int which = cgp >> 4, c8 = (cgp & 15) * 8;
    const int col = which * 512 + h * 128 + c8;
    const int t0 = seg * 16;
    u16x8 xr[19];
    const bool nohist = (seg == 0 && n == 0);
#pragma unroll
    for (int i = 0; i < 19; ++i) {
      const bool valid = !(nohist && i < 3);
      const long rr = valid ? (r0 + t0 - 3 + i) : r0;
      u16x8 v = *(const u16x8*)(P + rr * 2048 + col);
      xr[i] = valid ? v : u16x8{0, 0, 0, 0, 0, 0, 0, 0};
    }
    float wt[4][8];
#pragma unroll
    for (int j = 0; j < 4; ++j) {
      float4 a4 = *(const float4*)(cw + j * 1536 + col), b4 = *(const float4*)(cw + j * 1536 + col + 4);
      wt[j][0] = a4.x; wt[j][1] = a4.y; wt[j][2] = a4.z; wt[j][3] = a4.w; wt[j][4] = b4.x; wt[j][5] = b4.y; wt[j][6] = b4.z; wt[j][7] = b4.w;
    }
    bfu* dst = rawQ + which * (64 * 136) + c8;
#pragma unroll
    for (int r = 0; r < 16; ++r) {
      u16x8 o;
#pragma unroll
      for (int c = 0; c < 8; ++c) {
        float v = wt[0][c] * bf2f(xr[r][c]) + wt[1][c] * bf2f(xr[r + 1][c]) + wt[2][c] * bf2f(xr[r + 2][c]) + wt[3][c] * bf2f(xr[r + 3][c]);
        o[c] = f2bf(siluf(v));
      }
      *(u16x8*)(dst + (t0 + r) * 136) = o;
    }
  }
  if (w == 3) {
    const float* ps = Ps + (r0 + lane) * 16;
    float be = sigm(ps[h]);
    float gl = -__expf(p.in[6][layer * 4 + h]) * softplusf(ps[4 + h] + p.in[7][layer * 4 + h]);
    float s = wave_scan_incl(gl, lane);
    sm[128 + lane] = be;
    sm[192 + lane] = s;
  }
  __syncthreads();
  if (tid < 128) {
    int row = tid & 63, mat = tid >> 6;
    const bfu* rp = rawQ + mat * (64 * 136) + row * 136;
    float ss = 0.f;
    for (int c = 0; c < 128; ++c) { float v = bf2f(rp[c]); ss += v * v; }
    float sc = rsqrtf(ss + 1e-6f);
    if (mat == 0) sc *= 0.08838834764831845f;
    sm[mat * 64 + row] = sc;
  }
  __syncthreads();
  if (tid < 64) { float be = sm[128 + tid]; sm[256 + tid] = be; sm[320 + tid] = be * sm[64 + tid] * __expf(sm[192 + tid]); }
  {
    bf16x8 kf[4], qf[4];
#pragma unroll
    for (int ks = 0; ks < 4; ++ks) {
      kf[ks] = *(const bf16x8*)(rawK + (16 * w + fr) * 136 + ks * 32 + fq * 8);
      qf[ks] = *(const bf16x8*)(rawQ + (16 * w + fr) * 136 + ks * 32 + fq * 8);
    }
    bfu* AMg = Xb + 32768;
    for (int tj = 0; tj < 4; ++tj) {
      if (tj <= w) {
        f32x4 akk = {0.f, 0.f, 0.f, 0.f}, aqk = {0.f, 0.f, 0.f, 0.f};
#pragma unroll
        for (int ks = 0; ks < 4; ++ks) {
          bf16x8 bk = *(const bf16x8*)(rawK + (16 * tj + fr) * 136 + ks * 32 + fq * 8);
          akk = MFMA16(kf[ks], bk, akk);
          aqk = MFMA16(qf[ks], bk, aqk);
        }
        int j = 16 * tj + fr;
        float rkj = sm[64 + j], gcj = sm[192 + j];
#pragma unroll
        for (int r = 0; r < 4; ++r) {
          int i = 16 * w + fq * 4 + r;
          float dec = (i >= j) ? __expf(sm[192 + i] - gcj) : 0.f;
          aL[i * 68 + j] = (i > j) ? sm[128 + i] * sm[64 + i] * rkj * akk[r] * dec : 0.f;
          AMg[i * 64 + j] = f2bf((i >= j) ? sm[i] * rkj * aqk[r] * dec : 0.f);
        }
      } else {
#pragma unroll
        for (int r = 0; r < 4; ++r) AMg[(16 * w + fq * 4 + r) * 64 + 16 * tj + fr] = 0;
      }
    }
  }
  __syncthreads();
  {
    const bfu* src = (tid < 128) ? (rawV + tid) : (rawK + (tid - 128));
    const float* rs = sm + ((tid < 128) ? 256 : 320);
    float x[64];
#pragma unroll
    for (int i = 0; i < 64; ++i) {
      float a = bf2f(src[i * 136]) * rs[i];
#pragma unroll
      for (int j = 0; j < i; ++j) a -= aL[i * 68 + j] * x[j];
      x[i] = a;
    }
    if (tid < 128) {
      bfu* UT = Xb + 24576 + tid * 64;
#pragma unroll
      for (int i = 0; i < 64; i += 8) {
        u16x8 o;
#pragma unroll
        for (int j = 0; j < 8; ++j) o[j] = f2bf(x[i + j]);
        *(u16x8*)(UT + i) = o;
      }
    } else {
      bfu* Wg = Xb + 8192 + (tid - 128);
#pragma unroll
      for (int i = 0; i < 64; ++i) Wg[i * 128] = f2bf(x[i]);
    }
  }
  {
    bfu* QDg = Xb;
    bfu* KDTg = Xb + 16384;
    float gl_last = sm[192 + 63];
    for (int idx = tid; idx < 8192; idx += 256) { int i = idx >> 7, c = idx & 127; QDg[idx] = f2bf(bf2f(rawQ[i * 136 + c]) * sm[i] * __expf(sm[192 + i])); }
    for (int idx = tid; idx < 8192; idx += 256) { int c = idx >> 6, i = idx & 63; KDTg[idx] = f2bf(bf2f(rawK[i * 136 + c]) * sm[64 + i] * __expf(gl_last - sm[192 + i])); }
    if (tid < 128) SC[128 + tid] = __expf(gl_last);
  }
  __syncthreads();
}

DI void ssd_prep_item(const Params& p, int layer, int item) {
  const int tid = TIDX, lane = tid & 63, w = tid >> 6, fr = lane & 15, fq = lane >> 4;
  const int g = item & 1, cn = item >> 1, n = cn % NCHK;
  const long r0 = (long)cn * 64;
  const bfu* P = (const bfu*)(p.ws + OFF_P);
  const float* Ps = (const float*)(p.ws + OFF_PS);
  bfu* Xb = (bfu*)(p.ws + OFF_X) + (long)cn * 131072;
  float* SCb = (float*)(p.ws + OFF_SC) + (long)cn * 8 * 256;
  bfu* Bm = (bfu*)g_smem;
  bfu* Cm = Bm + 64 * 136;
  float* cb = (float*)(g_smem + 34816);
  float* sm = (float*)(g_smem + 34816 + 17408);
  {
    int hd = g * 4 + w;
    float dtv = softplusf(Ps[(r0 + lane) * 16 + 8 + hd] + p.in[11][layer * 8 + hd]);
    float a = -dtv * __expf(p.in[12][layer * 8 + hd]);
    float ac = wave_scan_incl(a, lane);
    sm[w * 64 + lane] = dtv;
    sm[256 + w * 64 + lane] = ac;
  }
  __syncthreads();
  const float* cw = p.in[9] + layer * 4 * 1024;
  const float* cbias = p.in[10] + layer * 1024;
  copy_z(p, P + r0 * 1536 + 1024 + g * 256, 1536, (bfu*)(p.ws + OFF_Z) + r0 * 512 + g * 256, 32);
  {
    const int cg8 = tid & 63, seg = tid >> 6, t0 = seg * 16;
    const int col = (cg8 < 16) ? 512 + g * 128 + cg8 * 8 : (cg8 < 32) ? 768 + g * 128 + (cg8 - 16) * 8 : g * 256 + (cg8 - 32) * 8;
    u16x8 xr[19];
    const bool nohist = (seg == 0 && n == 0);
#pragma unroll
    for (int i = 0; i < 19; ++i) {
      const bool valid = !(nohist && i < 3);
      const long rr = valid ? (r0 + t0 - 3 + i) : r0;
      u16x8 v = *(const u16x8*)(P + rr * 1536 + col);
      xr[i] = valid ? v : u16x8{0, 0, 0, 0, 0, 0, 0, 0};
    }
    float wt[4][8], bias[8];
#pragma unroll
    for (int j = 0; j < 4; ++j) {
      float4 a4 = *(const float4*)(cw + j * 1024 + col), b4 = *(const float4*)(cw + j * 1024 + col + 4);
      wt[j][0] = a4.x; wt[j][1] = a4.y; wt[j][2] = a4.z; wt[j][3] = a4.w; wt[j][4] = b4.x; wt[j][5] = b4.y; wt[j][6] = b4.z; wt[j][7] = b4.w;
    }
    {
      float4 a4 = *(const float4*)(cbias + col), b4 = *(const float4*)(cbias + col + 4);
      bias[0] = a4.x; bias[1] = a4.y; bias[2] = a4.z; bias[3] = a4.w; bias[4] = b4.x; bias[5] = b4.y; bias[6] = b4.z; bias[7] = b4.w;
    }
    if (cg8 < 32) {
      bfu* dst = (cg8 < 16) ? (Bm + cg8 * 8) : (Cm + (cg8 - 16) * 8);
#pragma unroll
      for (int r = 0; r < 16; ++r) {
        u16x8 o;
        const bool padrow = (n == 0 && t0 + r < 48);
#pragma unroll
        for (int c = 0; c < 8; ++c) {
          float v = wt[0][c] * bf2f(xr[r][c]) + wt[1][c] * bf2f(xr[r + 1][c]) + wt[2][c] * bf2f(xr[r + 2][c]) + wt[3][c] * bf2f(xr[r + 3][c]) + bias[c];
          o[c] = padrow ? (bfu)0 : f2bf(siluf(v));
        }
        *(u16x8*)(dst + (t0 + r) * 136) = o;
      }
    } else {
      const int hh = (cg8 - 32) >> 3, pp8 = ((cg8 - 32) & 7) * 8;
      bfu* vtb = Xb + 32768 + (g * 4 + hh) * 12288 + 4096;
      const float alast = sm[256 + hh * 64 + 63];
#pragma unroll
      for (int q4 = 0; q4 < 4; ++q4) {
        float dtv[4], ksv[4];
#pragma unroll
        for (int rr = 0; rr < 4; ++rr) {
          int t = t0 + q4 * 4 + rr;
          const bool padrow = (n == 0 && t < 48);
          dtv[rr] = padrow ? 0.f : sm[hh * 64 + t];
          ksv[rr] = __expf(alast - sm[256 + hh * 64 + t]);
        }
#pragma unroll
        for (int c = 0; c < 8; ++c) {
          u16x4 oa, ob;
#pragma unroll
          for (int rr = 0; rr < 4; ++rr) {
            int r = q4 * 4 + rr;
            float v = wt[0][c] * bf2f(xr[r][c]) + wt[1][c] * bf2f(xr[r + 1][c]) + wt[2][c] * bf2f(xr[r + 2][c]) + wt[3][c] * bf2f(xr[r + 3][c]) + bias[c];
            float xd = siluf(v) * dtv[rr];
            oa[rr] = f2bf(xd);
            ob[rr] = f2bf(xd * ksv[rr]);
          }
          *(u16x4*)(vtb + (pp8 + c) * 64 + t0 + q4 * 4) = oa;
          *(u16x4*)(vtb + 4096 + (pp8 + c) * 64 + t0 + q4 * 4) = ob;
        }
      }
    }
  }
  __syncthreads();
  {
    bf16x8 cf[4];
#pragma unroll
    for (int ks = 0; ks < 4; ++ks) cf[ks] = *(const bf16x8*)(Cm + (16 * w + fr) * 136 + ks * 32 + fq * 8);
    for (int tj = 0; tj < 4; ++tj) {
      if (tj <= w) {
        f32x4 a = {0.f, 0.f, 0.f, 0.f};
#pragma unroll
        for (int ks = 0; ks < 4; ++ks) {
          bf16x8 bk = *(const bf16x8*)(Bm + (16 * tj + fr) * 136 + ks * 32 + fq * 8);
          a = MFMA16(cf[ks], bk, a);
        }
#pragma unroll
        for (int r = 0; r < 4; ++r) cb[(16 * w + fq * 4 + r) * 68 + 16 * tj + fr] = a[r];
      }
    }
    bfu* Cg = Xb + g * 16384;
    bfu* BTg = Cg + 8192;
    for (int idx = tid; idx < 8192; idx += 256) Cg[idx] = Cm[(idx >> 7) * 136 + (idx & 127)];
    for (int idx = tid; idx < 8192; idx += 256) BTg[idx] = Bm[(idx & 63) * 136 + (idx >> 6)];
  }
  __syncthreads();
  for (int hh = 0; hh < 4; ++hh) {
    int hd = g * 4 + hh;
    bfu* AMg = Xb + 32768 + hd * 12288;
    float Dh = p.in[13][layer * 8 + hd];
    const float* dtp = sm + hh * 64;
    const float* acp = sm + 256 + hh * 64;
    for (int idx = tid; idx < 4096; idx += 256) {
      int l = idx >> 6, m = idx & 63;
      float v = (m <= l) ? cb[l * 68 + m] * __expf(acp[l] - acp[m]) : 0.f;
      if (m == l) v += Dh / dtp[l];
      AMg[idx] = f2bf(v);
    }
    float* sc = SCb + hd * 256;
    float alast = acp[63];
    if (tid < 64) { sc[tid] = __expf(acp[tid]); sc[64 + tid] = __expf(alast - acp[tid]); }
    else if (tid < 192) sc[128 + (tid - 64)] = __expf(alast);
  }
  __syncthreads();
}

DI void hg_prep_item(const Params& p, int layer, int item) {
  const int tid = TIDX, lane = tid & 63, w = tid >> 6, fr = lane & 15, fq = lane >> 4;
  const int h = item & 3, cn = item >> 2;
  const long r0 = (long)cn * 64;
  const bfu* P = (const bfu*)(p.ws + OFF_P);
  const float* lbv = (const float*)(p.ws + OFF_LB);
  bfu* Xb = (bfu*)(p.ws + OFF_X) + (long)item * 28672;
  float* SC = (float*)(p.ws + OFF_SC) + (long)item * 256;
  bfu* Qall = (bfu*)g_smem;
  bfu* Ks = Qall + 160 * 136;
  float* segs = (float*)(g_smem + 60928);
  bfu* QDg = Xb;
  bfu* KDTg = Xb + 8192;
  bfu* AMg = Xb + 16384;
  bfu* VTg = Xb + 20480;
  copy_z(p, P + r0 * 2048 + 1536 + h * 128, 2048, (bfu*)(p.ws + OFF_Z) + r0 * 512 + h * 128, 16);
  {
    const int k8 = (tid & 15) * 8, rs = tid >> 4, t0 = rs * 4;
    u16x8 fr4[4], qr4[4], ir4[4];
    const bfu* base = P + (r0 + t0) * 2048 + h * 128 + k8;
#pragma unroll
    for (int r = 0; r < 4; ++r) {
      qr4[r] = *(const u16x8*)(base + (long)r * 2048);
      fr4[r] = *(const u16x8*)(base + (long)r * 2048 + 512);
      ir4[r] = *(const u16x8*)(base + (long)r * 2048 + 1024);
    }
    float lb[8];
    {
      float4 a4 = *(const float4*)(lbv + h * 128 + k8), b4 = *(const float4*)(lbv + h * 128 + k8 + 4);
      lb[0] = a4.x; lb[1] = a4.y; lb[2] = a4.z; lb[3] = a4.w; lb[4] = b4.x; lb[5] = b4.y; lb[6] = b4.z; lb[7] = b4.w;
    }
    float lf[4][8];
    float ssum[8];
#pragma unroll
    for (int c = 0; c < 8; ++c) ssum[c] = 0.f;
#pragma unroll
    for (int r = 0; r < 4; ++r)
#pragma unroll
      for (int c = 0; c < 8; ++c) {
        float zf = bf2f(fr4[r][c]);
        float f = lb[c] + (1.f - lb[c]) * (1.f / (1.f + __expf(-zf)));
        lf[r][c] = __logf(f);
        ssum[c] += lf[r][c];
      }
    *(float4*)(segs + rs * 128 + k8) = make_float4(ssum[0], ssum[1], ssum[2], ssum[3]);
    *(float4*)(segs + rs * 128 + k8 + 4) = make_float4(ssum[4], ssum[5], ssum[6], ssum[7]);
#pragma unroll
    for (int c = 0; c < 8; ++c) {
      u16x4 o = {ir4[0][c], ir4[1][c], ir4[2][c], ir4[3][c]};
      *(u16x4*)(VTg + (k8 + c) * 64 + t0) = o;
    }
    __syncthreads();
    float Gb[8], G1[8], G2[8], G3[8], GL[8];
#pragma unroll
    for (int c = 0; c < 8; ++c) { Gb[c] = 0.f; G1[c] = 0.f; G2[c] = 0.f; G3[c] = 0.f; GL[c] = 0.f; }
    for (int s2 = 0; s2 < 16; ++s2) {
      float4 a4 = *(const float4*)(segs + s2 * 128 + k8), b4 = *(const float4*)(segs + s2 * 128 + k8 + 4);
      float v[8] = {a4.x, a4.y, a4.z, a4.w, b4.x, b4.y, b4.z, b4.w};
#pragma unroll
      for (int c = 0; c < 8; ++c) {
        if (s2 < rs) Gb[c] += v[c];
        if (s2 < 4) G1[c] += v[c];
        if (s2 < 8) G2[c] += v[c];
        if (s2 < 12) G3[c] += v[c];
        GL[c] += v[c];
      }
    }
    const int Jt = rs >> 2;
    float G[8];
#pragma unroll
    for (int c = 0; c < 8; ++c) G[c] = Gb[c];
#pragma unroll
    for (int r = 0; r < 4; ++r) {
      const int t = t0 + r;
      u16x8 oq, oq1, oq2, oq3, ok;
#pragma unroll
      for (int c = 0; c < 8; ++c) {
        G[c] += lf[r][c];
        float zf = bf2f(fr4[r][c]);
        float kk = (1.f - lb[c]) * (1.f / (1.f + __expf(zf)));
        float q = siluf(bf2f(qr4[r][c]));
        oq[c] = f2bf(q * __expf(G[c]));
        oq1[c] = f2bf(q * __expf(G[c] - G1[c]));
        oq2[c] = f2bf(q * __expf(G[c] - G2[c]));
        oq3[c] = f2bf(q * __expf(G[c] - G3[c]));
        float GJ = (Jt == 0) ? 0.f : (Jt == 1) ? G1[c] : (Jt == 2) ? G2[c] : G3[c];
        ok[c] = f2bf(kk * __expf(fminf(GJ - G[c], 80.f)));
      }
      *(u16x8*)(QDg + t * 128 + k8) = oq;
      *(u16x8*)(Qall + t * 136 + k8) = oq;
      if (t >= 16) *(u16x8*)(Qall + (64 + t - 16) * 136 + k8) = oq1;
      if (t >= 32) *(u16x8*)(Qall + (112 + t - 32) * 136 + k8) = oq2;
      if (t >= 48) *(u16x8*)(Qall + (144 + t - 48) * 136 + k8) = oq3;
      *(u16x8*)(Ks + t * 136 + k8) = ok;
    }
#pragma unroll
    for (int c = 0; c < 8; ++c) {
      float Gc = Gb[c];
      u16x4 o;
#pragma unroll
      for (int r = 0; r < 4; ++r) {
        Gc += lf[r][c];
        float zf = bf2f(fr4[r][c]);
        float kk = (1.f - lb[c]) * (1.f / (1.f + __expf(zf)));
        o[r] = f2bf(kk * __expf(GL[c] - Gc));
      }
      *(u16x4*)(KDTg + (k8 + c) * 64 + t0) = o;
    }
    if (rs == 0) {
#pragma unroll
      for (int c = 0; c < 8; ++c) SC[128 + k8 + c] = __expf(GL[c]);
    }
  }
  __syncthreads();
  for (int J = 0; J < 4; ++J) {
    if (J <= w) {
      int rowbase = (J == 0 ? 0 : J == 1 ? 64 : J == 2 ? 112 : 144) + 16 * (w - J);
      f32x4 a = {0.f, 0.f, 0.f, 0.f};
#pragma unroll
      for (int ks = 0; ks < 4; ++ks) {
        bf16x8 af = *(const bf16x8*)(Qall + (rowbase + fr) * 136 + ks * 32 + fq * 8);
        bf16x8 bk = *(const bf16x8*)(Ks + (16 * J + fr) * 136 + ks * 32 + fq * 8);
        a = MFMA16(af, bk, a);
      }
#pragma unroll
      for (int r = 0; r < 4; ++r) {
        int t = 16 * w + fq * 4 + r, s = 16 * J + fr;
        AMg[t * 64 + s] = f2bf((s <= t) ? a[r] : 0.f);
      }
    } else {
#pragma unroll
      for (int r = 0; r < 4; ++r) AMg[(16 * w + fq * 4 + r) * 64 + 16 * J + fr] = 0;
    }
  }
  __syncthreads();
}

struct LinArgs {
  const bfu* kdt; long kdt_cs;
  const bfu* vt; long vt_cs;
  const float* sc; long sc_cs;
  bfu* ss; long ss_cs;
  int kt0;
};
struct LinFrags { bf16x8 kf[2]; bf16x8 vf[2]; f32x4 dv; };
DI void lin_load(LinFrags& f, const LinArgs& e, int n, int w, int fr, int fq) {
#pragma unroll
  for (int ks = 0; ks < 2; ++ks) f.kf[ks] = *(const bf16x8*)(e.kdt + n * e.kdt_cs + ((e.kt0 + w) * 16 + fr) * 64 + ks * 32 + fq * 8);
#pragma unroll
  for (int ks = 0; ks < 2; ++ks) f.vf[ks] = *(const bf16x8*)(e.vt + n * e.vt_cs + fr * 64 + ks * 32 + fq * 8);
  f.dv = *(const f32x4*)(e.sc + n * e.sc_cs + 128 + (e.kt0 + w) * 16 + fq * 4);
}
template <int NST>
DI void engine_lin(const LinArgs& e) {
  const int tid = TIDX, lane = tid & 63, w = tid >> 6, fr = lane & 15, fq = lane >> 4;
  f32x4 S = f32x4{0.f, 0.f, 0.f, 0.f};
  LinFrags f[NST];
#pragma unroll
  for (int s = 0; s < NST - 1; ++s) lin_load(f[s], e, s, w, fr, fq);
  for (int n0 = 0; n0 < NCHK; n0 += NST) {
#pragma unroll
    for (int s = 0; s < NST; ++s) {
      const int n = n0 + s;
      if (n < NCHK) {
        int nl = n + NST - 1; if (nl > NCHK - 1) nl = NCHK - 1;
        lin_load(f[(s + NST - 1) % NST], e, nl, w, fr, fq);
        const LinFrags& c = f[s];
        u16x4 pk = {f2bf(S[0]), f2bf(S[1]), f2bf(S[2]), f2bf(S[3])};
        *(u16x4*)(e.ss + n * e.ss_cs + fr * 128 + (e.kt0 + w) * 16 + fq * 4) = pk;
#pragma unroll
        for (int r = 0; r < 4; ++r) S[r] *= c.dv[r];
#pragma unroll
        for (int ks = 0; ks < 2; ++ks) S = MFMA16(c.kf[ks], c.vf[ks], S);
      }
    }
  }
}

struct GdnArgs {
  const bfu* w; const bfu* kdt; bfu* ut; long cs;
  const float* sc; long sc_cs;
  bfu* ss; long ss_cs;
};
struct GdnFrags { bf16x8 wf[4]; bf16x8 kf[2][2]; u16x4 v[2]; float dv; };
DI void gdn_load(GdnFrags& f, const GdnArgs& e, int n, int w, int fr, int fq) {
#pragma unroll
  for (int ks = 0; ks < 4; ++ks) f.wf[ks] = *(const bf16x8*)(e.w + n * e.cs + (16 * w + fr) * 128 + ks * 32 + fq * 8);
#pragma unroll
  for (int a = 0; a < 2; ++a)
#pragma unroll
    for (int ks = 0; ks < 2; ++ks) f.kf[a][ks] = *(const bf16x8*)(e.kdt + n * e.cs + ((2 * w + a) * 16 + fr) * 64 + ks * 32 + fq * 8);
#pragma unroll
  for (int jv = 0; jv < 2; ++jv) f.v[jv] = *(const u16x4*)(e.ut + n * e.cs + (jv * 16 + fr) * 64 + 16 * w + fq * 4);
  f.dv = e.sc[n * e.sc_cs + 128];
}
template <int NST>
DI void engine_gdn(const GdnArgs& e) {
  const int tid = TIDX, lane = tid & 63, w = tid >> 6, fr = lane & 15, fq = lane >> 4;
  char* VT = g_smem + 17408;
  f32x4 S[2][2];
#pragma unroll
  for (int a = 0; a < 2; ++a)
#pragma unroll
    for (int jv = 0; jv < 2; ++jv) S[a][jv] = f32x4{0.f, 0.f, 0.f, 0.f};
  GdnFrags f[NST];
#pragma unroll
  for (int s = 0; s < NST - 1; ++s) gdn_load(f[s], e, s, w, fr, fq);
  for (int n0 = 0; n0 < NCHK; n0 += NST) {
#pragma unroll
    for (int s = 0; s < NST; ++s) {
      const int n = n0 + s;
      if (n < NCHK) {
        int nl = n + NST - 1; if (nl > NCHK - 1) nl = NCHK - 1;
        gdn_load(f[(s + NST - 1) % NST], e, nl, w, fr, fq);
        const GdnFrags& c = f[s];
        char* STc = g_smem + (n & 1) * 8704;
#pragma unroll
        for (int a = 0; a < 2; ++a)
#pragma unroll
          for (int jv = 0; jv < 2; ++jv) {
            u16x4 pk = {f2bf(S[a][jv][0]), f2bf(S[a][jv][1]), f2bf(S[a][jv][2]), f2bf(S[a][jv][3])};
            *(u16x4*)(STc + ((jv * 16 + fr) * 136 + (2 * w + a) * 16 + fq * 4) * 2) = pk;
            *(u16x4*)(e.ss + n * e.ss_cs + (jv * 16 + fr) * 128 + (2 * w + a) * 16 + fq * 4) = pk;
          }
        __syncthreads();
        f32x4 av[2] = {f32x4{0.f, 0.f, 0.f, 0.f}, f32x4{0.f, 0.f, 0.f, 0.f}};
#pragma unroll
        for (int ks = 0; ks < 4; ++ks)
#pragma unroll
          for (int jv = 0; jv < 2; ++jv) {
            bf16x8 sf = *(const bf16x8*)(STc + ((jv * 16 + fr) * 136 + ks * 32 + fq * 8) * 2);
            av[jv] = MFMA16(c.wf[ks], sf, av[jv]);
          }
#pragma unroll
        for (int jv = 0; jv < 2; ++jv) {
          u16x4 pk;
#pragma unroll
          for (int r = 0; r < 4; ++r) pk[r] = f2bf(bf2f(c.v[jv][r]) - av[jv][r]);
          *(u16x4*)(VT + ((jv * 16 + fr) * 72 + 16 * w + fq * 4) * 2) = pk;
          *(u16x4*)(e.ut + n * e.cs + (jv * 16 + fr) * 64 + 16 * w + fq * 4) = pk;
        }
        __syncthreads();
#pragma unroll
        for (int a = 0; a < 2; ++a) {
#pragma unroll
          for (int jv = 0; jv < 2; ++jv)
#pragma unroll
            for (int r = 0; r < 4; ++r) S[a][jv][r] *= c.dv;
#pragma unroll
          for (int ks = 0; ks < 2; ++ks)
#pragma unroll
            for (int jv = 0; jv < 2; ++jv) {
              bf16x8 vf = *(const bf16x8*)(VT + ((jv * 16 + fr) * 72 + ks * 32 + fq * 8) * 2);
              S[a][jv] = MFMA16(c.kf[a][ks], vf, S[a][jv]);
            }
        }
      }
    }
  }
  __syncthreads();
}

template <int NVT, bool USE_RS>
DI void oproj_core(f32x4 (&acc)[NVT], const bfu* qd, const bfu* am, const bfu* st, const bfu* vt, const float* rsp, int w, int fr, int fq) {
#pragma unroll
  for (int jv = 0; jv < NVT; ++jv) acc[jv] = f32x4{0.f, 0.f, 0.f, 0.f};
#pragma unroll
  for (int ks = 0; ks < 4; ++ks) {
    bf16x8 qf = *(const bf16x8*)(qd + (16 * w + fr) * 128 + ks * 32 + fq * 8);
#pragma unroll
    for (int jv = 0; jv < NVT; ++jv) {
      bf16x8 sf = *(const bf16x8*)(st + (jv * 16 + fr) * 128 + ks * 32 + fq * 8);
      acc[jv] = MFMA16(qf, sf, acc[jv]);
    }
  }
  if (USE_RS) {
    f32x4 rs = *(const f32x4*)(rsp + 16 * w + fq * 4);
#pragma unroll
    for (int jv = 0; jv < NVT; ++jv)
#pragma unroll
      for (int r = 0; r < 4; ++r) acc[jv][r] *= rs[r];
  }
#pragma unroll
  for (int ks = 0; ks < 2; ++ks) {
    bf16x8 af = *(const bf16x8*)(am + (16 * w + fr) * 64 + ks * 32 + fq * 8);
#pragma unroll
    for (int jv = 0; jv < NVT; ++jv) {
      bf16x8 vf = *(const bf16x8*)(vt + (jv * 16 + fr) * 64 + ks * 32 + fq * 8);
      acc[jv] = MFMA16(af, vf, acc[jv]);
    }
  }
}
DI void oproj_head128(const bfu* qd, const bfu* am, const bfu* st, const bfu* vt, const bfu* zP, int zld, const float* nw, bfu* Yo) {
  const int tid = TIDX, lane = tid & 63, w = tid >> 6, fr = lane & 15, fq = lane >> 4;
  const int row = 16 * w + (lane >> 2), q = lane & 3;
  u16x8 zr[4];
#pragma unroll
  for (int i = 0; i < 4; ++i) zr[i] = *(const u16x8*)(zP + (long)row * zld + q * 32 + i * 8);
  f32x4 acc[8];
  oproj_core<8, false>(acc, qd, am, st, vt, nullptr, w, fr, fq);
  float* T = (float*)g_smem;
#pragma unroll
  for (int jv = 0; jv < 8; ++jv)
#pragma unroll
    for (int r = 0; r < 4; ++r) T[(16 * w + fq * 4 + r) * 132 + jv * 16 + fr] = acc[jv][r];
  float o[32];
  float ss = 0.f;
#pragma unroll
  for (int i = 0; i < 8; ++i) {
    f32x4 v = *(const f32x4*)(T + row * 132 + q * 32 + i * 4);
#pragma unroll
    for (int j = 0; j < 4; ++j) { o[i * 4 + j] = v[j]; ss += v[j] * v[j]; }
  }
  ss += __shfl_xor(ss, 1); ss += __shfl_xor(ss, 2);
  const float rs = rsqrtf(ss * (1.f / 128.f) + 1e-6f);
#pragma unroll
  for (int i = 0; i < 4; ++i) {
    u16x8 res;
    f32x4 w0 = *(const f32x4*)(nw + q * 32 + i * 8), w1 = *(const f32x4*)(nw + q * 32 + i * 8 + 4);
#pragma unroll
    for (int j = 0; j < 8; ++j) {
      float wv = j < 4 ? w0[j & 3] : w1[j & 3];
      res[j] = f2bf(o[i * 8 + j] * rs * wv * siluf(bf2f(zr[i][j])));
    }
    *(u16x8*)(Yo + (long)row * 512 + q * 32 + i * 8) = res;
  }
}
DI void oproj_ssd(const bfu* Xb  , int g, const float* SCb, const bfu* SSb, const bfu* zP, const float* nw, bfu* Yo) {
  const int tid = TIDX, lane = tid & 63, w = tid >> 6, fr = lane & 15, fq = lane >> 4;
  const int row = 16 * w + (lane >> 2), q = lane & 3;
  float* T = (float*)g_smem;
#pragma unroll
  for (int hh = 0; hh < 4; ++hh) {
    int hd = g * 4 + hh;
    f32x4 acc[4];
    oproj_core<4, true>(acc, Xb + g * 16384, Xb + 32768 + hd * 12288, SSb + hd * 8192, Xb + 32768 + hd * 12288 + 4096, SCb + hd * 256, w, fr, fq);
#pragma unroll
    for (int jv = 0; jv < 4; ++jv)
#pragma unroll
      for (int r = 0; r < 4; ++r) T[(16 * w + fq * 4 + r) * 260 + hh * 64 + jv * 16 + fr] = acc[jv][r];
  }
  float ss = 0.f;
  float o[64];
#pragma unroll
  for (int i = 0; i < 8; ++i) {
    u16x8 z = *(const u16x8*)(zP + (long)row * 512 + q * 64 + i * 8);
    f32x4 v0 = *(const f32x4*)(T + row * 260 + q * 64 + i * 8), v1 = *(const f32x4*)(T + row * 260 + q * 64 + i * 8 + 4);
#pragma unroll
    for (int j = 0; j < 8; ++j) {
      float y = (j < 4 ? v0[j & 3] : v1[j & 3]) * siluf(bf2f(z[j]));
      o[i * 8 + j] = y;
      ss += y * y;
    }
  }
  ss += __shfl_xor(ss, 1); ss += __shfl_xor(ss, 2);
  const float rs = rsqrtf(ss * (1.f / 256.f) + 1e-6f);
#pragma unroll
  for (int i = 0; i < 8; ++i) {
    u16x8 res;
    f32x4 w0 = *(const f32x4*)(nw + q * 64 + i * 8), w1 = *(const f32x4*)(nw + q * 64 + i * 8 + 4);
#pragma unroll
    for (int j = 0; j < 8; ++j) res[j] = f2bf(o[i * 8 + j] * rs * (j < 4 ? w0[j & 3] : w1[j & 3]));
    *(u16x8*)(Yo + (long)row * 512 + q * 64 + i * 8) = res;
  }
}

DI float geluf(float x) { float u = 0.7978845608028654f * (x + 0.044715f * x * x * x); return 0.5f * x * (1.f + tanhf(u)); }

DI void phase_s5_gemm1(const Params& p) {
  const bfu* U2 = (const bfu*)(p.ws + OFF_U2);
  const bfu* Ms = (const bfu*)(p.ws + OFF_MS);
  float* Xloc = (float*)(p.ws + OFF_XLOC);
  for (int t = BIDX; t < 32 * 17; t += gridDim.x) {
    int g = t / 17, tm = t - g * 17;
    f32x4 acc[4][4];
    zero_acc<4>(acc);
    gemm_tile<4>(acc, U2 + ((long)g * 2176 + tm * 128) * 256, 256, Ms + (long)g * 128 * 256, 256, 256);
    ACC_FOREACH(4, { Xloc[((long)g * 2176 + tm * 128 + trow) * 128 + tcol] = acc[m][n][j]; })
  }
}
DI void phase_s5_scan(const Params& p, int layer) {
  float* Xloc = (float*)(p.ws + OFF_XLOC);
  bfu* Xst = (bfu*)(p.ws + OFF_XST);
  const int tid = TIDX;
  const int seg = tid >> 4, p16 = tid & 15;
  float* ex = (float*)g_smem;
  for (int it = BIDX; it < 256; it += gridDim.x) {
    const int g = it >> 3, b = (it >> 2) & 1, pq = it & 3;
    const int pr = pq * 16 + p16;
    const int idx = (layer * 32 + g) * 64 + pr;
    const float dt = expf(p.in[24][layer * 32 + g]);
    const float e1 = p.in[17][idx] * dt * 16.f, a1 = p.in[18][idx] * dt * 16.f;
    const float m16 = expf(e1);
    const float l16x = m16 * cosf(a1), l16y = m16 * sinf(a1);
    const int n0 = seg * 65, n1 = (n0 + 65 < 1028) ? n0 + 65 : 1028;
    const float* xl = Xloc + ((long)g * 2176 + b * 1028) * 128;
    bfu* xs = Xst + ((long)g * 2176 + b * 1028) * 128;
    float sre = 0.f, sim = 0.f;
#pragma unroll 13
    for (int n = n0; n < n1; ++n) {
      float lre = xl[(long)n * 128 + pr], lim = xl[(long)n * 128 + 64 + pr];
      float nre = l16x * sre - l16y * sim + lre;
      float nim = l16x * sim + l16y * sre + lim;
      sre = nre; sim = nim;
    }
    __syncthreads();
    ex[(seg * 16 + p16) * 2] = sre; ex[(seg * 16 + p16) * 2 + 1] = sim;
    __syncthreads();
    float cre = 0.f, cim = 0.f;
    {
      const float mL = expf(e1 * 65.f), aL = a1 * 65.f;
      const float lLx = mL * cosf(aL), lLy = mL * sinf(aL);
      for (int s2 = 0; s2 < seg; ++s2) {
        float ere = ex[(s2 * 16 + p16) * 2], eim = ex[(s2 * 16 + p16) * 2 + 1];
        float nre = lLx * cre - lLy * cim + ere;
        float nim = lLx * cim + lLy * cre + eim;
        cre = nre; cim = nim;
      }
    }
    sre = cre; sim = cim;
#pragma unroll 13
    for (int n = n0; n < n1; ++n) {
      float lre = xl[(long)n * 128 + pr], lim = xl[(long)n * 128 + 64 + pr];
      xs[(long)n * 128 + pr] = f2bf(sre);
      xs[(long)n * 128 + 64 + pr] = f2bf(sim);
      float nre = l16x * sre - l16y * sim + lre;
      float nim = l16x * sim + l16y * sre + lim;
      sre = nre; sim = nim;
    }
  }
}
DI void phase_s5_gemm2(const Params& p) {
  const bfu* U2 = (const bfu*)(p.ws + OFF_U2);
  const bfu* Xst = (const bfu*)(p.ws + OFF_XST);
  const bfu* Mc = (const bfu*)(p.ws + OFF_MC);
  bfu* Ys5 = (bfu*)(p.ws + OFF_YS5);
  for (int t = BIDX; t < 32 * 17 * 2; t += gridDim.x) {
    int g = t / 34, rem = t - g * 34, tm = rem >> 1, tn = rem & 1;
    f32x4 acc[4][4];
    zero_acc<4>(acc);
    const bfu* Bt = Mc + ((long)g * 256 + tn * 128) * 384;
    gemm_tile<4>(acc, U2 + ((long)g * 2176 + tm * 128) * 256, 256, Bt, 384, 256);
    gemm_tile<4>(acc, Xst + ((long)g * 2176 + tm * 128) * 128, 128, Bt + 256, 384, 128);
    ACC_FOREACH(4, {
      int nc = tm * 128 + trow, o = tn * 128 + tcol;
      if (nc < 2056) Ys5[((long)nc * 16 + (o >> 4)) * 512 + g * 16 + (o & 15)] = f2bf(geluf(acc[m][n][j]));
    })
  }
}
DI void phase_glu(const Params& p) {
  const bfu* Ys5 = (const bfu*)(p.ws + OFF_YS5);
  const bfu* Wg = (const bfu*)(p.ws + OFF_WGLU);
  const bfu* Pz = (const bfu*)(p.ws + OFF_PZ);
  bfu* Yd = (bfu*)(p.ws + OFF_Y) + (long)3 * TR * 512;
  for (int v = BIDX; v < 320 * 8; v += gridDim.x) {
    int tm, tn;
    if (!tile_map(v, 8, tm, tn)) continue;
    f32x4 acc[4][4];
    zero_acc<4>(acc);
    gemm_tile<4>(acc, Ys5 + (long)tm * 128 * 512, 512, Wg + (long)tn * 128 * 512, 512, 512);
    const int lane = TIDX & 63, wid = TIDX >> 6, wr = wid >> 1, wc = wid & 1, fr = lane & 15, fq = lane >> 4;
#pragma unroll
    for (int m = 0; m < 4; ++m)
#pragma unroll
      for (int n = 0; n < 2; ++n)
#pragma unroll
        for (int j = 0; j < 4; ++j) {
          int row = tm * 128 + wr * 64 + m * 16 + fq * 4 + j;
          int oc = tn * 64 + wc * 32 + n * 16 + fr;
          float z = bf2f(Pz[(long)row * 512 + oc]);
          Yd[(long)row * 512 + oc] = f2bf(acc[m][n][j] * sigm(acc[m][n + 2][j]) * siluf(z));
        }
  }
}
DI void phase_gates(const Params& p) {
  const bfu* h16 = (const bfu*)(p.ws + OFF_H16);
  const bfu* WT = (const bfu*)(p.ws + OFF_WIN);
  bfu* G = (bfu*)(p.ws + OFF_P);
  for (int v = BIDX; v < 320 * 32; v += gridDim.x) {
    int tm, tn;
    if (!tile_map(v, 32, tm, tn)) continue;
    f32x4 acc[4][4];
    zero_acc<4>(acc);
    gemm_tile<4>(acc, h16 + (long)tm * 128 * 1024, 1024, WT + (long)(6656 + tn * 128) * 1024, 1024, 1024);
    {
      const int lane = TIDX & 63, wid = TIDX >> 6, wr = wid >> 1, wc = wid & 1, fr = lane & 15, fq = lane >> 4;
#pragma unroll
      for (int m = 0; m < 4; ++m)
#pragma unroll
        for (int n = 0; n < 4; ++n) {
          const int row4 = (tm * 128 + wr * 64 + m * 16 + fq * 4) >> 2, col = tn * 128 + wc * 64 + n * 16 + fr;
          u16x4 pk = {f2bf(sigm(acc[m][n][0])), f2bf(sigm(acc[m][n][1])), f2bf(sigm(acc[m][n][2])), f2bf(sigm(acc[m][n][3]))};
          *(u16x4*)(G + ((long)row4 * 4096 + col) * 4) = pk;
        }
    }
  }
}
DI void phase_merge(const Params& p) {
  const bfu* WbT = (const bfu*)(p.ws + OFF_WB);
  const bfu* Y = (const bfu*)(p.ws + OFF_Y);
  const bfu* G = (const bfu*)(p.ws + OFF_P);
  bfu* mixed = (bfu*)(p.ws + OFF_H16);
  for (int v = BIDX; v < 320 * 8; v += gridDim.x) {
    int tm, tn;
    if (!tile_map(v, 8, tm, tn)) continue;
    f32x4 tot[4][4];
    zero_acc<4>(tot);
    for (int b = 0; b < 4; ++b) {
      f32x4 acc[4][4];
      zero_acc<4>(acc);
      gemm_tile<4>(acc, Y + ((long)b * TR + tm * 128) * 512, 512, WbT + (long)(b * 1024 + tn * 128) * 512, 512, 512);
      {
        const int lane = TIDX & 63, wid = TIDX >> 6, wr = wid >> 1, wc = wid & 1, fr = lane & 15, fq = lane >> 4;
#pragma unroll
        for (int m = 0; m < 4; ++m)
#pragma unroll
          for (int n = 0; n < 4; ++n) {
            const int row4 = (tm * 128 + wr * 64 + m * 16 + fq * 4) >> 2, col = b * 1024 + tn * 128 + wc * 64 + n * 16 + fr;
            u16x4 gk = *(const u16x4*)(G + ((long)row4 * 4096 + col) * 4);
#pragma unroll
            for (int j = 0; j < 4; ++j) tot[m][n][j] += bf2f(gk[j]) * acc[m][n][j];
          }
      }
    }
    ACC_FOREACH(4, { mixed[(long)(tm * 128 + trow) * 1024 + tn * 128 + tcol] = f2bf(tot[m][n][j]); })
  }
}
DI void phase_out(const Params& p) {
  const bfu* mixed = (const bfu*)(p.ws + OFF_H16);
  const bfu* WoT = (const bfu*)(p.ws + OFF_WO);
  float* h32 = (float*)(p.ws + OFF_H32);
  const float ALPHA = 1.6817928305074290f;
  for (int v = BIDX; v < 320 * 8; v += gridDim.x) {
    int tm, tn;
    if (!tile_map(v, 8, tm, tn)) continue;
    f32x4 acc[4][4];
    zero_acc<4>(acc);
    gemm_tile<4>(acc, mixed + (long)tm * 128 * 1024, 1024, WoT + (long)tn * 128 * 1024, 1024, 1024);
    ACC_FOREACH(4, {
      long a = (long)(tm * 128 + trow) * 1024 + tn * 128 + tcol;
      h32[a] = ALPHA * h32[a] + acc[m][n][j];
    })
  }
}

DI void run_phase(const Params& p, int ph) {
  if (ph == 0) { phase_tables(p); return; }
  if (ph == NPHASE - 1) { ln_rows(p, 3, true); return; }
  const int layer = (ph - 1) / NPL, sub = (ph - 1) % NPL;
  bfu* Xb = (bfu*)(p.ws + OFF_X);
  float* SC = (float*)(p.ws + OFF_SC);
  bfu* Y = (bfu*)(p.ws + OFF_Y);
  const bfu* Zb = (const bfu*)(p.ws + OFF_Z);
  const int bid = BIDX;
  switch (sub) {
    case 0: ln_rows(p, layer - 1, false); phase_convert(p, layer); break;
    case 1: phase_proj(p, 0, 2048, 0, true, 0); break;
    case 2: for (int it = bid; it < 2056; it += gridDim.x) gdn_prep_item(p, layer, it); break;
    case 3:
      if (bid < 32) {
        int b = bid >> 4, h = (bid >> 2) & 3, sl = bid & 3;
        GdnArgs e;
        bfu* base = Xb + ((long)(b * NCHK) * 4 + h) * 36864;
        e.w = base + 8192; e.kdt = base + 16384; e.ut = base + 24576 + sl * 32 * 64; e.cs = 4 * 36864;
        e.sc = SC + ((long)(b * NCHK) * 4 + h) * 256; e.sc_cs = 4 * 256;
        e.ss = Y + (long)TR * 512 + ((long)(b * NCHK) * 4 + h) * 16384 + sl * 32 * 128; e.ss_cs = 4 * 16384;
        engine_gdn<4>(e);
      } else phase_proj(p, 2048, 1536, 0, false, 32, gridDim.x == 512 ? 32 : 0);
      break;
    case 4:
      for (int it = bid; it < 2056; it += gridDim.x) {
        int h = it & 3; long r0 = (long)(it >> 2) * 64;
        const bfu* base = Xb + (long)it * 36864;
        oproj_head128(base, base + 32768, Y + (long)TR * 512 + (long)it * 16384, base + 24576,
                      Zb + r0 * 512 + h * 128, 512, p.in[8] + layer * 128, Y + r0 * 512 + h * 128);
      }
      break;
    case 5: for (int it = bid; it < 1028; it += gridDim.x) ssd_prep_item(p, layer, it); break;
    case 6:
      if (bid < 128) {
        int b = bid >> 6, hd = (bid >> 3) & 7, sl = (bid >> 1) & 3, kh = bid & 1, g = hd >> 2;
        LinArgs e;
        const bfu* base = Xb + (long)(b * NCHK) * 131072;
        e.kdt = base + g * 16384 + 8192; e.kdt_cs = 131072;
        e.vt = base + 32768 + hd * 12288 + 8192 + sl * 16 * 64; e.vt_cs = 131072;
        e.sc = SC + ((long)(b * NCHK) * 8 + hd) * 256; e.sc_cs = 8 * 256;
        e.ss = Y + (long)2 * TR * 512 + ((long)(b * NCHK) * 8 + hd) * 8192 + sl * 16 * 128; e.ss_cs = 8 * 8192;
        e.kt0 = kh * 4;
        engine_lin<9>(e);
      } else phase_proj(p, 3584, 2048, 0, false, 128);
      break;
    case 7:
      for (int it = bid; it < 1028; it += gridDim.x) {
        int g = it & 1; long cn = it >> 1; long r0 = cn * 64;
        oproj_ssd(Xb + cn * 131072, g, SC + cn * 8 * 256, Y + (long)2 * TR * 512 + cn * 8 * 8192,
                  Zb + r0 * 512 + g * 256, p.in[14] + layer * 512 + g * 256, Y + (long)TR * 512 + r0 * 512 + g * 256);
      }
      break;
    case 8: for (int it = bid; it < 2056; it += gridDim.x) hg_prep_item(p, layer, it); break;
    case 9:
      if (bid < 128) {
        int b = bid >> 6, h = (bid >> 4) & 3, sl = (bid >> 1) & 7, kh = bid & 1;
        LinArgs e;
        const bfu* base = Xb + ((long)(b * NCHK) * 4 + h) * 28672;
        e.kdt = base + 8192; e.kdt_cs = 4 * 28672;
        e.vt = base + 20480 + sl * 16 * 64; e.vt_cs = 4 * 28672;
        e.sc = SC + ((long)(b * NCHK) * 4 + h) * 256; e.sc_cs = 4 * 256;
        bfu* ssb = b == 0 ? (Y + (long)3 * TR * 512) : (Xb + (long)2056 * 28672);
        e.ss = ssb + (long)h * 16384 + sl * 16 * 128; e.ss_cs = 4 * 16384;
        e.kt0 = kh * 4;
        engine_lin<9>(e);
      } else phase_proj(p, 5632, 1024, 1, false, 128);
      break;
    case 10:
      for (int it = bid; it < 2056; it += gridDim.x) {
        int h = it & 3; int cn = it >> 2; long r0 = (long)cn * 64;
        int b = cn / NCHK, n = cn - b * NCHK;
        const bfu* base = Xb + (long)it * 28672;
        const bfu* ssb = b == 0 ? (Y + (long)3 * TR * 512) : (Xb + (long)2056 * 28672);
        oproj_head128(base, base + 16384, ssb + ((long)n * 4 + h) * 16384, base + 20480,
                      Zb + r0 * 512 + h * 128, 512, p.in[16] + layer * 128, Y + (long)2 * TR * 512 + r0 * 512 + h * 128);
      }
      break;
    case 11: phase_s5_gemm1(p); break;
    case 12: phase_s5_scan(p, layer); break;
    case 13: phase_s5_gemm2(p); break;
    case 14: phase_glu(p); break;
    case 15: phase_gates(p); break;
    case 16: phase_merge(p); break;
    case 17: phase_out(p); break;
  }
}


#define XB_TMO      128
#define XB_XCNT(j)  (256  + 64 * (j))
#define XB_XSUB(j)  (1280 + 64 * (j))
#define XB_XGEN(j)  (2304 + 64 * (j))
#define XB_TOP      3328
#define XB_TOPGEN   3392
#define XCD_BAR_WORDS 3456
#define XB_SPIN_CAP (1u << 20)
#define LAS __attribute__((address_space(3)))
DI unsigned xb_ld(unsigned* p) { return __hip_atomic_load(p, __ATOMIC_RELAXED, __HIP_MEMORY_SCOPE_AGENT); }
DI unsigned xb_add(unsigned* p, unsigned v) { return __hip_atomic_fetch_add(p, v, __ATOMIC_RELAXED, __HIP_MEMORY_SCOPE_AGENT); }
DI unsigned xb_xcc_id() { return (unsigned)__builtin_amdgcn_s_getreg((3 << 11) | 20) & 0xFu; }
#define XB_SPIN(cond, bar) do { unsigned _sp = 0; while (cond) { __builtin_amdgcn_s_sleep(1); \
    if ((++_sp & 255u) == 0u) { if (xb_ld(&(bar)[XB_TMO])) break; if (_sp > XB_SPIN_CAP) { atomicAdd(&(bar)[XB_TMO], 1u); break; } } } } while (0)
struct XcdBarrier { unsigned* bar; unsigned x; volatile LAS unsigned* st; };
DI XcdBarrier xcd_barrier_post(unsigned* bar, volatile LAS unsigned* st) {
  XcdBarrier b; b.bar = bar; b.x = xb_xcc_id(); b.st = st;
  if (threadIdx.x == 0) (void)xb_add(&bar[XB_XCNT(b.x)], 1u);
  return b;
}
DI void xcd_barrier_complete(unsigned* bar, unsigned x, unsigned& nloc, unsigned& nx) {
  const unsigned G = gridDim.x * gridDim.y * gridDim.z;
  unsigned sum, cnt, mine, sp = 0u;
  for (;;) {
    sum = 0u; cnt = 0u; mine = 0u;
#pragma unroll
    for (unsigned j = 0; j < 16; ++j) { const unsigned c = xb_ld(&bar[XB_XCNT(j)]); sum += c; cnt += (c > 0u) ? 1u : 0u; mine = (j == x) ? c : mine; }
    if (sum == G) break;
    __builtin_amdgcn_s_sleep(1);
    if ((++sp & 255u) == 0u) { if (xb_ld(&bar[XB_TMO])) break; if (sp > XB_SPIN_CAP) { atomicAdd(&bar[XB_TMO], 1u); break; } }
  }
  nloc = mine > 0u ? mine : 1u; nx = cnt > 0u ? cnt : 1u;
}
DI void xcd_barrier(const XcdBarrier& b) {
  asm volatile("s_waitcnt vmcnt(0)" ::: "memory");
  __syncthreads();
  if (threadIdx.x == 0) {
    unsigned* bar = b.bar;
    __builtin_amdgcn_s_waitcnt(0);
    unsigned nloc = b.st[0], nx = b.st[1];
    if (nloc == 0u) { xcd_barrier_complete(bar, b.x, nloc, nx); b.st[0] = nloc; b.st[1] = nx; }
    const unsigned old = xb_add(&bar[XB_XSUB(b.x)], 1u);
    const unsigned gen = old / nloc;
    if (old + 1u == (gen + 1u) * nloc) {
      __builtin_amdgcn_fence(__ATOMIC_RELEASE, "agent");
      asm volatile("s_waitcnt vmcnt(0)" ::: "memory");
      const unsigned og = xb_add(&bar[XB_TOP], 1u);
      const unsigned tg = og / nx;
      if (og + 1u == (tg + 1u) * nx) xb_add(&bar[XB_TOPGEN], 1u);
      else XB_SPIN(xb_ld(&bar[XB_TOPGEN]) == tg, bar);
      __builtin_amdgcn_fence(__ATOMIC_ACQUIRE, "agent");
      xb_add(&bar[XB_XGEN(b.x)], 1u);
      asm volatile("s_waitcnt vmcnt(0)" ::: "memory");
    } else {
      XB_SPIN(xb_ld(&bar[XB_XGEN(b.x)]) == gen, bar);
      __builtin_amdgcn_fence(__ATOMIC_ACQUIRE, "agent");
      asm volatile("s_waitcnt vmcnt(0)" ::: "memory");
    }
  }
  __syncthreads();
}
#ifndef DBL_MASK
#define DBL_MASK 0
#endif
#ifndef TIMING_PROBE
#define TIMING_PROBE 0
#endif
#ifndef TP_MASK_A
#define TP_MASK_A 0
#endif
#ifndef TP_MASK_B
#define TP_MASK_B 0
#endif
__global__ void __launch_bounds__(256, 2) mega_kernel(Params p, int ph_lo, int ph_hi) {
  if (ph_hi - ph_lo == 1) { run_phase(p, ph_lo); return; }
  cg::grid_group grid = cg::this_grid();
  volatile LAS unsigned* xst = (volatile LAS unsigned*)(g_smem + LDS_BYTES - 16);
  if (threadIdx.x == 0) { xst[0] = 0u; xst[1] = 0u; xst[2] = 0u; xst[3] = 0u; }
  __syncthreads();
  XcdBarrier xb = xcd_barrier_post((unsigned*)(p.ws + OFF_BAR), xst);
  for (int ph = ph_lo; ph < ph_hi; ++ph) {
    run_phase(p, ph);
#if DBL_MASK
    if (ph > 0 && ph < NPHASE - 1 && ((DBL_MASK >> ((ph - 1) % NPL)) & 1)) { xcd_barrier(xb); run_phase(p, ph); }
#endif
    if (ph + 1 < ph_hi) {
      if (ph == ph_lo) grid.sync();
      else xcd_barrier(xb);
    }
  }
}

extern "C" void kernel_launch(void* const* d_in, const int* in_sizes, int n_in, void* d_out, int out_size, void* d_ws, size_t ws_size,
                              hipStream_t stream) {
  static int grid_blocks = 0;
  if (!grid_blocks) {
    int dev = 0, cus = 0, per_cu = 0;
    hipGetDevice(&dev);
    hipDeviceGetAttribute(&cus, hipDeviceAttributeMultiprocessorCount, dev);
    hipFuncSetAttribute((const void*)mega_kernel, hipFuncAttributeMaxDynamicSharedMemorySize, LDS_BYTES);
    hipOccupancyMaxActiveBlocksPerMultiprocessor(&per_cu, mega_kernel, 256, LDS_BYTES);
    if (per_cu > 2) per_cu = 2;
    if (per_cu < 1) per_cu = 1;
    grid_blocks = cus * per_cu;
  }
  if (ws_size < WS_NEEDED) { fprintf(stderr, "workspace too small: %zu < %zu\n", ws_size, WS_NEEDED); return; }
  Params p{};
  for (int i = 0; i < 31; ++i) p.in[i] = (const float*)d_in[i];
  p.out = (float*)d_out;
  p.ws = (char*)d_ws;
#if MULTI_LAUNCH
  for (int ph = 0; ph < NPHASE; ++ph) {
    hipLaunchKernelGGL(mega_kernel, dim3(grid_blocks), dim3(256), LDS_BYTES, stream, p, ph, ph + 1);
  }
#else
  int lo = 0, hi = NPHASE;
  hipMemsetAsync((char*)d_ws + OFF_BAR, 0, 16384, stream);
  void* args[] = {&p, &lo, &hi};
  hipError_t e = hipLaunchCooperativeKernel((void*)mega_kernel, dim3(grid_blocks), dim3(256), args, LDS_BYTES, stream);
  if (e != hipSuccess) fprintf(stderr, "cooperative launch failed: %s (grid %d)\n", hipGetErrorString(e), grid_blocks);
#endif
}
```

```cpp
#include <hip/hip_runtime.h>
#include <hip/hip_cooperative_groups.h>
#include <cstdio>
namespace cg = cooperative_groups;

typedef unsigned short bfu;
using bf16x8 = __attribute__((ext_vector_type(8))) short;
using f32x4 = __attribute__((ext_vector_type(4))) float;
using u16x4 = __attribute__((ext_vector_type(4))) unsigned short;
using u16x8 = __attribute__((ext_vector_type(8))) unsigned short;
#define DI __device__ __forceinline__
#define MFMA16(a, b, c) __builtin_amdgcn_mfma_f32_16x16x32_bf16((a), (b), (c), 0, 0, 0)

#ifndef PH_MASK
#define PH_MASK 0xFFFFFF
#endif
#ifndef MULTI_LAUNCH
#define MULTI_LAUNCH 0
#endif

constexpr int TR = 32896;
constexpr int NCHK = 257;
constexpr int LBATCH = 16448;
constexpr int LDS_BYTES = 73728;
constexpr int NPL = 18;
constexpr int NPHASE = 1 + 4 * NPL + 1;

constexpr size_t OFF_H32 = 0;
constexpr size_t OFF_H16 = 134742016;
constexpr size_t OFF_Y = 202113024;
constexpr size_t OFF_P = 336855040;
constexpr size_t OFF_X = 471597056;
constexpr size_t OFF_SC = 623181824;
constexpr size_t OFF_PS = 627392512;
constexpr size_t OFF_W = 629497856;
constexpr size_t OFF_WIN = OFF_W;
constexpr size_t OFF_WS = OFF_WIN + 22020096;
constexpr size_t OFF_WGLU = OFF_WS + 32768;
constexpr size_t OFF_WB = OFF_WGLU + 1048576;
constexpr size_t OFF_WO = OFF_WB + 4194304;
constexpr size_t OFF_MS = OFF_WO + 2097152;
constexpr size_t OFF_MC = OFF_MS + 2097152;
constexpr size_t OFF_LB = OFF_MC + 6291456;
constexpr size_t OFF_LP = OFF_LB + 2048;
constexpr size_t OFF_BB = OFF_LP + 1114112;
constexpr size_t OFF_BAR = OFF_BB + 1048576;
constexpr size_t OFF_Z = OFF_BAR + 16384;
constexpr size_t WS_NEEDED = OFF_Z + 33685504;
constexpr size_t OFF_PZ = OFF_P;
constexpr size_t OFF_U2 = OFF_P + 33685504;
constexpr size_t OFF_YS5 = OFF_U2 + 35651584;
constexpr size_t OFF_XLOC = OFF_X;
constexpr size_t OFF_XST = OFF_X + 35651584;

struct Params {
  const float* in[31];
  float* out;
  char* ws;
};

extern __shared__ __attribute__((aligned(16))) char g_smem[];
DI int tid_laundered() { int t = threadIdx.x; asm volatile("" : "+v"(t)); return t; }
DI int bid_laundered() { int b = blockIdx.x; asm volatile("" : "+s"(b)); return b; }
#define TIDX tid_laundered()
#define BIDX bid_laundered()


DI bfu f2bf(float x) { unsigned u = __float_as_uint(x); u += 0x7fffu + ((u >> 16) & 1u); return (bfu)(u >> 16); }
DI float bf2f(bfu b) { return __uint_as_float(((unsigned)b) << 16); }
DI float sigm(float x) { return 1.f / (1.f + __expf(-x)); }
DI float siluf(float x) { return x / (1.f + __expf(-x)); }
DI float softplusf(float x) { return x > 20.f ? x : log1pf(expf(x)); }
DI float wave_sum(float v) {
#pragma unroll
  for (int m = 32; m >= 1; m >>= 1) v += __shfl_xor(v, m);
  return v;
}
DI float wave_scan_incl(float s, int lane) {
#pragma unroll
  for (int d = 1; d < 64; d <<= 1) { float o = __shfl_up(s, d); if (lane >= d) s += o; }
  return s;
}

template <int NREP>
DI void gemm_stage(const bfu* __restrict__ A, int lda, const bfu* __restrict__ Bt, int ldb, int kt, char* buf, int tid) {
#pragma unroll
  for (int i = 0; i < 2; ++i) {
    int b = tid * 16 + i * 4096; int r = b >> 6, c = (b & 63) >> 1;
    __builtin_amdgcn_global_load_lds((const unsigned*)(A + (long)r * lda + kt + c), (unsigned*)(buf + b), 16, 0, 0);
  }
#pragma unroll
  for (int i = 0; i < NREP / 2; ++i) {
    int b = tid * 16 + i * 4096; int r = b >> 6, c = (b & 63) >> 1;
    __builtin_amdgcn_global_load_lds((const unsigned*)(Bt + (long)r * ldb + kt + c), (unsigned*)(buf + 8192 + b), 16, 0, 0);
  }
}
template <int NREP>
DI void gemm_tile(f32x4 (&acc)[4][NREP], const bfu* __restrict__ A, int lda, const bfu* __restrict__ Bt, int ldb, int K) {
  const int tid = TIDX, lane = tid & 63, wid = tid >> 6, wr = wid >> 1, wc = wid & 1, fr = lane & 15, fq = lane >> 4;
  constexpr int GL = 2 + NREP / 2;
  const int nk = K >> 5;
  __syncthreads();
#pragma unroll
  for (int s = 0; s < 3; ++s)
    if (s < nk) gemm_stage<NREP>(A, lda, Bt, ldb, s * 32, g_smem + s * 16384, tid);
  for (int i = 0; i < nk; ++i) {
    const int younger = nk - 1 - i;
    if (younger >= 2) asm volatile("s_waitcnt vmcnt(%0)" ::"n"(2 * GL) : "memory");
    else if (younger == 1) asm volatile("s_waitcnt vmcnt(%0)" ::"n"(GL) : "memory");
    else asm volatile("s_waitcnt vmcnt(0)" ::: "memory");
    __builtin_amdgcn_s_barrier();
    if (i + 3 < nk) gemm_stage<NREP>(A, lda, Bt, ldb, (i + 3) * 32, g_smem + ((i + 3) & 3) * 16384, tid);
    const char* SA = g_smem + (i & 3) * 16384;
    const char* SB = SA + 8192;
    bf16x8 af[4], bfr[NREP];
#pragma unroll
    for (int m = 0; m < 4; ++m) af[m] = *(const bf16x8*)(SA + (wr * 64 + m * 16 + fr) * 64 + fq * 16);
#pragma unroll
    for (int n = 0; n < NREP; ++n) bfr[n] = *(const bf16x8*)(SB + (wc * (NREP * 16) + n * 16 + fr) * 64 + fq * 16);
#pragma unroll
    for (int m = 0; m < 4; ++m)
#pragma unroll
      for (int n = 0; n < NREP; ++n) acc[m][n] = MFMA16(af[m], bfr[n], acc[m][n]);
  }
}
template <int NREP>
DI void zero_acc(f32x4 (&acc)[4][NREP]) {
#pragma unroll
  for (int m = 0; m < 4; ++m)
#pragma unroll
    for (int n = 0; n < NREP; ++n) acc[m][n] = f32x4{0.f, 0.f, 0.f, 0.f};
}
#define ACC_FOREACH(NREP_, ...)                                                                \
  {                                                                                              \
    const int lane_ = TIDX & 63, wid_ = TIDX >> 6, wr_ = wid_ >> 1, wc_ = wid_ & 1; \
    const int fr_ = lane_ & 15, fq_ = lane_ >> 4;                                                \
    _Pragma("unroll") for (int m = 0; m < 4; ++m) _Pragma("unroll") for (int n = 0; n < NREP_; ++n) \
        _Pragma("unroll") for (int j = 0; j < 4; ++j) {                                          \
      const int trow = wr_ * 64 + m * 16 + fq_ * 4 + j;                                          \
      const int tcol = wc_ * (NREP_ * 16) + n * 16 + fr_;                                        \
      __VA_ARGS__                                                                                \
    }                                                                                            \
  }

DI void phase_tables(const Params& p) {
  const int gtid = BIDX * 256 + TIDX, gth = gridDim.x * 256;
  float2* LP = (float2*)(p.ws + OFF_LP);
  float2* BB = (float2*)(p.ws + OFF_BB);
  for (int idx = gtid; idx < 4 * 32 * 64; idx += gth) {
    int l = idx >> 11, g = (idx >> 6) & 31;
    float dt = expf(p.in[24][l * 32 + g]);
    float are = p.in[17][idx], aim = p.in[18][idx];
    float e1 = are * dt, a1 = aim * dt;
    for (int d = 0; d <= 16; ++d) {
      float mag = expf((float)d * e1), ang = (float)d * a1;
      LP[(long)idx * 17 + d] = make_float2(mag * cosf(ang), mag * sinf(ang));
    }
    float mag = expf(e1);
    float lre = mag * cosf(a1), lim = mag * sinf(a1);
    float den = are * are + aim * aim;
    float nr = lre - 1.f, ni = lim;
    float zre = (nr * are + ni * aim) / den, zim = (ni * are - nr * aim) / den;
    for (int c = 0; c < 16; ++c) {
      float bre = p.in[19][(long)idx * 16 + c], bim = p.in[20][(long)idx * 16 + c];
      BB[(long)idx * 16 + c] = make_float2(zre * bre - zim * bim, zre * bim + zim * bre);
    }
  }
}

DI void ln_rows(const Params& p, int layer, bool final_) {
  float* h32 = (float*)(p.ws + OFF_H32);
  bfu* h16 = (bfu*)(p.ws + OFF_H16);
  const int lane = TIDX & 63;
  const int gw = BIDX * 4 + (TIDX >> 6), nw = gridDim.x * 4;
  const float* gam = layer < 0 ? p.in[2] : p.in[29] + layer * 1024;
  const float* bet = layer < 0 ? p.in[3] : p.in[30] + layer * 1024;
  for (int r = gw; r < TR; r += nw) {
    int b = r / LBATCH, pos = r - b * LBATCH;
    float* d32 = h32 + (long)r * 1024;
    bfu* d16 = h16 + (long)r * 1024;
    if (pos < 48) {
      if (!final_) {
#pragma unroll
        for (int i = 0; i < 4; ++i) {
          *(float4*)(d32 + i * 256 + lane * 4) = make_float4(0.f, 0.f, 0.f, 0.f);
          *(u16x4*)(d16 + i * 256 + lane * 4) = u16x4{0, 0, 0, 0};
        }
      }
      continue;
    }
    const float* src;
    if (layer < 0) src = pos < 64 ? p.in[1] + (pos - 48) * 1024 : p.in[0] + ((long)b * 16384 + (pos - 64)) * 1024;
    else src = d32;
    float4 v[4];
    float s = 0.f;
#pragma unroll
    for (int i = 0; i < 4; ++i) { v[i] = *(const float4*)(src + i * 256 + lane * 4); s += v[i].x + v[i].y + v[i].z + v[i].w; }
    float mu = wave_sum(s) * (1.f / 1024.f);
    float q = 0.f;
#pragma unroll
    for (int i = 0; i < 4; ++i) {
      v[i].x -= mu; v[i].y -= mu; v[i].z -= mu; v[i].w -= mu;
      q += v[i].x * v[i].x + v[i].y * v[i].y + v[i].z * v[i].z + v[i].w * v[i].w;
    }
    float rs = rsqrtf(wave_sum(q) * (1.f / 1024.f) + 1e-5f);
#pragma unroll
    for (int i = 0; i < 4; ++i) {
      float4 g4 = *(const float4*)(gam + i * 256 + lane * 4), b4 = *(const float4*)(bet + i * 256 + lane * 4);
      float4 o = make_float4(v[i].x * rs * g4.x + b4.x, v[i].y * rs * g4.y + b4.y, v[i].z * rs * g4.z + b4.z, v[i].w * rs * g4.w + b4.w);
      if (final_) {
        if (pos >= 64) *(float4*)(p.out + ((long)b * 16384 + (pos - 64)) * 1024 + i * 256 + lane * 4) = o;
      } else {
        *(float4*)(d32 + i * 256 + lane * 4) = o;
        *(u16x4*)(d16 + i * 256 + lane * 4) = u16x4{f2bf(o.x), f2bf(o.y), f2bf(o.z), f2bf(o.w)};
      }
    }
  }
}

template <class F>
DI void conv_T(bfu* dst, int N, int K, F src) {
  const long gtid = BIDX * 256 + TIDX, gth = (long)gridDim.x * 256;
  const long total = (long)N * (K / 8);
  for (long idx = gtid; idx < total; idx += gth) {
    int n = (int)(idx % N); int kg = (int)(idx / N);
    u16x8 o;
#pragma unroll
    for (int j = 0; j < 8; ++j) o[j] = f2bf(src(kg * 8 + j, n));
    *(u16x8*)(dst + (long)n * K + kg * 8) = o;
  }
}

DI void phase_convert(const Params& p, int l) {
  const float* win = p.in[4] + (long)l * 1024 * 10768;
  conv_T((bfu*)(p.ws + OFF_WIN), 10752, 1024, [&](int k, int n) {
    int sc = n < 2048 ? n : n < 3584 ? n + 8 : n < 5632 ? n + 16 : n < 6656 ? n + 16 : n + 16;
    return win[(long)k * 10768 + sc];
  });
  conv_T((bfu*)(p.ws + OFF_WS), 16, 1024, [&](int k, int n) { int sc = n < 8 ? 2048 + n : 3592 + (n - 8); return win[(long)k * 10768 + sc]; });
  const float* w1 = p.in[25] + (long)l * 512 * 512;
  const float* w2 = p.in[26] + (long)l * 512 * 512;
  conv_T((bfu*)(p.ws + OFF_WGLU), 1024, 512, [&](int k, int r) {
    int j = r >> 7, wc = (r >> 6) & 1, n = (r >> 4) & 3, fr = r & 15;
    int oc = j * 64 + wc * 32 + (n & 1) * 16 + fr;
    return (n >> 1) ? w2[k * 512 + oc] : w1[k * 512 + oc];
  });
  const float* wb = p.in[27] + (long)l * 4 * 512 * 1024;
  conv_T((bfu*)(p.ws + OFF_WB), 4096, 512, [&](int k, int r) { int b = r >> 10, n = r & 1023; return wb[((long)b * 512 + k) * 1024 + n]; });
  const float* wo = p.in[28] + (long)l * 1024 * 1024;
  conv_T((bfu*)(p.ws + OFF_WO), 1024, 1024, [&](int k, int n) { return wo[(long)k * 1024 + n]; });
  const int gtid = BIDX * 256 + TIDX, gth = gridDim.x * 256;
  float* lbv = (float*)(p.ws + OFF_LB);
  for (int c = gtid; c < 512; c += gth) {
    float v0 = p.in[15][c], v1 = p.in[15][512 + c], v2 = p.in[15][1024 + c], v3 = p.in[15][1536 + c];
    float mx = fmaxf(fmaxf(v0, v1), fmaxf(v2, v3));
    float e0 = expf(v0 - mx), e1 = expf(v1 - mx), e2 = expf(v2 - mx), e3 = expf(v3 - mx);
    float inv = 1.f / (e0 + e1 + e2 + e3);
    float acc = 0.f;
    if (l >= 1) acc += e1 * inv;
    if (l >= 2) acc += e2 * inv;
    if (l >= 3) acc += e3 * inv;
    lbv[c] = acc;
  }
  const float2* LP = (const float2*)(p.ws + OFF_LP) + (long)l * 32 * 64 * 17;
  const float2* BB = (const float2*)(p.ws + OFF_BB) + (long)l * 32 * 64 * 16;
  const float* cre = p.in[21] + (long)l * 32 * 16 * 64;
  const float* cim = p.in[22] + (long)l * 32 * 16 * 64;
  const float* dd = p.in[23] + l * 512;
  bfu* Ms = (bfu*)(p.ws + OFF_MS);
  bfu* Mc = (bfu*)(p.ws + OFF_MC);
  for (int idx = gtid; idx < 32 * 128 * 256; idx += gth) {
    int g = idx >> 15, pp = (idx >> 8) & 127, kk = idx & 255;
    int s = kk >> 4, c2 = kk & 15, pr = pp & 63;
    float2 lp = LP[((long)g * 64 + pr) * 17 + (15 - s)];
    float2 bb = BB[((long)g * 64 + pr) * 16 + c2];
    float v = pp < 64 ? lp.x * bb.x - lp.y * bb.y : lp.x * bb.y + lp.y * bb.x;
    Ms[idx] = f2bf(v);
  }
  for (int idx = gtid; idx < 32 * 256 * 384; idx += gth) {
    int g = idx / (256 * 384); int rem = idx - g * (256 * 384);
    int o = rem / 384, kk = rem - o * 384;
    int t = o >> 4, c = o & 15;
    float v = 0.f;
    const float* cr = cre + ((long)g * 16 + c) * 64;
    const float* ci = cim + ((long)g * 16 + c) * 64;
    if (kk < 256) {
      int s = kk >> 4, c2 = kk & 15;
      if (t >= s) {
        int d = t - s;
        for (int pr = 0; pr < 64; ++pr) {
          float2 lp = LP[((long)g * 64 + pr) * 17 + d];
          float2 bb = BB[((long)g * 64 + pr) * 16 + c2];
          float ere = lp.x * bb.x - lp.y * bb.y, eim = lp.x * bb.y + lp.y * bb.x;
          v += cr[pr] * ere - ci[pr] * eim;
        }
        if (kk == o) v += dd[g * 16 + c];
      }
    } else {
      int pp = kk - 256, pr = pp & 63;
      float2 lp = LP[((long)g * 64 + pr) * 17 + (t + 1)];
      v = pp < 64 ? cr[pr] * lp.x - ci[pr] * lp.y : -(cr[pr] * lp.y + ci[pr] * lp.x);
    }
    Mc[idx] = f2bf(v);
  }
}

DI bool tile_map(int v, int ntn, int& tm, int& tn) {
  const int x = v & 7, j = v >> 3, sidx = j >> 5, within = j & 31, ntng = ntn >> 2;
  const int gq = sidx / ntng, tng = sidx - gq * ntng;
  tm = (gq * 8 + x) * 8 + (within >> 2);
  tn = tng * 4 + (within & 3);
  return tm < 257;
}
DI void phase_proj(const Params& p, int wrow0, int ncols, int mode, bool with_small, int boff, int nskip = 0) {
  const bfu* h16 = (const bfu*)(p.ws + OFF_H16);
  const bfu* WT = (const bfu*)(p.ws + OFF_WIN);
  bfu* P = (bfu*)(p.ws + OFF_P);
  bfu* U2 = (bfu*)(p.ws + OFF_U2);
  const int ntn = ncols >> 7;
  const int G = gridDim.x - boff - nskip;
  const int bsel = BIDX;
  if (nskip && bsel >= 256 && bsel < 256 + nskip) return;
  const int bidx = bsel - boff - ((nskip && bsel >= 256) ? nskip : 0);
  for (int v = bidx; v < 320 * ntn; v += G) {
    int tm, tn;
    if (!tile_map(v, ntn, tm, tn)) continue;
    {
      f32x4 acc[4][4];
      zero_acc<4>(acc);
      gemm_tile<4>(acc, h16 + (long)tm * 128 * 1024, 1024, WT + (long)(wrow0 + tn * 128) * 1024, 1024, 1024);
      if (mode == 0) {
        ACC_FOREACH(4, { P[(long)(tm * 128 + trow) * ncols + tn * 128 + tcol] = f2bf(acc[m][n][j]); })
      } else {
        ACC_FOREACH(4, {
          int row = tm * 128 + trow, col = tn * 128 + tcol;
          if (col < 512) { int g = col >> 4, c2 = col & 15; U2[((long)g * 2176 + (row >> 4)) * 256 + (row & 15) * 16 + c2] = f2bf(acc[m][n][j]); }
          else P[(long)row * 512 + (col - 512)] = f2bf(acc[m][n][j]);
        })
      }
    }
  }
  if (with_small) for (int tm = bidx; tm < 257; tm += G) {
    {
      const int lane = TIDX & 63, w = TIDX >> 6, fr = lane & 15, fq = lane >> 4;
      const bfu* WsT = (const bfu*)(p.ws + OFF_WS);
      float* Ps = (float*)(p.ws + OFF_PS);
      f32x4 a0 = {0.f, 0.f, 0.f, 0.f}, a1 = {0.f, 0.f, 0.f, 0.f};
      const bfu* pa0 = h16 + (long)(tm * 128 + w * 32 + fr) * 1024 + fq * 8;
      const bfu* pa1 = pa0 + 16 * 1024;
      const bfu* pb = WsT + fr * 1024 + fq * 8;
      for (int k = 0; k < 1024; k += 32) {
        bf16x8 x0 = *(const bf16x8*)(pa0 + k), x1 = *(const bf16x8*)(pa1 + k), y = *(const bf16x8*)(pb + k);
        a0 = MFMA16(x0, y, a0);
        a1 = MFMA16(x1, y, a1);
      }
#pragma unroll
      for (int j = 0; j < 4; ++j) {
        Ps[(long)(tm * 128 + w * 32 + fq * 4 + j) * 16 + fr] = a0[j];
        Ps[(long)(tm * 128 + w * 32 + 16 + fq * 4 + j) * 16 + fr] = a1[j];
      }
    }
  }
}

DI void copy_z(const Params& p, const bfu* src, int sld, bfu* dst, int pieces_per_row) {
  const int tid = TIDX;
  const int total = 64 * pieces_per_row;
  for (int i = tid; i < total; i += 256) {
    int r = i / pieces_per_row, c = i - r * pieces_per_row;
    *(u16x8*)(dst + (long)r * 512 + c * 8) = *(const u16x8*)(src + (long)r * sld + c * 8);
  }
}
DI void gdn_prep_item(const Params& p, int layer, int item) {
  const int tid = TIDX, lane = tid & 63, w = tid >> 6, fr = lane & 15, fq = lane >> 4;
  const int h = item & 3, cn = item >> 2, n = cn % NCHK;
  const long r0 = (long)cn * 64;
  const bfu* P = (const bfu*)(p.ws + OFF_P);
  const float* Ps = (const float*)(p.ws + OFF_PS);
  bfu* Xb = (bfu*)(p.ws + OFF_X) + (long)item * 36864;
  float* SC = (float*)(p.ws + OFF_SC) + (long)item * 256;
  bfu* rawQ = (bfu*)g_smem;
  bfu* rawK = rawQ + 64 * 136;
  bfu* rawV = rawK + 64 * 136;
  float* aL = (float*)(g_smem + 52224);
  float* sm = (float*)(g_smem + 69632);
  const float* cw = p.in[5] + layer * 4 * 1536;
  copy_z(p, P + r0 * 2048 + 1536 + h * 128, 2048, (bfu*)(p.ws + OFF_Z) + r0 * 512 + h * 128, 16);
  if (w < 3) {
    const int cgp = tid % 48, seg = tid / 48;
    const int which = cgp >> 4, c8 = (cgp & 15) * 8;
    const int col = which * 512 + h * 128 + c8;
    const int t0 = seg * 16;
    u16x8 xr[19];
    const bool nohist = (seg == 0 && n == 0);
#pragma unroll
    for (int i = 0; i < 19; ++i) {
      const bool valid = !(nohist && i < 3);
      const long rr = valid ? (r0 + t0 - 3 + i) : r0;
      u16x8 v = *(const u16x8*)(P + rr * 2048 + col);
      xr[i] = valid ? v : u16x8{0, 0, 0, 0, 0, 0, 0, 0};
    }
    float wt[4][8];
#pragma unroll
    for (int j = 0; j < 4; ++j) {
      float4 a4 = *(const float4*)(cw + j * 1536 + col), b4 = *(const float4*)(cw + j * 1536 + col + 4);
      wt[j][0] = a4.x; wt[j][1] = a4.y; wt[j][2] = a4.z; wt[j][3] = a4.w; wt[j][4] = b4.x; wt[j][5] = b4.y; wt[j][6] = b4.z; wt[j][7] = b4.w;
    }
    bfu* dst = rawQ + which * (64 * 136) + c8;
#pragma unroll
    for (int r = 0; r < 16; ++r) {
      u16x8 o;
#pragma unroll
      for (int c = 0; c < 8; ++c) {
        float v = wt[0][c] * bf2f(xr[r][c]) + wt[1][c] * bf2f(xr[r + 1][c]) + wt[2][c] * bf2f(xr[r + 2][c]) + wt[3][c] * bf2f(xr[r + 3][c]);
        o[c] = f2bf(siluf(v));
      }
      *(u16x8*)(dst + (t0 + r) * 136) = o;
    }
  }
  if (w == 3) {
    const float* ps = Ps + (r0 + lane) * 16;
    float be = sigm(ps[h]);
    float gl = -__expf(p.in[6][layer * 4 + h]) * softplusf(ps[4 + h] + p.in[7][layer * 4 + h]);
    float s = wave_scan_incl(gl, lane);
    sm[128 + lane] = be;
    sm[192 + lane] = s;
  }
  __syncthreads();
  if (tid < 128) {
    int row = tid & 63, mat = tid >> 6;
    const bfu* rp = rawQ + mat * (64 * 136) + row * 136;
    float ss = 0.f;
    for (int c = 0; c < 128; ++c) { float v = bf2f(rp[c]); ss += v * v; }
    float sc = rsqrtf(ss + 1e-6f);
    if (mat == 0) sc *= 0.08838834764831845f;
    sm[mat * 64 + row] = sc;
  }
  __syncthreads();
  if (tid < 64) { float be = sm[128 + tid]; sm[256 + tid] = be; sm[320 + tid] = be * sm[64 + tid] * __expf(sm[192 + tid]); }
  {
    bf16x8 kf[4], qf[4];
#pragma unroll
    for (int ks = 0; ks < 4; ++ks) {
      kf[ks] = *(const bf16x8*)(rawK + (16 * w + fr) * 136 + ks * 32 + fq * 8);
      qf[ks] = *(const bf16x8*)(rawQ + (16 * w + fr) * 136 + ks * 32 + fq * 8);
    }
    bfu* AMg = Xb + 32768;
    for (int tj = 0; tj < 4; ++tj) {
      if (tj <= w) {
        f32x4 akk = {0.f, 0.f, 0.f, 0.f}, aqk = {0.f, 0.f, 0.f, 0.f};
#pragma unroll
        for (int ks = 0; ks < 4; ++ks) {
          bf16x8 bk = *(const bf16x8*)(rawK + (16 * tj + fr) * 136 + ks * 32 + fq * 8);
          akk = MFMA16(kf[ks], bk, akk);
          aqk = MFMA16(qf[ks], bk, aqk);
        }
        int j = 16 * tj + fr;
        float rkj = sm[64 + j], gcj = sm[192 + j];
#pragma unroll
        for (int r = 0; r < 4; ++r) {
          int i = 16 * w + fq * 4 + r;
          float dec = (i >= j) ? __expf(sm[192 + i] - gcj) : 0.f;
          aL[i * 68 + j] = (i > j) ? sm[128 + i] * sm[64 + i] * rkj * akk[r] * dec : 0.f;
          AMg[i * 64 + j] = f2bf((i >= j) ? sm[i] * rkj * aqk[r] * dec : 0.f);
        }
      } else {
#pragma unroll
        for (int r = 0; r < 4; ++r) AMg[(16 * w + fq * 4 + r) * 64 + 16 * tj + fr] = 0;
      }
    }
  }
  __syncthreads();
  {
    const bfu* src = (tid < 128) ? (rawV + tid) : (rawK + (tid - 128));
    const float* rs = sm + ((tid < 128) ? 256 : 320);
    float x[64];
#pragma unroll
    for (int i = 0; i < 64; ++i) {
      float a = bf2f(src[i * 136]) * rs[i];
#pragma unroll
      for (int j = 0; j < i; ++j) a -= aL[i * 68 + j] * x[j];
      x[i] = a;
    }
    if (tid < 128) {
      bfu* UT = Xb + 24576 + tid * 64;
#pragma unroll
      for (int i = 0; i < 64; i += 8) {
        u16x8 o;
#pragma unroll
        for (int j = 0; j < 8; ++j) o[j] = f2bf(x[i + j]);
        *(u16x8*)(UT + i) = o;
      }
    } else {
      bfu* Wg = Xb + 8192 + (tid - 128);
#pragma unroll
      for (int i = 0; i < 64; ++i) Wg[i * 128] = f2bf(x[i]);
    }
  }
  {
    bfu* QDg = Xb;
    bfu* KDTg = Xb + 16384;
    float gl_last = sm[192 + 63];
    for (int idx = tid; idx < 8192; idx += 256) { int i = idx >> 7, c = idx & 127; QDg[idx] = f2bf(bf2f(rawQ[i * 136 + c]) * sm[i] * __expf(sm[192 + i])); }
    for (int idx = tid; idx < 8192; idx += 256) { int c = idx >> 6, i = idx & 63; KDTg[idx] = f2bf(bf2f(rawK[i * 136 + c]) * sm[64 + i] * __expf(gl_last - sm[192 + i])); }
    if (tid < 128) SC[128 + tid] = __expf(gl_last);
  }
  __syncthreads();
}

DI void ssd_prep_item(const Params& p, int layer, int item) {
  const int tid = TIDX, lane = tid & 63, w = tid >> 6, fr = lane & 15, fq = lane >> 4;
  const int g = item & 1, cn = item >> 1, n = cn % NCHK;
  const long r0 = (long)cn * 64;
  const bfu* P = (const bfu*)(p.ws + OFF_P);
  const float* Ps = (const float*)(p.ws + OFF_PS);
  bfu* Xb = (bfu*)(p.ws + OFF_X) + (long)cn * 131072;
  float* SCb = (float*)(p.ws + OFF_SC) + (long)cn * 8 * 256;
  bfu* Bm = (bfu*)g_smem;
  bfu* Cm = Bm + 64 * 136;
  float* cb = (float*)(g_smem + 34816);
  float* sm = (float*)(g_smem + 34816 + 17408);
  {
    int hd = g * 4 + w;
    float dtv = softplusf(Ps[(r0 + lane) * 16 + 8 + hd] + p.in[11][layer * 8 + hd]);
    float a = -dtv * __expf(p.in[12][layer * 8 + hd]);
    float ac = wave_scan_incl(a, lane);
    sm[w * 64 + lane] = dtv;
    sm[256 + w * 64 + lane] = ac;
  }
  __syncthreads();
  const float* cw = p.in[9] + layer * 4 * 1024;
  const float* cbias = p.in[10] + layer * 1024;
  copy_z(p, P + r0 * 1536 + 1024 + g * 256, 1536, (bfu*)(p.ws + OFF_Z) + r0 * 512 + g * 256, 32);
  {
    const int cg8 = tid & 63, seg = tid >> 6, t0 = seg * 16;
    const int col = (cg8 < 16) ? 512 + g * 128 + cg8 * 8 : (cg8 < 32) ? 768 + g * 128 + (cg8 - 16) * 8 : g * 256 + (cg8 - 32) * 8;
    u16x8 xr[19];
    const bool nohist = (seg == 0 && n == 0);
#pragma unroll
    for (int i = 0; i < 19; ++i) {
      const bool valid = !(nohist && i < 3);
      const long rr = valid ? (r0 + t0 - 3 + i) : r0;
      u16x8 v = *(const u16x8*)(P + rr * 1536 + col);
      xr[i] = valid ? v : u16x8{0, 0, 0, 0, 0, 0, 0, 0};
    }
    float wt[4][8], bias[8];
#pragma unroll
    for (int j = 0; j < 4; ++j) {
      float4 a4 = *(const float4*)(cw + j * 1024 + col), b4 = *(const float4*)(cw + j * 1024 + col + 4);
      wt[j][0] = a4.x; wt[j][1] = a4.y; wt[j][2] = a4.z; wt[j][3] = a4.w; wt[j][4] = b4.x; wt[j][5] = b4.y; wt[j][6] = b4.z; wt[j][7] = b4.w;
    }
    {
      float4 a4 = *(const float4*)(cbias + col), b4 = *(const float4*)(cbias + col + 4);
      bias[0] = a4.x; bias[1] = a4.y; bias[2] = a4.z; bias[3] = a4.w; bias[4] = b4.x; bias[5] = b4.y; bias[6] = b4.z; bias[7] = b4.w;
    }
    if (cg8 < 32) {
      bfu* dst = (cg8 < 16) ? (Bm + cg8 * 8) : (Cm + (cg8 - 16) * 8);
#pragma unroll
      for (int r = 0; r < 16; ++r) {
        u16x8 o;
        const bool padrow = (n == 0 && t0 + r < 48);
#pragma unroll
        for (int c = 0; c < 8; ++c) {
          float v = wt[0][c] * bf2f(xr[r][c]) + wt[1][c] * bf2f(xr[r + 1][c]) + wt[2][c] * bf2f(xr[r + 2][c]) + wt[3][c] * bf2f(xr[r + 3][c]) + bias[c];
          o[c] = padrow ? (bfu)0 : f2bf(siluf(v));
        }
        *(u16x8*)(dst + (t0 + r) * 136) = o;
      }
    } else {
      const int hh = (cg8 - 32) >> 3, pp8 = ((cg8 - 32) & 7) * 8;
      bfu* vtb = Xb + 32768 + (g * 4 + hh) * 12288 + 4096;
      const float alast = sm[256 + hh * 64 + 63];
#pragma unroll
      for (int q4 = 0; q4 < 4; ++q4) {
        float dtv[4], ksv[4];
#pragma unroll
        for (int rr = 0; rr < 4; ++rr) {
          int t = t0 + q4 * 4 + rr;
          const bool padrow = (n == 0 && t < 48);
          dtv[rr] = padrow ? 0.f : sm[hh * 64 + t];
          ksv[rr] = __expf(alast - sm[256 + hh * 64 + t]);
        }
#pragma unroll
        for (int c = 0; c < 8; ++c) {
          u16x4 oa, ob;
#pragma unroll
          for (int rr = 0; rr < 4; ++rr) {
            int r = q4 * 4 + rr;
            float v = wt[0][c] * bf2f(xr[r][c]) + wt[1][c] * bf2f(xr[r + 1][c]) + wt[2][c] * bf2f(xr[r + 2][c]) + wt[3][c] * bf2f(xr[r + 3][c]) + bias[c];
            float xd = siluf(v) * dtv[rr];
            oa[rr] = f2bf(xd);
            ob[rr] = f2bf(xd * ksv[rr]);
          }
          *(u16x4*)(vtb + (pp8 + c) * 64 + t0 + q4 * 4) = oa;
          *(u16x4*)(vtb + 4096 + (pp8 + c) * 64 + t0 + q4 * 4) = ob;
        }
      }
    }
  }
  __syncthreads();
  {
    bf16x8 cf[4];
#pragma unroll
    for (int ks = 0; ks < 4; ++ks) cf[ks] = *(const bf16x8*)(Cm + (16 * w + fr) * 136 + ks * 32 + fq * 8);
    for (int tj = 0; tj < 4; ++tj) {
      if (tj <= w) {
        f32x4 a = {0.f, 0.f, 0.f, 0.f};
#pragma unroll
        for (int ks = 0; ks < 4; ++ks) {
          bf16x8 bk = *(const bf16x8*)(Bm + (16 * tj + fr) * 136 + ks * 32 + fq * 8);
          a = MFMA16(cf[ks], bk, a);
        }
#pragma unroll
        for (int r = 0; r < 4; ++r) cb[(16 * w + fq * 4 + r) * 68 + 16 * tj + fr] = a[r];
      }
    }
    bfu* Cg = Xb + g * 16384;
    bfu* BTg = Cg + 8192;
    for (int idx = tid; idx < 8192; idx += 256) Cg[idx] = Cm[(idx >> 7) * 136 + (idx & 127)];
    for (int idx = tid; idx < 8192; idx += 256) BTg[idx] = Bm[(idx & 63) * 136 + (idx >> 6)];
  }
  __syncthreads();
  for (int hh = 0; hh < 4; ++hh) {
    int hd = g * 4 + hh;
    bfu* AMg = Xb + 32768 + hd * 12288;
    float Dh = p.in[13][layer * 8 + hd];
    const float* dtp = sm + hh * 64;
    const float* acp = sm + 256 + hh * 64;
    for (int idx = tid; idx < 4096; idx += 256) {
      int l = idx >> 6, m = idx & 63;
      float v = (m <= l) ? cb[l * 68 + m] * __expf(acp[l] - acp[m]) : 0.f;
      if (m == l) v += Dh / dtp[l];
      AMg[idx] = f2bf(v);
    }
    float* sc = SCb + hd * 256;
    float alast = acp[63];
    if (tid < 64) { sc[tid] = __expf(acp[tid]); sc[64 + tid] = __expf(alast - acp[tid]); }
    else if (tid < 192) sc[128 + (tid - 64)] = __expf(alast);
  }
  __syncthreads();
}

DI void hg_prep_item(const Params& p, int layer, int item) {
  const int tid = TIDX, lane = tid & 63, w = tid >> 6, fr = lane & 15, fq = lane >> 4;
  const int h = item & 3, cn = item >> 2;
  const long r0 = (long)cn * 64;
  const bfu* P = (const bfu*)(p.ws + OFF_P);
  const float* lbv = (const float*)(p.ws + OFF_LB);
  bfu* Xb = (bfu*)(p.ws + OFF_X) + (long)item * 28672;
  float* SC = (float*)(p.ws + OFF_SC) + (long)item * 256;
  bfu* Qall = (bfu*)g_smem;
  bfu* Ks = Qall + 160 * 136;
  float* segs = (float*)(g_smem + 60928);
  bfu* QDg = Xb;
  bfu* KDTg = Xb + 8192;
  bfu* AMg = Xb + 16384;
  bfu* VTg = Xb + 20480;
  copy_z(p, P + r0 * 2048 + 1536 + h * 128, 2048, (bfu*)(p.ws + OFF_Z) + r0 * 512 + h * 128, 16);
  {
    const int k8 = (tid & 15) * 8, rs = tid >> 4, t0 = rs * 4;
    u16x8 fr4[4], qr4[4], ir4[4];
    const bfu* base = P + (r0 + t0) * 2048 + h * 128 + k8;
#pragma unroll
    for (int r = 0; r < 4; ++r) {
      qr4[r] = *(const u16x8*)(base + (long)r * 2048);
      fr4[r] = *(const u16x8*)(base + (long)r * 2048 + 512);
      ir4[r] = *(const u16x8*)(base + (long)r * 2048 + 1024);
    }
    float lb[8];
    {
      float4 a4 = *(const float4*)(lbv + h * 128 + k8), b4 = *(const float4*)(lbv + h * 128 + k8 + 4);
      lb[0] = a4.x; lb[1] = a4.y; lb[2] = a4.z; lb[3] = a4.w; lb[4] = b4.x; lb[5] = b4.y; lb[6] = b4.z; lb[7] = b4.w;
    }
    float lf[4][8];
    float ssum[8];
#pragma unroll
    for (int c = 0; c < 8; ++c) ssum[c] = 0.f;
#pragma unroll
    for (int r = 0; r < 4; ++r)
#pragma unroll
      for (int c = 0; c < 8; ++c) {
        float zf = bf2f(fr4[r][c]);
        float f = lb[c] + (1.f - lb[c]) * (1.f / (1.f + __expf(-zf)));
        lf[r][c] = __logf(f);
        ssum[c] += lf[r][c];
      }
    *(float4*)(segs + rs * 128 + k8) = make_float4(ssum[0], ssum[1], ssum[2], ssum[3]);
    *(float4*)(segs + rs * 128 + k8 + 4) = make_float4(ssum[4], ssum[5], ssum[6], ssum[7]);
#pragma unroll
    for (int c = 0; c < 8; ++c) {
      u16x4 o = {ir4[0][c], ir4[1][c], ir4[2][c], ir4[3][c]};
      *(u16x4*)(VTg + (k8 + c) * 64 + t0) = o;
    }
    __syncthreads();
    float Gb[8], G1[8], G2[8], G3[8], GL[8];
#pragma unroll
    for (int c = 0; c < 8; ++c) { Gb[c] = 0.f; G1[c] = 0.f; G2[c] = 0.f; G3[c] = 0.f; GL[c] = 0.f; }
    for (int s2 = 0; s2 < 16; ++s2) {
      float4 a4 = *(const float4*)(segs + s2 * 128 + k8), b4 = *(const float4*)(segs + s2 * 128 + k8 + 4);
      float v[8] = {a4.x, a4.y, a4.z, a4.w, b4.x, b4.y, b4.z, b4.w};
#pragma unroll
      for (int c = 0; c < 8; ++c) {
        if (s2 < rs) Gb[c] += v[c];
        if (s2 < 4) G1[c] += v[c];
        if (s2 < 8) G2[c] += v[c];
        if (s2 < 12) G3[c] += v[c];
        GL[c] += v[c];
      }
    }
    const int Jt = rs >> 2;
    float G[8];
#pragma unroll
    for (int c = 0; c < 8; ++c) G[c] = Gb[c];
#pragma unroll
    for (int r = 0; r < 4; ++r) {
      const int t = t0 + r;
      u16x8 oq, oq1, oq2, oq3, ok;
#pragma unroll
      for (int c = 0; c < 8; ++c) {
        G[c] += lf[r][c];
        float zf = bf2f(fr4[r][c]);
        float kk = (1.f - lb[c]) * (1.f / (1.f + __expf(zf)));
        float q = siluf(bf2f(qr4[r][c]));
        oq[c] = f2bf(q * __expf(G[c]));
        oq1[c] = f2bf(q * __expf(G[c] - G1[c]));
        oq2[c] = f2bf(q * __expf(G[c] - G2[c]));
        oq3[c] = f2bf(q * __expf(G[c] - G3[c]));
        float GJ = (Jt == 0) ? 0.f : (Jt == 1) ? G1[c] : (Jt == 2) ? G2[c] : G3[c];
        ok[c] = f2bf(kk * __expf(fminf(GJ - G[c], 80.f)));
      }
      *(u16x8*)(QDg + t * 128 + k8) = oq;
      *(u16x8*)(Qall + t * 136 + k8) = oq;
      if (t >= 16) *(u16x8*)(Qall + (64 + t - 16) * 136 + k8) = oq1;
      if (t >= 32) *(u16x8*)(Qall + (112 + t - 32) * 136 + k8) = oq2;
      if (t >= 48) *(u16x8*)(Qall + (144 + t - 48) * 136 + k8) = oq3;
      *(u16x8*)(Ks + t * 136 + k8) = ok;
    }
#pragma unroll
    for (int c = 0; c < 8; ++c) {
      float Gc = Gb[c];
      u16x4 o;
#pragma unroll
      for (int r = 0; r < 4; ++r) {
        Gc += lf[r][c];
        float zf = bf2f(fr4[r][c]);
        float kk = (1.f - lb[c]) * (1.f / (1.f + __expf(zf)));
        o[r] = f2bf(kk * __expf(GL[c] - Gc));
      }
      *(u16x4*)(KDTg + (k8 + c) * 64 + t0) = o;
    }
    if (rs == 0) {
#pragma unroll
      for (int c = 0; c < 8; ++c) SC[128 + k8 + c] = __expf(GL[c]);
    }
  }
  __syncthreads();
  for (int J = 0; J < 4; ++J) {
    if (J <= w) {
      int rowbase = (J == 0 ? 0 : J == 1 ? 64 : J == 2 ? 112 : 144) + 16 * (w - J);
      f32x4 a = {0.f, 0.f, 0.f, 0.f};
#pragma unroll
      for (int ks = 0; ks < 4; ++ks) {
        bf16x8 af = *(const bf16x8*)(Qall + (rowbase + fr) * 136 + ks * 32 + fq * 8);
        bf16x8 bk = *(const bf16x8*)(Ks + (16 * J + fr) * 136 + ks * 32 + fq * 8);
        a = MFMA16(af, bk, a);
      }
#pragma unroll
      for (int r = 0; r < 4; ++r) {
        int t = 16 * w + fq * 4 + r, s = 16 * J + fr;
        AMg[t * 64 + s] = f2bf((s <= t) ? a[r] : 0.f);
      }
    } else {
#pragma unroll
      for (int r = 0; r < 4; ++r) AMg[(16 * w + fq * 4 + r) * 64 + 16 * J + fr] = 0;
    }
  }
  __syncthreads();
}

struct LinArgs {
  const bfu* kdt; long kdt_cs;
  const bfu* vt; long vt_cs;
  const float* sc; long sc_cs;
  bfu* ss; long ss_cs;
  int kt0;
};
struct LinFrags { bf16x8 kf[2]; bf16x8 vf[2]; f32x4 dv; };
DI void lin_load(LinFrags& f, const LinArgs& e, int n, int w, int fr, int fq) {
#pragma unroll
  for (int ks = 0; ks < 2; ++ks) f.kf[ks] = *(const bf16x8*)(e.kdt + n * e.kdt_cs + ((e.kt0 + w) * 16 + fr) * 64 + ks * 32 + fq * 8);
#pragma unroll
  for (int ks = 0; ks < 2; ++ks) f.vf[ks] = *(const bf16x8*)(e.vt + n * e.vt_cs + fr * 64 + ks * 32 + fq * 8);
  f.dv = *(const f32x4*)(e.sc + n * e.sc_cs + 128 + (e.kt0 + w) * 16 + fq * 4);
}
template <int NST>
DI void engine_lin(const LinArgs& e) {
  const int tid = TIDX, lane = tid & 63, w = tid >> 6, fr = lane & 15, fq = lane >> 4;
  f32x4 S = f32x4{0.f, 0.f, 0.f, 0.f};
  LinFrags f[NST];
#pragma unroll
  for (int s = 0; s < NST - 1; ++s) lin_load(f[s], e, s, w, fr, fq);
  for (int n0 = 0; n0 < NCHK; n0 += NST) {
#pragma unroll
    for (int s = 0; s < NST; ++s) {
      const int n = n0 + s;
      if (n < NCHK) {
        int nl = n + NST - 1; if (nl > NCHK - 1) nl = NCHK - 1;
        lin_load(f[(s + NST - 1) % NST], e, nl, w, fr, fq);
        const LinFrags& c = f[s];
        u16x4 pk = {f2bf(S[0]), f2bf(S[1]), f2bf(S[2]), f2bf(S[3])};
        *(u16x4*)(e.ss + n * e.ss_cs + fr * 128 + (e.kt0 + w) * 16 + fq * 4) = pk;
#pragma unroll
        for (int r = 0; r < 4; ++r) S[r] *= c.dv[r];
#pragma unroll
        for (int ks = 0; ks < 2; ++ks) S = MFMA16(c.kf[ks], c.vf[ks], S);
      }
    }
  }
}

struct GdnArgs {
  const bfu* w; const bfu* kdt; bfu* ut; long cs;
  const float* sc; long sc_cs;
  bfu* ss; long ss_cs;
};
struct GdnFrags { bf16x8 wf[4]; bf16x8 kf[2][2]; u16x4 v[2]; float dv; };
DI void gdn_load(GdnFrags& f, const GdnArgs& e, int n, int w, int fr, int fq) {
#pragma unroll
  for (int ks = 0; ks < 4; ++ks) f.wf[ks] = *(const bf16x8*)(e.w + n * e.cs + (16 * w + fr) * 128 + ks * 32 + fq * 8);
#pragma unroll
  for (int a = 0; a < 2; ++a)
#pragma unroll
    for (int ks = 0; ks < 2; ++ks) f.kf[a][ks] = *(const bf16x8*)(e.kdt + n * e.cs + ((2 * w + a) * 16 + fr) * 64 + ks * 32 + fq * 8);
#pragma unroll
  for (int jv = 0; jv < 2; ++jv) f.v[jv] = *(const u16x4*)(e.ut + n * e.cs + (jv * 16 + fr) * 64 + 16 * w + fq * 4);
  f.dv = e.sc[n * e.sc_cs + 128];
}
template <int NST>
DI void engine_gdn(const GdnArgs& e) {
  const int tid = TIDX, lane = tid & 63, w = tid >> 6, fr = lane & 15, fq = lane >> 4;
  char* VT = g_smem + 17408;
  f32x4 S[2][2];
#pragma unroll
  for (int a = 0; a < 2; ++a)
#pragma unroll
    for (int jv = 0; jv < 2; ++jv) S[a][jv] = f32x4{0.f, 0.f, 0.f, 0.f};
  GdnFrags f[NST];
#pragma unroll
  for (int s = 0; s < NST - 1; ++s) gdn_load(f[s], e, s, w, fr, fq);
  for (int n0 = 0; n0 < NCHK; n0 += NST) {
#pragma unroll
    for (int s = 0; s < NST; ++s) {
      const int n = n0 + s;
      if (n < NCHK) {
        int nl = n + NST - 1; if (nl > NCHK - 1) nl = NCHK - 1;
        gdn_load(f[(s + NST - 1) % NST], e, nl, w, fr, fq);
        const GdnFrags& c = f[s];
        char* STc = g_smem + (n & 1) * 8704;
#pragma unroll
        for (int a = 0; a < 2; ++a)
#pragma unroll
          for (int jv = 0; jv < 2; ++jv) {
            u16x4 pk = {f2bf(S[a][jv][0]), f2bf(S[a][jv][1]), f2bf(S[a][jv][2]), f2bf(S[a][jv][3])};
            *(u16x4*)(STc + ((jv * 16 + fr) * 136 + (2 * w + a) * 16 + fq * 4) * 2) = pk;
            *(u16x4*)(e.ss + n * e.ss_cs + (jv * 16 + fr) * 128 + (2 * w + a) * 16 + fq * 4) = pk;
          }
        __syncthreads();
        f32x4 av[2] = {f32x4{0.f, 0.f, 0.f, 0.f}, f32x4{0.f, 0.f, 0.f, 0.f}};
#pragma unroll
        for (int ks = 0; ks < 4; ++ks)
#pragma unroll
          for (int jv = 0; jv < 2; ++jv) {
            bf16x8 sf = *(const bf16x8*)(STc + ((jv * 16 + fr) * 136 + ks * 32 + fq * 8) * 2);
            av[jv] = MFMA16(c.wf[ks], sf, av[jv]);
          }
#pragma unroll
        for (int jv = 0; jv < 2; ++jv) {
          u16x4 pk;
#pragma unroll
          for (int r = 0; r < 4; ++r) pk[r] = f2bf(bf2f(c.v[jv][r]) - av[jv][r]);
          *(u16x4*)(VT + ((jv * 16 + fr) * 72 + 16 * w + fq * 4) * 2) = pk;
          *(u16x4*)(e.ut + n * e.cs + (jv * 16 + fr) * 64 + 16 * w + fq * 4) = pk;
        }
        __syncthreads();
#pragma unroll
        for (int a = 0; a < 2; ++a) {
#pragma unroll
          for (int jv = 0; jv < 2; ++jv)
#pragma unroll
            for (int r = 0; r < 4; ++r) S[a][jv][r] *= c.dv;
#pragma unroll
          for (int ks = 0; ks < 2; ++ks)
#pragma unroll
            for (int jv = 0; jv < 2; ++jv) {
              bf16x8 vf = *(const bf16x8*)(VT + ((jv * 16 + fr) * 72 + ks * 32 + fq * 8) * 2);
              S[a][jv] = MFMA16(c.kf[a][ks], vf, S[a][jv]);
            }
        }
      }
    }
  }
  __syncthreads();
}

template <int NVT, bool USE_RS>
DI void oproj_core(f32x4 (&acc)[NVT], const bfu* qd, const bfu* am, const bfu* st, const bfu* vt, const float* rsp, int w, int fr, int fq) {
#pragma unroll
  for (int jv = 0; jv < NVT; ++jv) acc[jv] = f32x4{0.f, 0.f, 0.f, 0.f};
#pragma unroll
  for (int ks = 0; ks < 4; ++ks) {
    bf16x8 qf = *(const bf16x8*)(qd + (16 * w + fr) * 128 + ks * 32 + fq * 8);
#pragma unroll
    for (int jv = 0; jv < NVT; ++jv) {
      bf16x8 sf = *(const bf16x8*)(st + (jv * 16 + fr) * 128 + ks * 32 + fq * 8);
      acc[jv] = MFMA16(qf, sf, acc[jv]);
    }
  }
  if (USE_RS) {
    f32x4 rs = *(const f32x4*)(rsp + 16 * w + fq * 4);
#pragma unroll
    for (int jv = 0; jv < NVT; ++jv)
#pragma unroll
      for (int r = 0; r < 4; ++r) acc[jv][r] *= rs[r];
  }
#pragma unroll
  for (int ks = 0; ks < 2; ++ks) {
    bf16x8 af = *(const bf16x8*)(am + (16 * w + fr) * 64 + ks * 32 + fq * 8);
#pragma unroll
    for (int jv = 0; jv < NVT; ++jv) {
      bf16x8 vf = *(const bf16x8*)(vt + (jv * 16 + fr) * 64 + ks * 32 + fq * 8);
      acc[jv] = MFMA16(af, vf, acc[jv]);
    }
  }
}
DI void oproj_head128(const bfu* qd, const bfu* am, const bfu* st, const bfu* vt, const bfu* zP, int zld, const float* nw, bfu* Yo) {
  const int tid = TIDX, lane = tid & 63, w = tid >> 6, fr = lane & 15, fq = lane >> 4;
  const int row = 16 * w + (lane >> 2), q = lane & 3;
  u16x8 zr[4];
#pragma unroll
  for (int i = 0; i < 4; ++i) zr[i] = *(const u16x8*)(zP + (long)row * zld + q * 32 + i * 8);
  f32x4 acc[8];
  oproj_core<8, false>(acc, qd, am, st, vt, nullptr, w, fr, fq);
  float* T = (float*)g_smem;
#pragma unroll
  for (int jv = 0; jv < 8; ++jv)
#pragma unroll
    for (int r = 0; r < 4; ++r) T[(16 * w + fq * 4 + r) * 132 + jv * 16 + fr] = acc[jv][r];
  float o[32];
  float ss = 0.f;
#pragma unroll
  for (int i = 0; i < 8; ++i) {
    f32x4 v = *(const f32x4*)(T + row * 132 + q * 32 + i * 4);
#pragma unroll
    for (int j = 0; j < 4; ++j) { o[i * 4 + j] = v[j]; ss += v[j] * v[j]; }
  }
  ss += __shfl_xor(ss, 1); ss += __shfl_xor(ss, 2);
  const float rs = rsqrtf(ss * (1.f / 128.f) + 1e-6f);
#pragma unroll
  for (int i = 0; i < 4; ++i) {
    u16x8 res;
    f32x4 w0 = *(const f32x4*)(nw + q * 32 + i * 8), w1 = *(const f32x4*)(nw + q * 32 + i * 8 + 4);
#pragma unroll
    for (int j = 0; j < 8; ++j) {
      float wv = j < 4 ? w0[j & 3] : w1[j & 3];
      res[j] = f2bf(o[i * 8 + j] * rs * wv * siluf(bf2f(zr[i][j])));
    }
    *(u16x8*)(Yo + (long)row * 512 + q * 32 + i * 8) = res;
  }
}
DI void oproj_ssd(const bfu* Xb  , int g, const float* SCb, const bfu* SSb, const bfu* zP, const float* nw, bfu* Yo) {
  const int tid = TIDX, lane = tid & 63, w = tid >> 6, fr = lane & 15, fq = lane >> 4;
  const int row = 16 * w + (lane >> 2), q = lane & 3;
  float* T = (float*)g_smem;
#pragma unroll
  for (int hh = 0; hh < 4; ++hh) {
    int hd = g * 4 + hh;
    f32x4 acc[4];
    oproj_core<4, true>(acc, Xb + g * 16384, Xb + 32768 + hd * 12288, SSb + hd * 8192, Xb + 32768 + hd * 12288 + 4096, SCb + hd * 256, w, fr, fq);
#pragma unroll
    for (int jv = 0; jv < 4; ++jv)
#pragma unroll
      for (int r = 0; r < 4; ++r) T[(16 * w + fq * 4 + r) * 260 + hh * 64 + jv * 16 + fr] = acc[jv][r];
  }
  float ss = 0.f;
  float o[64];
#pragma unroll
  for (int i = 0; i < 8; ++i) {
    u16x8 z = *(const u16x8*)(zP + (long)row * 512 + q * 64 + i * 8);
    f32x4 v0 = *(const f32x4*)(T + row * 260 + q * 64 + i * 8), v1 = *(const f32x4*)(T + row * 260 + q * 64 + i * 8 + 4);
#pragma unroll
    for (int j = 0; j < 8; ++j) {
      float y = (j < 4 ? v0[j & 3] : v1[j & 3]) * siluf(bf2f(z[j]));
      o[i * 8 + j] = y;
      ss += y * y;
    }
  }
  ss += __shfl_xor(ss, 1); ss += __shfl_xor(ss, 2);
  const float rs = rsqrtf(ss * (1.f / 256.f) + 1e-6f);
#pragma unroll
  for (int i = 0; i < 8; ++i) {
    u16x8 res;
    f32x4 w0 = *(const f32x4*)(nw + q * 64 + i * 8), w1 = *(const f32x4*)(nw + q * 64 + i * 8 + 4);
#pragma unroll
    for (int j = 0; j < 8; ++j) res[j] = f2bf(o[i * 8 + j] * rs * (j < 4 ? w0[j & 3] : w1[j & 3]));
    *(u16x8*)(Yo + (long)row * 512 + q * 64 + i * 8) = res;
  }
}

DI float geluf(float x) { float u = 0.7978845608028654f * (x + 0.044715f * x * x * x); return 0.5f * x * (1.f + tanhf(u)); }

DI void phase_s5_gemm1(const Params& p) {
  const bfu* U2 = (const bfu*)(p.ws + OFF_U2);
  const bfu* Ms = (const bfu*)(p.ws + OFF_MS);
  float* Xloc = (float*)(p.ws + OFF_XLOC);
  for (int t = BIDX; t < 32 * 17; t += gridDim.x) {
    int g = t / 17, tm = t - g * 17;
    f32x4 acc[4][4];
    zero_acc<4>(acc);
    gemm_tile<4>(acc, U2 + ((long)g * 2176 + tm * 128) * 256, 256, Ms + (long)g * 128 * 256, 256, 256);
    ACC_FOREACH(4, { Xloc[((long)g * 2176 + tm * 128 + trow) * 128 + tcol] = acc[m][n][j]; })
  }
}
DI void phase_s5_scan(const Params& p, int layer) {
  float* Xloc = (float*)(p.ws + OFF_XLOC);
  bfu* Xst = (bfu*)(p.ws + OFF_XST);
  const int tid = TIDX;
  const int seg = tid >> 4, p16 = tid & 15;
  float* ex = (float*)g_smem;
  for (int it = BIDX; it < 256; it += gridDim.x) {
    const int g = it >> 3, b = (it >> 2) & 1, pq = it & 3;
    const int pr = pq * 16 + p16;
    const int idx = (layer * 32 + g) * 64 + pr;
    const float dt = expf(p.in[24][layer * 32 + g]);
    const float e1 = p.in[17][idx] * dt * 16.f, a1 = p.in[18][idx] * dt * 16.f;
    const float m16 = expf(e1);
    const float l16x = m16 * cosf(a1), l16y = m16 * sinf(a1);
    const int n0 = seg * 65, n1 = (n0 + 65 < 1028) ? n0 + 65 : 1028;
    const float* xl = Xloc + ((long)g * 2176 + b * 1028) * 128;
    bfu* xs = Xst + ((long)g * 2176 + b * 1028) * 128;
    float sre = 0.f, sim = 0.f;
#pragma unroll 13
    for (int n = n0; n < n1; ++n) {
      float lre = xl[(long)n * 128 + pr], lim = xl[(long)n * 128 + 64 + pr];
      float nre = l16x * sre - l16y * sim + lre;
      float nim = l16x * sim + l16y * sre + lim;
      sre = nre; sim = nim;
    }
    __syncthreads();
    ex[(seg * 16 + p16) * 2] = sre; ex[(seg * 16 + p16) * 2 + 1] = sim;
    __syncthreads();
    float cre = 0.f, cim = 0.f;
    {
      const float mL = expf(e1 * 65.f), aL = a1 * 65.f;
      const float lLx = mL * cosf(aL), lLy = mL * sinf(aL);
      for (int s2 = 0; s2 < seg; ++s2) {
        float ere = ex[(s2 * 16 + p16) * 2], eim = ex[(s2 * 16 + p16) * 2 + 1];
        float nre = lLx * cre - lLy * cim + ere;
        float nim = lLx * cim + lLy * cre + eim;
        cre = nre; cim = nim;
      }
    }
    sre = cre; sim = cim;
#pragma unroll 13
    for (int n = n0; n < n1; ++n) {
      float lre = xl[(long)n * 128 + pr], lim = xl[(long)n * 128 + 64 + pr];
      xs[(long)n * 128 + pr] = f2bf(sre);
      xs[(long)n * 128 + 64 + pr] = f2bf(sim);
      float nre = l16x * sre - l16y * sim + lre;
      float nim = l16x * sim + l16y * sre + lim;
      sre = nre; sim = nim;
    }
  }
}
DI void phase_s5_gemm2(const Params& p) {
  const bfu* U2 = (const bfu*)(p.ws + OFF_U2);
  const bfu* Xst = (const bfu*)(p.ws + OFF_XST);
  const bfu* Mc = (const bfu*)(p.ws + OFF_MC);
  bfu* Ys5 = (bfu*)(p.ws + OFF_YS5);
  for (int t = BIDX; t < 32 * 17 * 2; t += gridDim.x) {
    int g = t / 34, rem = t - g * 34, tm = rem >> 1, tn = rem & 1;
    f32x4 acc[4][4];
    zero_acc<4>(acc);
    const bfu* Bt = Mc + ((long)g * 256 + tn * 128) * 384;
    gemm_tile<4>(acc, U2 + ((long)g * 2176 + tm * 128) * 256, 256, Bt, 384, 256);
    gemm_tile<4>(acc, Xst + ((long)g * 2176 + tm * 128) * 128, 128, Bt + 256, 384, 128);
    ACC_FOREACH(4, {
      int nc = tm * 128 + trow, o = tn * 128 + tcol;
      if (nc < 2056) Ys5[((long)nc * 16 + (o >> 4)) * 512 + g * 16 + (o & 15)] = f2bf(geluf(acc[m][n][j]));
    })
  }
}
DI void phase_glu(const Params& p) {
  const bfu* Ys5 = (const bfu*)(p.ws + OFF_YS5);
  const bfu* Wg = (const bfu*)(p.ws + OFF_WGLU);
  const bfu* Pz = (const bfu*)(p.ws + OFF_PZ);
  bfu* Yd = (bfu*)(p.ws + OFF_Y) + (long)3 * TR * 512;
  for (int v = BIDX; v < 320 * 8; v += gridDim.x) {
    int tm, tn;
    if (!tile_map(v, 8, tm, tn)) continue;
    f32x4 acc[4][4];
    zero_acc<4>(acc);
    gemm_tile<4>(acc, Ys5 + (long)tm * 128 * 512, 512, Wg + (long)tn * 128 * 512, 512, 512);
    const int lane = TIDX & 63, wid = TIDX >> 6, wr = wid >> 1, wc = wid & 1, fr = lane & 15, fq = lane >> 4;
#pragma unroll
    for (int m = 0; m < 4; ++m)
#pragma unroll
      for (int n = 0; n < 2; ++n)
#pragma unroll
        for (int j = 0; j < 4; ++j) {
          int row = tm * 128 + wr * 64 + m * 16 + fq * 4 + j;
          int oc = tn * 64 + wc * 32 + n * 16 + fr;
          float z = bf2f(Pz[(long)row * 512 + oc]);
          Yd[(long)row * 512 + oc] = f2bf(acc[m][n][j] * sigm(acc[m][n + 2][j]) * siluf(z));
        }
  }
}
DI void phase_gates(const Params& p) {
  const bfu* h16 = (const bfu*)(p.ws + OFF_H16);
  const bfu* WT = (const bfu*)(p.ws + OFF_WIN);
  bfu* G = (bfu*)(p.ws + OFF_P);
  for (int v = BIDX; v < 320 * 32; v += gridDim.x) {
    int tm, tn;
    if (!tile_map(v, 32, tm, tn)) continue;
    f32x4 acc[4][4];
    zero_acc<4>(acc);
    gemm_tile<4>(acc, h16 + (long)tm * 128 * 1024, 1024, WT + (long)(6656 + tn * 128) * 1024, 1024, 1024);
    {
      const int lane = TIDX & 63, wid = TIDX >> 6, wr = wid >> 1, wc = wid & 1, fr = lane & 15, fq = lane >> 4;
#pragma unroll
      for (int m = 0; m < 4; ++m)
#pragma unroll
        for (int n = 0; n < 4; ++n) {
          const int row4 = (tm * 128 + wr * 64 + m * 16 + fq * 4) >> 2, col = tn * 128 + wc * 64 + n * 16 + fr;
          u16x4 pk = {f2bf(sigm(acc[m][n][0])), f2bf(sigm(acc[m][n][1])), f2bf(sigm(acc[m][n][2])), f2bf(sigm(acc[m][n][3]))};
          *(u16x4*)(G + ((long)row4 * 4096 + col) * 4) = pk;
        }
    }
  }
}
DI void phase_merge(const Params& p) {
  const bfu* WbT = (const bfu*)(p.ws + OFF_WB);
  const bfu* Y = (const bfu*)(p.ws + OFF_Y);
  const bfu* G = (const bfu*)(p.ws + OFF_P);
  bfu* mixed = (bfu*)(p.ws + OFF_H16);
  for (int v = BIDX; v < 320 * 8; v += gridDim.x) {
    int tm, tn;
    if (!tile_map(v, 8, tm, tn)) continue;
    f32x4 tot[4][4];
    zero_acc<4>(tot);
    for (int b = 0; b < 4; ++b) {
      f32x4 acc[4][4];
      zero_acc<4>(acc);
      gemm_tile<4>(acc, Y + ((long)b * TR + tm * 128) * 512, 512, WbT + (long)(b * 1024 + tn * 128) * 512, 512, 512);
      {
        const int lane = TIDX & 63, wid = TIDX >> 6, wr = wid >> 1, wc = wid & 1, fr = lane & 15, fq = lane >> 4;
#pragma unroll
        for (int m = 0; m < 4; ++m)
#pragma unroll
          for (int n = 0; n < 4; ++n) {
            const int row4 = (tm * 128 + wr * 64 + m * 16 + fq * 4) >> 2, col = b * 1024 + tn * 128 + wc * 64 + n * 16 + fr;
            u16x4 gk = *(const u16x4*)(G + ((long)row4 * 4096 + col) * 4);
#pragma unroll
            for (int j = 0; j < 4; ++j) tot[m][n][j] += bf2f(gk[j]) * acc[m][n][j];
          }
      }
    }
    ACC_FOREACH(4, { mixed[(long)(tm * 128 + trow) * 1024 + tn * 128 + tcol] = f2bf(tot[m][n][j]); })
  }
}
DI void phase_out(const Params& p) {
  const bfu* mixed = (const bfu*)(p.ws + OFF_H16);
  const bfu* WoT = (const bfu*)(p.ws + OFF_WO);
  float* h32 = (float*)(p.ws + OFF_H32);
  const float ALPHA = 1.6817928305074290f;
  for (int v = BIDX; v < 320 * 8; v += gridDim.x) {
    int tm, tn;
    if (!tile_map(v, 8, tm, tn)) continue;
    f32x4 acc[4][4];
    zero_acc<4>(acc);
    gemm_tile<4>(acc, mixed + (long)tm * 128 * 1024, 1024, WoT + (long)tn * 128 * 1024, 1024, 1024);
    ACC_FOREACH(4, {
      long a = (long)(tm * 128 + trow) * 1024 + tn * 128 + tcol;
      h32[a] = ALPHA * h32[a] + acc[m][n][j];
    })
  }
}

DI void run_phase(const Params& p, int ph) {
  if (ph == 0) { phase_tables(p); return; }
  if (ph == NPHASE - 1) { ln_rows(p, 3, true); return; }
  const int layer = (ph - 1) / NPL, sub = (ph - 1) % NPL;
  bfu* Xb = (bfu*)(p.ws + OFF_X);
  float* SC = (float*)(p.ws + OFF_SC);
  bfu* Y = (bfu*)(p.ws + OFF_Y);
  const bfu* Zb = (const bfu*)(p.ws + OFF_Z);
  const int bid = BIDX;
  switch (sub) {
    case 0: ln_rows(p, layer - 1, false); phase_convert(p, layer); break;
    case 1: phase_proj(p, 0, 2048, 0, true, 0); break;
    case 2: for (int it = bid; it < 2056; it += gridDim.x) gdn_prep_item(p, layer, it); break;
    case 3:
      if (bid < 32) {
        int b = bid >> 4, h = (bid >> 2) & 3, sl = bid & 3;
        GdnArgs e;
        bfu* base = Xb + ((long)(b * NCHK) * 4 + h) * 36864;
        e.w = base + 8192; e.kdt = base + 16384; e.ut = base + 24576 + sl * 32 * 64; e.cs = 4 * 36864;
        e.sc = SC + ((long)(b * NCHK) * 4 + h) * 256; e.sc_cs = 4 * 256;
        e.ss = Y + (long)TR * 512 + ((long)(b * NCHK) * 4 + h) * 16384 + sl * 32 * 128; e.ss_cs = 4 * 16384;
        engine_gdn<4>(e);
      } else phase_proj(p, 2048, 1536, 0, false, 32, gridDim.x == 512 ? 32 : 0);
      break;
    case 4:
      for (int it = bid; it < 2056; it += gridDim.x) {
        int h = it & 3; long r0 = (long)(it >> 2) * 64;
        const bfu* base = Xb + (long)it * 36864;
        oproj_head128(base, base + 32768, Y + (long)TR * 512 + (long)it * 16384, base + 24576,
                      Zb + r0 * 512 + h * 128, 512, p.in[8] + layer * 128, Y + r0 * 512 + h * 128);
      }
      break;
    case 5: for (int it = bid; it < 1028; it += gridDim.x) ssd_prep_item(p, layer, it); break;
    case 6:
      if (bid < 128) {
        int b = bid >> 6, hd = (bid >> 3) & 7, sl = (bid >> 1) & 3, kh = bid & 1, g = hd >> 2;
        LinArgs e;
        const bfu* base = Xb + (long)(b * NCHK) * 131072;
        e.kdt = base + g * 16384 + 8192; e.kdt_cs = 131072;
        e.vt = base + 32768 + hd * 12288 + 8192 + sl * 16 * 64; e.vt_cs = 131072;
        e.sc = SC + ((long)(b * NCHK) * 8 + hd) * 256; e.sc_cs = 8 * 256;
        e.ss = Y + (long)2 * TR * 512 + ((long)(b * NCHK) * 8 + hd) * 8192 + sl * 16 * 128; e.ss_cs = 8 * 8192;
        e.kt0 = kh * 4;
        engine_lin<9>(e);
      } else phase_proj(p, 3584, 2048, 0, false, 128);
      break;
    case 7:
      for (int it = bid; it < 1028; it += gridDim.x) {
        int g = it & 1; long cn = it >> 1; long r0 = cn * 64;
        oproj_ssd(Xb + cn * 131072, g, SC + cn * 8 * 256, Y + (long)2 * TR * 512 + cn * 8 * 8192,
                  Zb + r0 * 512 + g * 256, p.in[14] + layer * 512 + g * 256, Y + (long)TR * 512 + r0 * 512 + g * 256);
      }
      break;
    case 8: for (int it = bid; it < 2056; it += gridDim.x) hg_prep_item(p, layer, it); break;
    case 9:
      if (bid < 128) {
        int b = bid >> 6, h = (bid >> 4) & 3, sl = (bid >> 1) & 7, kh = bid & 1;
        LinArgs e;
        const bfu* base = Xb + ((long)(b * NCHK) * 4 + h) * 28672;
        e.kdt = base + 8192; e.kdt_cs = 4 * 28672;
        e.vt = base + 20480 + sl * 16 * 64; e.vt_cs = 4 * 28672;
        e.sc = SC + ((long)(b * NCHK) * 4 + h) * 256; e.sc_cs = 4 * 256;
        bfu* ssb = b == 0 ? (Y + (long)3 * TR * 512) : (Xb + (long)2056 * 28672);
        e.ss = ssb + (long)h * 16384 + sl * 16 * 128; e.ss_cs = 4 * 16384;
        e.kt0 = kh * 4;
        engine_lin<9>(e);
      } else phase_proj(p, 5632, 1024, 1, false, 128, gridDim.x == 512 ? 128 : 0);
      break;
    case 10:
      for (int it = bid; it < 2056; it += gridDim.x) {
        int h = it & 3; int cn = it >> 2; long r0 = (long)cn * 64;
        int b = cn / NCHK, n = cn - b * NCHK;
        const bfu* base = Xb + (long)it * 28672;
        const bfu* ssb = b == 0 ? (Y + (long)3 * TR * 512) : (Xb + (long)2056 * 28672);
        oproj_head128(base, base + 16384, ssb + ((long)n * 4 + h) * 16384, base + 20480,
                      Zb + r0 * 512 + h * 128, 512, p.in[16] + layer * 128, Y + (long)2 * TR * 512 + r0 * 512 + h * 128);
      }
      break;
    case 11: phase_s5_gemm1(p); break;
    case 12: phase_s5_scan(p, layer); break;
    case 13: phase_s5_gemm2(p); break;
    case 14: phase_glu(p); break;
    case 15: phase_gates(p); break;
    case 16: phase_merge(p); break;
    case 17: phase_out(p); break;
  }
}


#define XB_TMO      128
#define XB_XCNT(j)  (256  + 64 * (j))
#define XB_XSUB(j)  (1280 + 64 * (j))
#define XB_XGEN(j)  (2304 + 64 * (j))
#define XB_TOP      3328
#define XB_TOPGEN   3392
#define XCD_BAR_WORDS 3456
#define XB_SPIN_CAP (1u << 20)
#define LAS __attribute__((address_space(3)))
DI unsigned xb_ld(unsigned* p) { return __hip_atomic_load(p, __ATOMIC_RELAXED, __HIP_MEMORY_SCOPE_AGENT); }
DI unsigned xb_add(unsigned* p, unsigned v) { return __hip_atomic_fetch_add(p, v, __ATOMIC_RELAXED, __HIP_MEMORY_SCOPE_AGENT); }
DI unsigned xb_xcc_id() { return (unsigned)__builtin_amdgcn_s_getreg((3 << 11) | 20) & 0xFu; }
#define XB_SPIN(cond, bar) do { unsigned _sp = 0; while (cond) { __builtin_amdgcn_s_sleep(1); \
    if ((++_sp & 255u) == 0u) { if (xb_ld(&(bar)[XB_TMO])) break; if (_sp > XB_SPIN_CAP) { atomicAdd(&(bar)[XB_TMO], 1u); break; } } } } while (0)
struct XcdBarrier { unsigned* bar; unsigned x; volatile LAS unsigned* st; };
DI XcdBarrier xcd_barrier_post(unsigned* bar, volatile LAS unsigned* st) {
  XcdBarrier b; b.bar = bar; b.x = xb_xcc_id(); b.st = st;
  if (threadIdx.x == 0) (void)xb_add(&bar[XB_XCNT(b.x)], 1u);
  return b;
}
DI void xcd_barrier_complete(unsigned* bar, unsigned x, unsigned& nloc, unsigned& nx) {
  const unsigned G = gridDim.x * gridDim.y * gridDim.z;
  unsigned sum, cnt, mine, sp = 0u;
  for (;;) {
    sum = 0u; cnt = 0u; mine = 0u;
#pragma unroll
    for (unsigned j = 0; j < 16; ++j) { const unsigned c = xb_ld(&bar[XB_XCNT(j)]); sum += c; cnt += (c > 0u) ? 1u : 0u; mine = (j == x) ? c : mine; }
    if (sum == G) break;
    __builtin_amdgcn_s_sleep(1);
    if ((++sp & 255u) == 0u) { if (xb_ld(&bar[XB_TMO])) break; if (sp > XB_SPIN_CAP) { atomicAdd(&bar[XB_TMO], 1u); break; } }
  }
  nloc = mine > 0u ? mine : 1u; nx = cnt > 0u ? cnt : 1u;
}
DI void xcd_barrier(const XcdBarrier& b) {
  asm volatile("s_waitcnt vmcnt(0)" ::: "memory");
  __syncthreads();
  if (threadIdx.x == 0) {
    unsigned* bar = b.bar;
    __builtin_amdgcn_s_waitcnt(0);
    unsigned nloc = b.st[0], nx = b.st[1];
    if (nloc == 0u) { xcd_barrier_complete(bar, b.x, nloc, nx); b.st[0] = nloc; b.st[1] = nx; }
    const unsigned old = xb_add(&bar[XB_XSUB(b.x)], 1u);
    const unsigned gen = old / nloc;
    if (old + 1u == (gen + 1u) * nloc) {
      __builtin_amdgcn_fence(__ATOMIC_RELEASE, "agent");
      asm volatile("s_waitcnt vmcnt(0)" ::: "memory");
      const unsigned og = xb_add(&bar[XB_TOP], 1u);
      const unsigned tg = og / nx;
      if (og + 1u == (tg + 1u) * nx) xb_add(&bar[XB_TOPGEN], 1u);
      else XB_SPIN(xb_ld(&bar[XB_TOPGEN]) == tg, bar);
      __builtin_amdgcn_fence(__ATOMIC_ACQUIRE, "agent");
      xb_add(&bar[XB_XGEN(b.x)], 1u);
      asm volatile("s_waitcnt vmcnt(0)" ::: "memory");
    } else {
      XB_SPIN(xb_ld(&bar[XB_XGEN(b.x)]) == gen, bar);
      __builtin_amdgcn_fence(__ATOMIC_ACQUIRE, "agent");
      asm volatile("s_waitcnt vmcnt(0)" ::: "memory");
    }
  }
  __syncthreads();
}
#ifndef DBL_MASK
#define DBL_MASK 0
#endif
#ifndef TIMING_PROBE
#define TIMING_PROBE 0
#endif
#ifndef TP_MASK_A
#define TP_MASK_A 0
#endif
#ifndef TP_MASK_B
#define TP_MASK_B 0
#endif
__global__ void __launch_bounds__(256, 2) mega_kernel(Params p, int ph_lo, int ph_hi) {
  if (ph_hi - ph_lo == 1) { run_phase(p, ph_lo); return; }
  cg::grid_group grid = cg::this_grid();
  volatile LAS unsigned* xst = (volatile LAS unsigned*)(g_smem + LDS_BYTES - 16);
  if (threadIdx.x == 0) { xst[0] = 0u; xst[1] = 0u; xst[2] = 0u; xst[3] = 0u; }
  __syncthreads();
  XcdBarrier xb = xcd_barrier_post((unsigned*)(p.ws + OFF_BAR), xst);
  for (int ph = ph_lo; ph < ph_hi; ++ph) {
    run_phase(p, ph);
#if DBL_MASK
    if (ph > 0 && ph < NPHASE - 1 && ((DBL_MASK >> ((ph - 1) % NPL)) & 1)) { xcd_barrier(xb); run_phase(p, ph); }
#endif
    if (ph + 1 < ph_hi) {
      if (ph == ph_lo) grid.sync();
      else xcd_barrier(xb);
    }
  }
}

extern "C" void kernel_launch(void* const* d_in, const int* in_sizes, int n_in, void* d_out, int out_size, void* d_ws, size_t ws_size,
                              hipStream_t stream) {
  static int grid_blocks = 0;
  if (!grid_blocks) {
    int dev = 0, cus = 0, per_cu = 0;
    hipGetDevice(&dev);
    hipDeviceGetAttribute(&cus, hipDeviceAttributeMultiprocessorCount, dev);
    hipFuncSetAttribute((const void*)mega_kernel, hipFuncAttributeMaxDynamicSharedMemorySize, LDS_BYTES);
    hipOccupancyMaxActiveBlocksPerMultiprocessor(&per_cu, mega_kernel, 256, LDS_BYTES);
    if (per_cu > 2) per_cu = 2;
    if (per_cu < 1) per_cu = 1;
    grid_blocks = cus * per_cu;
  }
  if (ws_size < WS_NEEDED) { fprintf(stderr, "workspace too small: %zu < %zu\n", ws_size, WS_NEEDED); return; }
  Params p{};
  for (int i = 0; i < 31; ++i) p.in[i] = (const float*)d_in[i];
  p.out = (float*)d_out;
  p.ws = (char*)d_ws;
#if MULTI_LAUNCH
  for (int ph = 0; ph < NPHASE; ++ph) {
    hipLaunchKernelGGL(mega_kernel, dim3(grid_blocks), dim3(256), LDS_BYTES, stream, p, ph, ph + 1);
  }
#else
  int lo = 0, hi = NPHASE;
  hipMemsetAsync((char*)d_ws + OFF_BAR, 0, 16384, stream);
  void* args[] = {&p, &lo, &hi};
  hipError_t e = hipLaunchCooperativeKernel((void*)mega_kernel, dim3(grid_blocks), dim3(256), args, LDS_BYTES, stream);
  if (e != hipSuccess) fprintf(stderr, "cooperative launch failed: %s (grid %d)\n", hipGetErrorString(e), grid_blocks);
#endif
}
```

```cpp
#include <hip/hip_runtime.h>
#include <hip/hip_cooperative_groups.h>
#include <cstdio>
namespace cg = cooperative_groups;

typedef unsigned short bfu;
using bf16x8 = __attribute__((ext_vector_type(8))) short;
using f32x4 = __attribute__((ext_vector_type(4))) float;
using u16x4 = __attribute__((ext_vector_type(4))) unsigned short;
using u16x8 = __attribute__((ext_vector_type(8))) unsigned short;
#define DI __device__ __forceinline__
#define MFMA16(a, b, c) __builtin_amdgcn_mfma_f32_16x16x32_bf16((a), (b), (c), 0, 0, 0)

#ifndef PH_MASK
#define PH_MASK 0xFFFFFF
#endif
#ifndef MULTI_LAUNCH
#define MULTI_LAUNCH 0
#endif

constexpr int TR = 32896;
constexpr int NCHK = 257;
constexpr int LBATCH = 16448;
constexpr int LDS_BYTES = 73728;
constexpr int NPL = 18;
constexpr int NPHASE = 1 + 4 * NPL + 1;

constexpr size_t OFF_H32 = 0;
constexpr size_t OFF_H16 = 134742016;
constexpr size_t OFF_Y = 202113024;
constexpr size_t OFF_P = 336855040;
constexpr size_t OFF_X = 471597056;
constexpr size_t OFF_SC = 623181824;
constexpr size_t OFF_PS = 627392512;
constexpr size_t OFF_W = 629497856;
constexpr size_t OFF_WIN = OFF_W;
constexpr size_t OFF_WS = OFF_WIN + 22020096;
constexpr size_t OFF_WGLU = OFF_WS + 32768;
constexpr size_t OFF_WB = OFF_WGLU + 1048576;
constexpr size_t OFF_WO = OFF_WB + 4194304;
constexpr size_t OFF_MS = OFF_WO + 2097152;
constexpr size_t OFF_MC = OFF_MS + 2097152;
constexpr size_t OFF_LB = OFF_MC + 6291456;
constexpr size_t OFF_LP = OFF_LB + 2048;
constexpr size_t OFF_BB = OFF_LP + 1114112;
constexpr size_t OFF_BAR = OFF_BB + 1048576;
constexpr size_t OFF_Z = OFF_BAR + 16384;
constexpr size_t WS_NEEDED = OFF_Z + 33685504;
constexpr size_t OFF_PZ = OFF_P;
constexpr size_t OFF_U2 = OFF_P + 33685504;
constexpr size_t OFF_YS5 = OFF_U2 + 35651584;
constexpr size_t OFF_XLOC = OFF_X;
constexpr size_t OFF_XST = OFF_X + 35651584;

struct Params {
  const float* in[31];
  float* out;
  char* ws;
};

extern __shared__ __attribute__((aligned(16))) char g_smem[];
DI int tid_laundered() { int t = threadIdx.x; asm volatile("" : "+v"(t)); return t; }
DI int bid_laundered() { int b = blockIdx.x; asm volatile("" : "+s"(b)); return b; }
#define TIDX tid_laundered()
#define BIDX bid_laundered()


DI bfu f2bf(float x) { unsigned u = __float_as_uint(x); u += 0x7fffu + ((u >> 16) & 1u); return (bfu)(u >> 16); }
DI float bf2f(bfu b) { return __uint_as_float(((unsigned)b) << 16); }
DI float sigm(float x) { return 1.f / (1.f + __expf(-x)); }
DI float siluf(float x) { return x / (1.f + __expf(-x)); }
DI float softplusf(float x) { return x > 20.f ? x : log1pf(expf(x)); }
DI float wave_sum(float v) {
#pragma unroll
  for (int m = 32; m >= 1; m >>= 1) v += __shfl_xor(v, m);
  return v;
}
DI float wave_scan_incl(float s, int lane) {
#pragma unroll
  for (int d = 1; d < 64; d <<= 1) { float o = __shfl_up(s, d); if (lane >= d) s += o; }
  return s;
}

template <int NREP>
DI void gemm_stage(const bfu* __restrict__ A, int lda, const bfu* __restrict__ Bt, int ldb, int kt, char* buf, int tid) {
#pragma unroll
  for (int i = 0; i < 2; ++i) {
    int b = tid * 16 + i * 4096; int r = b >> 6, c = (b & 63) >> 1;
    __builtin_amdgcn_global_load_lds((const unsigned*)(A + (long)r * lda + kt + c), (unsigned*)(buf + b), 16, 0, 0);
  }
#pragma unroll
  for (int i = 0; i < NREP / 2; ++i) {
    int b = tid * 16 + i * 4096; int r = b >> 6, c = (b & 63) >> 1;
    __builtin_amdgcn_global_load_lds((const unsigned*)(Bt + (long)r * ldb + kt + c), (unsigned*)(buf + 8192 + b), 16, 0, 0);
  }
}
template <int NREP>
DI void gemm_tile(f32x4 (&acc)[4][NREP], const bfu* __restrict__ A, int lda, const bfu* __restrict__ Bt, int ldb, int K) {
  const int tid = TIDX, lane = tid & 63, wid = tid >> 6, wr = wid >> 1, wc = wid & 1, fr = lane & 15, fq = lane >> 4;
  constexpr int GL = 2 + NREP / 2;
  const int nk = K >> 5;
  __syncthreads();
#pragma unroll
  for (int s = 0; s < 3; ++s)
    if (s < nk) gemm_stage<NREP>(A, lda, Bt, ldb, s * 32, g_smem + s * 16384, tid);
  for (int i = 0; i < nk; ++i) {
    const int younger = nk - 1 - i;
    if (younger >= 2) asm volatile("s_waitcnt vmcnt(%0)" ::"n"(2 * GL) : "memory");
    else if (younger == 1) asm volatile("s_waitcnt vmcnt(%0)" ::"n"(GL) : "memory");
    else asm volatile("s_waitcnt vmcnt(0)" ::: "memory");
    __builtin_amdgcn_s_barrier();
    if (i + 3 < nk) gemm_stage<NREP>(A, lda, Bt, ldb, (i + 3) * 32, g_smem + ((i + 3) & 3) * 16384, tid);
    const char* SA = g_smem + (i & 3) * 16384;
    const char* SB = SA + 8192;
    bf16x8 af[4], bfr[NREP];
#pragma unroll
    for (int m = 0; m < 4; ++m) af[m] = *(const bf16x8*)(SA + (wr * 64 + m * 16 + fr) * 64 + fq * 16);
#pragma unroll
    for (int n = 0; n < NREP; ++n) bfr[n] = *(const bf16x8*)(SB + (wc * (NREP * 16) + n * 16 + fr) * 64 + fq * 16);
#pragma unroll
    for (int m = 0; m < 4; ++m)
#pragma unroll
      for (int n = 0; n < NREP; ++n) acc[m][n] = MFMA16(af[m], bfr[n], acc[m][n]);
  }
}
template <int NREP>
DI void zero_acc(f32x4 (&acc)[4][NREP]) {
#pragma unroll
  for (int m = 0; m < 4; ++m)
#pragma unroll
    for (int n = 0; n < NREP; ++n) acc[m][n] = f32x4{0.f, 0.f, 0.f, 0.f};
}
#define ACC_FOREACH(NREP_, ...)                                                                \
  {                                                                                              \
    const int lane_ = TIDX & 63, wid_ = TIDX >> 6, wr_ = wid_ >> 1, wc_ = wid_ & 1; \
    const int fr_ = lane_ & 15, fq_ = lane_ >> 4;                                                \
    _Pragma("unroll") for (int m = 0; m < 4; ++m) _Pragma("unroll") for (int n = 0; n < NREP_; ++n) \
        _Pragma("unroll") for (int j = 0; j < 4; ++j) {                                          \
      const int trow = wr_ * 64 + m * 16 + fq_ * 4 + j;                                          \
      const int tcol = wc_ * (NREP_ * 16) + n * 16 + fr_;                                        \
      __VA_ARGS__                                                                                \
    }                                                                                            \
  }

DI void phase_tables(const Params& p) {
  const int gtid = BIDX * 256 + TIDX, gth = gridDim.x * 256;
  float2* LP = (float2*)(p.ws + OFF_LP);
  float2* BB = (float2*)(p.ws + OFF_BB);
  for (int idx = gtid; idx < 4 * 32 * 64; idx += gth) {
    int l = idx >> 11, g = (idx >> 6) & 31;
    float dt = expf(p.in[24][l * 32 + g]);
    float are = p.in[17][idx], aim = p.in[18][idx];
    float e1 = are * dt, a1 = aim * dt;
    for (int d = 0; d <= 16; ++d) {
      float mag = expf((float)d * e1), ang = (float)d * a1;
      LP[(long)idx * 17 + d] = make_float2(mag * cosf(ang), mag * sinf(ang));
    }
    float mag = expf(e1);
    float lre = mag * cosf(a1), lim = mag * sinf(a1);
    float den = are * are + aim * aim;
    float nr = lre - 1.f, ni = lim;
    float zre = (nr * are + ni * aim) / den, zim = (ni * are - nr * aim) / den;
    for (int c = 0; c < 16; ++c) {
      float bre = p.in[19][(long)idx * 16 + c], bim = p.in[20][(long)idx * 16 + c];
      BB[(long)idx * 16 + c] = make_float2(zre * bre - zim * bim, zre * bim + zim * bre);
    }
  }
}

DI void ln_rows(const Params& p, int layer, bool final_) {
  float* h32 = (float*)(p.ws + OFF_H32);
  bfu* h16 = (bfu*)(p.ws + OFF_H16);
  const int lane = TIDX & 63;
  const int gw = BIDX * 4 + (TIDX >> 6), nw = gridDim.x * 4;
  const float* gam = layer < 0 ? p.in[2] : p.in[29] + layer * 1024;
  const float* bet = layer < 0 ? p.in[3] : p.in[30] + layer * 1024;
  for (int r = gw; r < TR; r += nw) {
    int b = r / LBATCH, pos = r - b * LBATCH;
    float* d32 = h32 + (long)r * 1024;
    bfu* d16 = h16 + (long)r * 1024;
    if (pos < 48) {
      if (!final_) {
#pragma unroll
        for (int i = 0; i < 4; ++i) {
          *(float4*)(d32 + i * 256 + lane * 4) = make_float4(0.f, 0.f, 0.f, 0.f);
          *(u16x4*)(d16 + i * 256 + lane * 4) = u16x4{0, 0, 0, 0};
        }
      }
      continue;
    }
    const float* src;
    if (layer < 0) src = pos < 64 ? p.in[1] + (pos - 48) * 1024 : p.in[0] + ((long)b * 16384 + (pos - 64)) * 1024;
    else src = d32;
    float4 v[4];
    float s = 0.f;
#pragma unroll
    for (int i = 0; i < 4; ++i) { v[i] = *(const float4*)(src + i * 256 + lane * 4); s += v[i].x + v[i].y + v[i].z + v[i].w; }
    float mu = wave_sum(s) * (1.f / 1024.f);
    float q = 0.f;
#pragma unroll
    for (int i = 0; i < 4; ++i) {
      v[i].x -= mu; v[i].y -= mu; v[i].z -= mu; v[i].w -= mu;
      q += v[i].x * v[i].x + v[i].y * v[i].y + v[i].z * v[i].z + v[i].w * v[i].w;
    }
    float rs = rsqrtf(wave_sum(q) * (1.f / 1024.f) + 1e-5f);
#pragma unroll
    for (int i = 0; i < 4; ++i) {
      float4 g4 = *(const float4*)(gam + i * 256 + lane * 4), b4 = *(const float4*)(bet + i * 256 + lane * 4);
      float4 o = make_float4(v[i].x * rs * g4.x + b4.x, v[i].y * rs * g4.y + b4.y, v[i].z * rs * g4.z + b4.z, v[i].w * rs * g4.w + b4.w);
      if (final_) {
        if (pos >= 64) *(float4*)(p.out + ((long)b * 16384 + (pos - 64)) * 1024 + i * 256 + lane * 4) = o;
      } else {
        *(float4*)(d32 + i * 256 + lane * 4) = o;
        *(u16x4*)(d16 + i * 256 + lane * 4) = u16x4{f2bf(o.x), f2bf(o.y), f2bf(o.z), f2bf(o.w)};
      }
    }
  }
}

template <class F>
DI void conv_T(bfu* dst, int N, int K, F src) {
  const long gtid = BIDX * 256 + TIDX, gth = (long)gridDim.x * 256;
  const long total = (long)N * (K / 8);
  for (long idx = gtid; idx < total; idx += gth) {
    int n = (int)(idx % N); int kg = (int)(idx / N);
    u16x8 o;
#pragma unroll
    for (int j = 0; j < 8; ++j) o[j] = f2bf(src(kg * 8 + j, n));
    *(u16x8*)(dst + (long)n * K + kg * 8) = o;
  }
}

DI void phase_convert(const Params& p, int l) {
  const float* win = p.in[4] + (long)l * 1024 * 10768;
  conv_T((bfu*)(p.ws + OFF_WIN), 10752, 1024, [&](int k, int n) {
    int sc = n < 2048 ? n : n < 3584 ? n + 8 : n < 5632 ? n + 16 : n < 6656 ? n + 16 : n + 16;
    return win[(long)k * 10768 + sc];
  });
  conv_T((bfu*)(p.ws + OFF_WS), 16, 1024, [&](int k, int n) { int sc = n < 8 ? 2048 + n : 3592 + (n - 8); return win[(long)k * 10768 + sc]; });
  const float* w1 = p.in[25] + (long)l * 512 * 512;
  const float* w2 = p.in[26] + (long)l * 512 * 512;
  conv_T((bfu*)(p.ws + OFF_WGLU), 1024, 512, [&](int k, int r) {
    int j = r >> 7, wc = (r >> 6) & 1, n = (r >> 4) & 3, fr = r & 15;
    int oc = j * 64 + wc * 32 + (n & 1) * 16 + fr;
    return (n >> 1) ? w2[k * 512 + oc] : w1[k * 512 + oc];
  });
  const float* wb = p.in[27] + (long)l * 4 * 512 * 1024;
  conv_T((bfu*)(p.ws + OFF_WB), 4096, 512, [&](int k, int r) { int b = r >> 10, n = r & 1023; return wb[((long)b * 512 + k) * 1024 + n]; });
  const float* wo = p.in[28] + (long)l * 1024 * 1024;
  conv_T((bfu*)(p.ws + OFF_WO), 1024, 1024, [&](int k, int n) { return wo[(long)k * 1024 + n]; });
  const int gtid = BIDX * 256 + TIDX, gth = gridDim.x * 256;
  float* lbv = (float*)(p.ws + OFF_LB);
  for (int c = gtid; c < 512; c += gth) {
    float v0 = p.in[15][c], v1 = p.in[15][512 + c], v2 = p.in[15][1024 + c], v3 = p.in[15][1536 + c];
    float mx = fmaxf(fmaxf(v0, v1), fmaxf(v2, v3));
    float e0 = expf(v0 - mx), e1 = expf(v1 - mx), e2 = expf(v2 - mx), e3 = expf(v3 - mx);
    float inv = 1.f / (e0 + e1 + e2 + e3);
    float acc = 0.f;
    if (l >= 1) acc += e1 * inv;
    if (l >= 2) acc += e2 * inv;
    if (l >= 3) acc += e3 * inv;
    lbv[c] = acc;
  }
  const float2* LP = (const float2*)(p.ws + OFF_LP) + (long)l * 32 * 64 * 17;
  const float2* BB = (const float2*)(p.ws + OFF_BB) + (long)l * 32 * 64 * 16;
  const float* cre = p.in[21] + (long)l * 32 * 16 * 64;
  const float* cim = p.in[22] + (long)l * 32 * 16 * 64;
  const float* dd = p.in[23] + l * 512;
  bfu* Ms = (bfu*)(p.ws + OFF_MS);
  bfu* Mc = (bfu*)(p.ws + OFF_MC);
  for (int idx = gtid; idx < 32 * 128 * 256; idx += gth) {
    int g = idx >> 15, pp = (idx >> 8) & 127, kk = idx & 255;
    int s = kk >> 4, c2 = kk & 15, pr = pp & 63;
    float2 lp = LP[((long)g * 64 + pr) * 17 + (15 - s)];
    float2 bb = BB[((long)g * 64 + pr) * 16 + c2];
    float v = pp < 64 ? lp.x * bb.x - lp.y * bb.y : lp.x * bb.y + lp.y * bb.x;
    Ms[idx] = f2bf(v);
  }
  for (int idx = gtid; idx < 32 * 256 * 384; idx += gth) {
    int g = idx / (256 * 384); int rem = idx - g * (256 * 384);
    int o = rem / 384, kk = rem - o * 384;
    int t = o >> 4, c = o & 15;
    float v = 0.f;
    const float* cr = cre + ((long)g * 16 + c) * 64;
    const float* ci = cim + ((long)g * 16 + c) * 64;
    if (kk < 256) {
      int s = kk >> 4, c2 = kk & 15;
      if (t >= s) {
        int d = t - s;
        for (int pr = 0; pr < 64; ++pr) {
          float2 lp = LP[((long)g * 64 + pr) * 17 + d];
          float2 bb = BB[((long)g * 64 + pr) * 16 + c2];
          float ere = lp.x * bb.x - lp.y * bb.y, eim = lp.x * bb.y + lp.y * bb.x;
          v += cr[pr] * ere - ci[pr] * eim;
        }
        if (kk == o) v += dd[g * 16 + c];
      }
    } else {
      int pp = kk - 256, pr = pp & 63;
      float2 lp = LP[((long)g * 64 + pr) * 17 + (t + 1)];
      v = pp < 64 ? cr[pr] * lp.x - ci[pr] * lp.y : -(cr[pr] * lp.y + ci[pr] * lp.x);
    }
    Mc[idx] = f2bf(v);
  }
}

DI bool tile_map(int v, int ntn, int& tm, int& tn) {
  const int x = v & 7, j = v >> 3, sidx = j >> 5, within = j & 31, ntng = ntn >> 2;
  const int gq = sidx / ntng, tng = sidx - gq * ntng;
  tm = (gq * 8 + x) * 8 + (within >> 2);
  tn = tng * 4 + (within & 3);
  return tm < 257;
}
DI void phase_proj(const Params& p, int wrow0, int ncols, int mode, bool with_small, int boff, int nskip = 0) {
  const bfu* h16 = (const bfu*)(p.ws + OFF_H16);
  const bfu* WT = (const bfu*)(p.ws + OFF_WIN);
  bfu* P = (bfu*)(p.ws + OFF_P);
  bfu* U2 = (bfu*)(p.ws + OFF_U2);
  const int ntn = ncols >> 7;
  const int G = gridDim.x - boff - nskip;
  const int bsel = BIDX;
  if (nskip && bsel >= 256 && bsel < 256 + nskip) return;
  const int bidx = bsel - boff - ((nskip && bsel >= 256) ? nskip : 0);
  for (int v = bidx; v < 320 * ntn; v += G) {
    int tm, tn;
    if (!tile_map(v, ntn, tm, tn)) continue;
    {
      f32x4 acc[4][4];
      zero_acc<4>(acc);
      gemm_tile<4>(acc, h16 + (long)tm * 128 * 1024, 1024, WT + (long)(wrow0 + tn * 128) * 1024, 1024, 1024);
      if (mode == 0) {
        ACC_FOREACH(4, { P[(long)(tm * 128 + trow) * ncols + tn * 128 + tcol] = f2bf(acc[m][n][j]); })
      } else {
        ACC_FOREACH(4, {
          int row = tm * 128 + trow, col = tn * 128 + tcol;
          if (col < 512) { int g = col >> 4, c2 = col & 15; U2[((long)g * 2176 + (row >> 4)) * 256 + (row & 15) * 16 + c2] = f2bf(acc[m][n][j]); }
          else P[(long)row * 512 + (col - 512)] = f2bf(acc[m][n][j]);
        })
      }
    }
  }
  if (with_small) for (int tm = bidx; tm < 257; tm += G) {
    {
      const int lane = TIDX & 63, w = TIDX >> 6, fr = lane & 15, fq = lane >> 4;
      const bfu* WsT = (const bfu*)(p.ws + OFF_WS);
      float* Ps = (float*)(p.ws + OFF_PS);
      f32x4 a0 = {0.f, 0.f, 0.f, 0.f}, a1 = {0.f, 0.f, 0.f, 0.f};
      const bfu* pa0 = h16 + (long)(tm * 128 + w * 32 + fr) * 1024 + fq * 8;
      const bfu* pa1 = pa0 + 16 * 1024;
      const bfu* pb = WsT + fr * 1024 + fq * 8;
      for (int k = 0; k < 1024; k += 32) {
        bf16x8 x0 = *(const bf16x8*)(pa0 + k), x1 = *(const bf16x8*)(pa1 + k), y = *(const bf16x8*)(pb + k);
        a0 = MFMA16(x0, y, a0);
        a1 = MFMA16(x1, y, a1);
      }
#pragma unroll
      for (int j = 0; j < 4; ++j) {
        Ps[(long)(tm * 128 + w * 32 + fq * 4 + j) * 16 + fr] = a0[j];
        Ps[(long)(tm * 128 + w * 32 + 16 + fq * 4 + j) * 16 + fr] = a1[j];
      }
    }
  }
}

DI void copy_z(const Params& p, const bfu* src, int sld, bfu* dst, int pieces_per_row) {
  const int tid = TIDX;
  const int total = 64 * pieces_per_row;
  for (int i = tid; i < total; i += 256) {
    int r = i / pieces_per_row, c = i - r * pieces_per_row;
    *(u16x8*)(dst + (long)r * 512 + c * 8) = *(const u16x8*)(src + (long)r * sld + c * 8);
  }
}
DI void gdn_prep_item(const Params& p, int layer, int item) {
  const int tid = TIDX, lane = tid & 63, w = tid >> 6, fr = lane & 15, fq = lane >> 4;
  const int h = item & 3, cn = item >> 2, n = cn % NCHK;
  const long r0 = (long)cn * 64;
  const bfu* P = (const bfu*)(p.ws + OFF_P);
  const float* Ps = (const float*)(p.ws + OFF_PS);
  bfu* Xb = (bfu*)(p.ws + OFF_X) + (long)item * 36864;
  float* SC = (float*)(p.ws + OFF_SC) + (long)item * 256;
  bfu* rawQ = (bfu*)g_smem;
  bfu* rawK = rawQ + 64 * 136;
  bfu* rawV = rawK + 64 * 136;
  float* aL = (float*)(g_smem + 52224);
  float* sm = (float*)(g_smem + 69632);
  const float* cw = p.in[5] + layer * 4 * 1536;
  copy_z(p, P + r0 * 2048 + 1536 + h * 128, 2048, (bfu*)(p.ws + OFF_Z) + r0 * 512 + h * 128, 16);
  if (w < 3) {
    const int cgp = tid % 48, seg = tid / 48;
    const int which = cgp >> 4, c8 = (cgp & 15) * 8;
    const int col = which * 512 + h * 128 + c8;
    const int t0 = seg * 16;
    u16x8 xr[19];
    const bool nohist = (seg == 0 && n == 0);
#pragma unroll
    for (int i = 0; i < 19; ++i) {
      const bool valid = !(nohist && i < 3);
      const long rr = valid ? (r0 + t0 - 3 + i) : r0;
      u16x8 v = *(const u16x8*)(P + rr * 2048 + col);
      xr[i] = valid ? v : u16x8{0, 0, 0, 0, 0, 0, 0, 0};
    }
    float wt[4][8];
#pragma unroll
    for (int j = 0; j < 4; ++j) {
      float4 a4 = *(const float4*)(cw + j * 1536 + col), b4 = *(const float4*)(cw + j * 1536 + col + 4);
      wt[j][0] = a4.x; wt[j][1] = a4.y; wt[j][2] = a4.z; wt[j][3] = a4.w; wt[j][4] = b4.x; wt[j][5] = b4.y; wt[j][6] = b4.z; wt[j][7] = b4.w;
    }
    bfu* dst = rawQ + which * (64 * 136) + c8;
#pragma unroll
    for (int r = 0; r < 16; ++r) {
      u16x8 o;
#pragma unroll
      for (int c = 0; c < 8; ++c) {
        float v = wt[0][c] * bf2f(xr[r][c]) + wt[1][c] * bf2f(xr[r + 1][c]) + wt[2][c] * bf2f(xr[r + 2][c]) + wt[3][c] * bf2f(xr[r + 3][c]);
        o[c] = f2bf(siluf(v));
      }
      *(u16x8*)(dst + (t0 + r) * 136) = o;
    }
  }
  if (w == 3) {
    const float* ps = Ps + (r0 + lane) * 16;
    float be = sigm(ps[h]);
    float gl = -__expf(p.in[6][layer * 4 + h]) * softplusf(ps[4 + h] + p.in[7][layer * 4 + h]);
    float s = wave_scan_incl(gl, lane);
    sm[128 + lane] = be;
    sm[192 + lane] = s;
  }
  __syncthreads();
  if (tid < 128) {
    int row = tid & 63, mat = tid >> 6;
    const bfu* rp = rawQ + mat * (64 * 136) + row * 136;
    float ss = 0.f;
    for (int c = 0; c < 128; ++c) { float v = bf2f(rp[c]); ss += v * v; }
    float sc = rsqrtf(ss + 1e-6f);
    if (mat == 0) sc *= 0.08838834764831845f;
    sm[mat * 64 + row] = sc;
  }
  __syncthreads();
  if (tid < 64) { float be = sm[128 + tid]; sm[256 + tid] = be; sm[320 + tid] = be * sm[64 + tid] * __expf(sm[192 + tid]); }
  {
    bf16x8 kf[4], qf[4];
#pragma unroll
    for (int ks = 0; ks < 4; ++ks) {
      kf[ks] = *(const bf16x8*)(rawK + (16 * w + fr) * 136 + ks * 32 + fq * 8);
      qf[ks] = *(const bf16x8*)(rawQ + (16 * w + fr) * 136 + ks * 32 + fq * 8);
    }
    bfu* AMg = Xb + 32768;
    for (int tj = 0; tj < 4; ++tj) {
      if (tj <= w) {
        f32x4 akk = {0.f, 0.f, 0.f, 0.f}, aqk = {0.f, 0.f, 0.f, 0.f};
#pragma unroll
        for (int ks = 0; ks < 4; ++ks) {
          bf16x8 bk = *(const bf16x8*)(rawK + (16 * tj + fr) * 136 + ks * 32 + fq * 8);
          akk = MFMA16(kf[ks], bk, akk);
          aqk = MFMA16(qf[ks], bk, aqk);
        }
        int j = 16 * tj + fr;
        float rkj = sm[64 + j], gcj = sm[192 + j];
#pragma unroll
        for (int r = 0; r < 4; ++r) {
          int i = 16 * w + fq * 4 + r;
          float dec = (i >= j) ? __expf(sm[192 + i] - gcj) : 0.f;
          aL[i * 68 + j] = (i > j) ? sm[128 + i] * sm[64 + i] * rkj * akk[r] * dec : 0.f;
          AMg[i * 64 + j] = f2bf((i >= j) ? sm[i] * rkj * aqk[r] * dec : 0.f);
        }
      } else {
#pragma unroll
        for (int r = 0; r < 4; ++r) AMg[(16 * w + fq * 4 + r) * 64 + 16 * tj + fr] = 0;
      }
    }
  }
  __syncthreads();
  {
    const bfu* src = (tid < 128) ? (rawV + tid) : (rawK + (tid - 128));
    const float* rs = sm + ((tid < 128) ? 256 : 320);
    float x[64];
#pragma unroll
    for (int i = 0; i < 64; ++i) {
      float a = bf2f(src[i * 136]) * rs[i];
#pragma unroll
      for (int j = 0; j < i; ++j) a -= aL[i * 68 + j] * x[j];
      x[i] = a;
    }
    if (tid < 128) {
      bfu* UT = Xb + 24576 + tid * 64;
#pragma unroll
      for (int i = 0; i < 64; i += 8) {
        u16x8 o;
#pragma unroll
        for (int j = 0; j < 8; ++j) o[j] = f2bf(x[i + j]);
        *(u16x8*)(UT + i) = o;
      }
    } else {
      bfu* Wg = Xb + 8192 + (tid - 128);
#pragma unroll
      for (int i = 0; i < 64; ++i) Wg[i * 128] = f2bf(x[i]);
    }
  }
  {
    bfu* QDg = Xb;
    bfu* KDTg = Xb + 16384;
    float gl_last = sm[192 + 63];
    for (int idx = tid; idx < 8192; idx += 256) { int i = idx >> 7, c = idx & 127; QDg[idx] = f2bf(bf2f(rawQ[i * 136 + c]) * sm[i] * __expf(sm[192 + i])); }
    for (int idx = tid; idx < 8192; idx += 256) { int c = idx >> 6, i = idx & 63; KDTg[idx] = f2bf(bf2f(rawK[i * 136 + c]) * sm[64 + i] * __expf(gl_last - sm[192 + i])); }
    if (tid < 128) SC[128 + tid] = __expf(gl_last);
  }
  __syncthreads();
}

DI void ssd_prep_item(const Params& p, int layer, int item) {
  const int tid = TIDX, lane = tid & 63, w = tid >> 6, fr = lane & 15, fq = lane >> 4;
  const int g = item & 1, cn = item >> 1, n = cn % NCHK;
  const long r0 = (long)cn * 64;
  const bfu* P = (const bfu*)(p.ws + OFF_P);
  const float* Ps = (const float*)(p.ws + OFF_PS);
  bfu* Xb = (bfu*)(p.ws + OFF_X) + (long)cn * 131072;
  float* SCb = (float*)(p.ws + OFF_SC) + (long)cn * 8 * 256;
  bfu* Bm = (bfu*)g_smem;
  bfu* Cm = Bm + 64 * 136;
  float* cb = (float*)(g_smem + 34816);
  float* sm = (float*)(g_smem + 34816 + 17408);
  {
    int hd = g * 4 + w;
    float dtv = softplusf(Ps[(r0 + lane) * 16 + 8 + hd] + p.in[11][layer * 8 + hd]);
    float a = -dtv * __expf(p.in[12][layer * 8 + hd]);
    float ac = wave_scan_incl(a, lane);
    sm[w * 64 + lane] = dtv;
    sm[256 + w * 64 + lane] = ac;
  }
  __syncthreads();
  const float* cw = p.in[9] + layer * 4 * 1024;
  const float* cbias = p.in[10] + layer * 1024;
  copy_z(p, P + r0 * 1536 + 1024 + g * 256, 1536, (bfu*)(p.ws + OFF_Z) + r0 * 512 + g * 256, 32);
  {
    const int cg8 = tid & 63, seg = tid >> 6, t0 = seg * 16;
    const int col = (cg8 < 16) ? 512 + g * 128 + cg8 * 8 : (cg8 < 32) ? 768 + g * 128 + (cg8 - 16) * 8 : g * 256 + (cg8 - 32) * 8;
    u16x8 xr[19];
    const bool nohist = (seg == 0 && n == 0);
#pragma unroll
    for (int i = 0; i < 19; ++i) {
      const bool valid = !(nohist && i < 3);
      const long rr = valid ? (r0 + t0 - 3 + i) : r0;
      u16x8 v = *(const u16x8*)(P + rr * 1536 + col);
      xr[i] = valid ? v : u16x8{0, 0, 0, 0, 0, 0, 0, 0};
    }
    float wt[4][8], bias[8];
#pragma unroll
    for (int j = 0; j < 4; ++j) {
      float4 a4 = *(const float4*)(cw + j * 1024 + col), b4 = *(const float4*)(cw + j * 1024 + col + 4);
      wt[j][0] = a4.x; wt[j][1] = a4.y; wt[j][2] = a4.z; wt[j][3] = a4.w; wt[j][4] = b4.x; wt[j][5] = b4.y; wt[j][6] = b4.z; wt[j][7] = b4.w;
    }
    {
      float4 a4 = *(const float4*)(cbias + col), b4 = *(const float4*)(cbias + col + 4);
      bias[0] = a4.x; bias[1] = a4.y; bias[2] = a4.z; bias[3] = a4.w; bias[4] = b4.x; bias[5] = b4.y; bias[6] = b4.z; bias[7] = b4.w;
    }
    if (cg8 < 32) {
      bfu* dst = (cg8 < 16) ? (Bm + cg8 * 8) : (Cm + (cg8 - 16) * 8);
#pragma unroll
      for (int r = 0; r < 16; ++r) {
        u16x8 o;
        const bool padrow = (n == 0 && t0 + r < 48);
#pragma unroll
        for (int c = 0; c < 8; ++c) {
          float v = wt[0][c] * bf2f(xr[r][c]) + wt[1][c] * bf2f(xr[r + 1][c]) + wt[2][c] * bf2f(xr[r + 2][c]) + wt[3][c] * bf2f(xr[r + 3][c]) + bias[c];
          o[c] = padrow ? (bfu)0 : f2bf(siluf(v));
        }
        *(u16x8*)(dst + (t0 + r) * 136) = o;
      }
    } else {
      const int hh = (cg8 - 32) >> 3, pp8 = ((cg8 - 32) & 7) * 8;
      bfu* vtb = Xb + 32768 + (g * 4 + hh) * 12288 + 4096;
      const float alast = sm[256 + hh * 64 + 63];
#pragma unroll
      for (int q4 = 0; q4 < 4; ++q4) {
        float dtv[4], ksv[4];
#pragma unroll
        for (int rr = 0; rr < 4; ++rr) {
          int t = t0 + q4 * 4 + rr;
          const bool padrow = (n == 0 && t < 48);
          dtv[rr] = padrow ? 0.f : sm[hh * 64 + t];
          ksv[rr] = __expf(alast - sm[256 + hh * 64 + t]);
        }
#pragma unroll
        for (int c = 0; c < 8; ++c) {
          u16x4 oa, ob;
#pragma unroll
          for (int rr = 0; rr < 4; ++rr) {
            int r = q4 * 4 + rr;
            float v = wt[0][c] * bf2f(xr[r][c]) + wt[1][c] * bf2f(xr[r + 1][c]) + wt[2][c] * bf2f(xr[r + 2][c]) + wt[3][c] * bf2f(xr[r + 3][c]) + bias[c];
            float xd = siluf(v) * dtv[rr];
            oa[rr] = f2bf(xd);
            ob[rr] = f2bf(xd * ksv[rr]);
          }
          *(u16x4*)(vtb + (pp8 + c) * 64 + t0 + q4 * 4) = oa;
          *(u16x4*)(vtb + 4096 + (pp8 + c) * 64 + t0 + q4 * 4) = ob;
        }
      }
    }
  }
  __syncthreads();
  {
    bf16x8 cf[4];
#pragma unroll
    for (int ks = 0; ks < 4; ++ks) cf[ks] = *(const bf16x8*)(Cm + (16 * w + fr) * 136 + ks * 32 + fq * 8);
    for (int tj = 0; tj < 4; ++tj) {
      if (tj <= w) {
        f32x4 a = {0.f, 0.f, 0.f, 0.f};
#pragma unroll
        for (int ks = 0; ks < 4; ++ks) {
          bf16x8 bk = *(const bf16x8*)(Bm + (16 * tj + fr) * 136 + ks * 32 + fq * 8);
          a = MFMA16(cf[ks], bk, a);
        }
#pragma unroll
        for (int r = 0; r < 4; ++r) cb[(16 * w + fq * 4 + r) * 68 + 16 * tj + fr] = a[r];
      }
    }
    bfu* Cg = Xb + g * 16384;
    bfu* BTg = Cg + 8192;
    for (int idx = tid; idx < 8192; idx += 256) Cg[idx] = Cm[(idx >> 7) * 136 + (idx & 127)];
    for (int idx = tid; idx < 8192; idx += 256) BTg[idx] = Bm[(idx & 63) * 136 + (idx >> 6)];
  }
  __syncthreads();
  for (int hh = 0; hh < 4; ++hh) {
    int hd = g * 4 + hh;
    bfu* AMg = Xb + 32768 + hd * 12288;
    float Dh = p.in[13][layer * 8 + hd];
    const float* dtp = sm + hh * 64;
    const float* acp = sm + 256 + hh * 64;
    for (int idx = tid; idx < 4096; idx += 256) {
      int l = idx >> 6, m = idx & 63;
      float v = (m <= l) ? cb[l * 68 + m] * __expf(acp[l] - acp[m]) : 0.f;
      if (m == l) v += Dh / dtp[l];
      AMg[idx] = f2bf(v);
    }
    float* sc = SCb + hd * 256;
    float alast = acp[63];
    if (tid < 64) { sc[tid] = __expf(acp[tid]); sc[64 + tid] = __expf(alast - acp[tid]); }
    else if (tid < 192) sc[128 + (tid - 64)] = __expf(alast);
  }
  __syncthreads();
}

DI void hg_prep_item(const Params& p, int layer, int item) {
  const int tid = TIDX, lane = tid & 63, w = tid >> 6, fr = lane & 15, fq = lane >> 4;
  const int h = item & 3, cn = item >> 2;
  const long r0 = (long)cn * 64;
  const bfu* P = (const bfu*)(p.ws + OFF_P);
  const float* lbv = (const float*)(p.ws + OFF_LB);
  bfu* Xb = (bfu*)(p.ws + OFF_X) + (long)item * 28672;
  float* SC = (float*)(p.ws + OFF_SC) + (long)item * 256;
  bfu* Qall = (bfu*)g_smem;
  bfu* Ks = Qall + 160 * 136;
  float* segs = (float*)(g_smem + 60928);
  bfu* QDg = Xb;
  bfu* KDTg = Xb + 8192;
  bfu* AMg = Xb + 16384;
  bfu* VTg = Xb + 20480;
  copy_z(p, P + r0 * 2048 + 1536 + h * 128, 2048, (bfu*)(p.ws + OFF_Z) + r0 * 512 + h * 128, 16);
  {
    const int k8 = (tid & 15) * 8, rs = tid >> 4, t0 = rs * 4;
    u16x8 fr4[4], qr4[4], ir4[4];
    const bfu* base = P + (r0 + t0) * 2048 + h * 128 + k8;
#pragma unroll
    for (int r = 0; r < 4; ++r) {
      qr4[r] = *(const u16x8*)(base + (long)r * 2048);
      fr4[r] = *(const u16x8*)(base + (long)r * 2048 + 512);
      ir4[r] = *(const u16x8*)(base + (long)r * 2048 + 1024);
    }
    float lb[8];
    {
      float4 a4 = *(const float4*)(lbv + h * 128 + k8), b4 = *(const float4*)(lbv + h * 128 + k8 + 4);
      lb[0] = a4.x; lb[1] = a4.y; lb[2] = a4.z; lb[3] = a4.w; lb[4] = b4.x; lb[5] = b4.y; lb[6] = b4.z; lb[7] = b4.w;
    }
    float lf[4][8];
    float ssum[8];
#pragma unroll
    for (int c = 0; c < 8; ++c) ssum[c] = 0.f;
#pragma unroll
    for (int r = 0; r < 4; ++r)
#pragma unroll
      for (int c = 0; c < 8; ++c) {
        float zf = bf2f(fr4[r][c]);
        float f = lb[c] + (1.f - lb[c]) * (1.f / (1.f + __expf(-zf)));
        lf[r][c] = __logf(f);
        ssum[c] += lf[r][c];
      }
    *(float4*)(segs + rs * 128 + k8) = make_float4(ssum[0], ssum[1], ssum[2], ssum[3]);
    *(float4*)(segs + rs * 128 + k8 + 4) = make_float4(ssum[4], ssum[5], ssum[6], ssum[7]);
#pragma unroll
    for (int c = 0; c < 8; ++c) {
      u16x4 o = {ir4[0][c], ir4[1][c], ir4[2][c], ir4[3][c]};
      *(u16x4*)(VTg + (k8 + c) * 64 + t0) = o;
    }
    __syncthreads();
    float Gb[8], G1[8], G2[8], G3[8], GL[8];
#pragma unroll
    for (int c = 0; c < 8; ++c) { Gb[c] = 0.f; G1[c] = 0.f; G2[c] = 0.f; G3[c] = 0.f; GL[c] = 0.f; }
    for (int s2 = 0; s2 < 16; ++s2) {
      float4 a4 = *(const float4*)(segs + s2 * 128 + k8), b4 = *(const float4*)(segs + s2 * 128 + k8 + 4);
      float v[8] = {a4.x, a4.y, a4.z, a4.w, b4.x, b4.y, b4.z, b4.w};
#pragma unroll
      for (int c = 0; c < 8; ++c) {
        if (s2 < rs) Gb[c] += v[c];
        if (s2 < 4) G1[c] += v[c];
        if (s2 < 8) G2[c] += v[c];
        if (s2 < 12) G3[c] += v[c];
        GL[c] += v[c];
      }
    }
    const int Jt = rs >> 2;
    float G[8];
#pragma unroll
    for (int c = 0; c < 8; ++c) G[c] = Gb[c];
#pragma unroll
    for (int r = 0; r < 4; ++r) {
      const int t = t0 + r;
      u16x8 oq, oq1, oq2, oq3, ok;
#pragma unroll
      for (int c = 0; c < 8; ++c) {
        G[c] += lf[r][c];
        float zf = bf2f(fr4[r][c]);
        float kk = (1.f - lb[c]) * (1.f / (1.f + __expf(zf)));
        float q = siluf(bf2f(qr4[r][c]));
        oq[c] = f2bf(q * __expf(G[c]));
        oq1[c] = f2bf(q * __expf(G[c] - G1[c]));
        oq2[c] = f2bf(q * __expf(G[c] - G2[c]));
        oq3[c] = f2bf(q * __expf(G[c] - G3[c]));
        float GJ = (Jt == 0) ? 0.f : (Jt == 1) ? G1[c] : (Jt == 2) ? G2[c] : G3[c];
        ok[c] = f2bf(kk * __expf(fminf(GJ - G[c], 80.f)));
      }
      *(u16x8*)(QDg + t * 128 + k8) = oq;
      *(u16x8*)(Qall + t * 136 + k8) = oq;
      if (t >= 16) *(u16x8*)(Qall + (64 + t - 16) * 136 + k8) = oq1;
      if (t >= 32) *(u16x8*)(Qall + (112 + t - 32) * 136 + k8) = oq2;
      if (t >= 48) *(u16x8*)(Qall + (144 + t - 48) * 136 + k8) = oq3;
      *(u16x8*)(Ks + t * 136 + k8) = ok;
    }
#pragma unroll
    for (int c = 0; c < 8; ++c) {
      float Gc = Gb[c];
      u16x4 o;
#pragma unroll
      for (int r = 0; r < 4; ++r) {
        Gc += lf[r][c];
        float zf = bf2f(fr4[r][c]);
        float kk = (1.f - lb[c]) * (1.f / (1.f + __expf(zf)));
        o[r] = f2bf(kk * __expf(GL[c] - Gc));
      }
      *(u16x4*)(KDTg + (k8 + c) * 64 + t0) = o;
    }
    if (rs == 0) {
#pragma unroll
      for (int c = 0; c < 8; ++c) SC[128 + k8 + c] = __expf(GL[c]);
    }
  }
  __syncthreads();
  for (int J = 0; J < 4; ++J) {
    if (J <= w) {
      int rowbase = (J == 0 ? 0 : J == 1 ? 64 : J == 2 ? 112 : 144) + 16 * (w - J);
      f32x4 a = {0.f, 0.f, 0.f, 0.f};
#pragma unroll
      for (int ks = 0; ks < 4; ++ks) {
        bf16x8 af = *(const bf16x8*)(Qall + (rowbase + fr) * 136 + ks * 32 + fq * 8);
        bf16x8 bk = *(const bf16x8*)(Ks + (16 * J + fr) * 136 + ks * 32 + fq * 8);
        a = MFMA16(af, bk, a);
      }
#pragma unroll
      for (int r = 0; r < 4; ++r) {
        int t = 16 * w + fq * 4 + r, s = 16 * J + fr;
        AMg[t * 64 + s] = f2bf((s <= t) ? a[r] : 0.f);
      }
    } else {
#pragma unroll
      for (int r = 0; r < 4; ++r) AMg[(16 * w + fq * 4 + r) * 64 + 16 * J + fr] = 0;
    }
  }
  __syncthreads();
}

struct LinArgs {
  const bfu* kdt; long kdt_cs;
  const bfu* vt; long vt_cs;
  const float* sc; long sc_cs;
  bfu* ss; long ss_cs;
  int kt0;
};
struct LinFrags { bf16x8 kf[2]; bf16x8 vf[2]; f32x4 dv; };
DI void lin_load(LinFrags& f, const LinArgs& e, int n, int w, int fr, int fq) {
#pragma unroll
  for (int ks = 0; ks < 2; ++ks) f.kf[ks] = *(const bf16x8*)(e.kdt + n * e.kdt_cs + ((e.kt0 + w) * 16 + fr) * 64 + ks * 32 + fq * 8);
#pragma unroll
  for (int ks = 0; ks < 2; ++ks) f.vf[ks] = *(const bf16x8*)(e.vt + n * e.vt_cs + fr * 64 + ks * 32 + fq * 8);
  f.dv = *(const f32x4*)(e.sc + n * e.sc_cs + 128 + (e.kt0 + w) * 16 + fq * 4);
}
template <int NST>
DI void engine_lin(const LinArgs& e) {
  const int tid = TIDX, lane = tid & 63, w = tid >> 6, fr = lane & 15, fq = lane >> 4;
  f32x4 S = f32x4{0.f, 0.f, 0.f, 0.f};
  LinFrags f[NST];
#pragma unroll
  for (int s = 0; s < NST - 1; ++s) lin_load(f[s], e, s, w, fr, fq);
  for (int n0 = 0; n0 < NCHK; n0 += NST) {
#pragma unroll
    for (int s = 0; s < NST; ++s) {
      const int n = n0 + s;
      if (n < NCHK) {
        int nl = n + NST - 1; if (nl > NCHK - 1) nl = NCHK - 1;
        lin_load(f[(s + NST - 1) % NST], e, nl, w, fr, fq);
        const LinFrags& c = f[s];
        u16x4 pk = {f2bf(S[0]), f2bf(S[1]), f2bf(S[2]), f2bf(S[3])};
        *(u16x4*)(e.ss + n * e.ss_cs + fr * 128 + (e.kt0 + w) * 16 + fq * 4) = pk;
#pragma unroll
        for (int r = 0; r < 4; ++r) S[r] *= c.dv[r];
#pragma unroll
        for (int ks = 0; ks < 2; ++ks) S = MFMA16(c.kf[ks], c.vf[ks], S);
      }
    }
  }
}

struct GdnArgs {
  const bfu* w; const bfu* kdt; bfu* ut; long cs;
  const float* sc; long sc_cs;
  bfu* ss; long ss_cs;
};
template <int NVT> struct GdnFrags { bf16x8 wf[4]; bf16x8 kf[2][2]; u16x4 v[NVT]; float dv; };
template <int NVT>
DI void gdn_load(GdnFrags<NVT>& f, const GdnArgs& e, int n, int w, int fr, int fq) {
#pragma unroll
  for (int ks = 0; ks < 4; ++ks) f.wf[ks] = *(const bf16x8*)(e.w + n * e.cs + (16 * w + fr) * 128 + ks * 32 + fq * 8);
#pragma unroll
  for (int a = 0; a < 2; ++a)
#pragma unroll
    for (int ks = 0; ks < 2; ++ks) f.kf[a][ks] = *(const bf16x8*)(e.kdt + n * e.cs + ((2 * w + a) * 16 + fr) * 64 + ks * 32 + fq * 8);
#pragma unroll
  for (int jv = 0; jv < NVT; ++jv) f.v[jv] = *(const u16x4*)(e.ut + n * e.cs + (jv * 16 + fr) * 64 + 16 * w + fq * 4);
  f.dv = e.sc[n * e.sc_cs + 128];
}
template <int NST, int NVT>
DI void engine_gdn(const GdnArgs& e) {
  const int tid = TIDX, lane = tid & 63, w = tid >> 6, fr = lane & 15, fq = lane >> 4;
  char* VT = g_smem + 17408;
  f32x4 S[2][NVT];
#pragma unroll
  for (int a = 0; a < 2; ++a)
#pragma unroll
    for (int jv = 0; jv < NVT; ++jv) S[a][jv] = f32x4{0.f, 0.f, 0.f, 0.f};
  GdnFrags<NVT> f[NST];
#pragma unroll
  for (int s = 0; s < NST - 1; ++s) gdn_load<NVT>(f[s], e, s, w, fr, fq);
  for (int n0 = 0; n0 < NCHK; n0 += NST) {
#pragma unroll
    for (int s = 0; s < NST; ++s) {
      const int n = n0 + s;
      if (n < NCHK) {
        int nl = n + NST - 1; if (nl > NCHK - 1) nl = NCHK - 1;
        gdn_load<NVT>(f[(s + NST - 1) % NST], e, nl, w, fr, fq);
        const GdnFrags<NVT>& c = f[s];
        char* STc = g_smem + (n & 1) * 8704;
#pragma unroll
        for (int a = 0; a < 2; ++a)
#pragma unroll
          for (int jv = 0; jv < NVT; ++jv) {
            u16x4 pk = {f2bf(S[a][jv][0]), f2bf(S[a][jv][1]), f2bf(S[a][jv][2]), f2bf(S[a][jv][3])};
            *(u16x4*)(STc + ((jv * 16 + fr) * 136 + (2 * w + a) * 16 + fq * 4) * 2) = pk;
            *(u16x4*)(e.ss + n * e.ss_cs + (jv * 16 + fr) * 128 + (2 * w + a) * 16 + fq * 4) = pk;
          }
        __syncthreads();
        f32x4 av[NVT];
#pragma unroll
        for (int jv = 0; jv < NVT; ++jv) av[jv] = f32x4{0.f, 0.f, 0.f, 0.f};
#pragma unroll
        for (int ks = 0; ks < 4; ++ks)
#pragma unroll
          for (int jv = 0; jv < NVT; ++jv) {
            bf16x8 sf = *(const bf16x8*)(STc + ((jv * 16 + fr) * 136 + ks * 32 + fq * 8) * 2);
            av[jv] = MFMA16(c.wf[ks], sf, av[jv]);
          }
#pragma unroll
        for (int jv = 0; jv < NVT; ++jv) {
          u16x4 pk;
#pragma unroll
          for (int r = 0; r < 4; ++r) pk[r] = f2bf(bf2f(c.v[jv][r]) - av[jv][r]);
          *(u16x4*)(VT + ((jv * 16 + fr) * 72 + 16 * w + fq * 4) * 2) = pk;
          *(u16x4*)(e.ut + n * e.cs + (jv * 16 + fr) * 64 + 16 * w + fq * 4) = pk;
        }
        __syncthreads();
#pragma unroll
        for (int a = 0; a < 2; ++a) {
#pragma unroll
          for (int jv = 0; jv < NVT; ++jv)
#pragma unroll
            for (int r = 0; r < 4; ++r) S[a][jv][r] *= c.dv;
#pragma unroll
          for (int ks = 0; ks < 2; ++ks)
#pragma unroll
            for (int jv = 0; jv < NVT; ++jv) {
              bf16x8 vf = *(const bf16x8*)(VT + ((jv * 16 + fr) * 72 + ks * 32 + fq * 8) * 2);
              S[a][jv] = MFMA16(c.kf[a][ks], vf, S[a][jv]);
            }
        }
      }
    }
  }
  __syncthreads();
}

template <int NVT, bool USE_RS>
DI void oproj_core(f32x4 (&acc)[NVT], const bfu* qd, const bfu* am, const bfu* st, const bfu* vt, const float* rsp, int w, int fr, int fq) {
#pragma unroll
  for (int jv = 0; jv < NVT; ++jv) acc[jv] = f32x4{0.f, 0.f, 0.f, 0.f};
#pragma unroll
  for (int ks = 0; ks < 4; ++ks) {
    bf16x8 qf = *(const bf16x8*)(qd + (16 * w + fr) * 128 + ks * 32 + fq * 8);
#pragma unroll
    for (int jv = 0; jv < NVT; ++jv) {
      bf16x8 sf = *(const bf16x8*)(st + (jv * 16 + fr) * 128 + ks * 32 + fq * 8);
      acc[jv] = MFMA16(qf, sf, acc[jv]);
    }
  }
  if (USE_RS) {
    f32x4 rs = *(const f32x4*)(rsp + 16 * w + fq * 4);
#pragma unroll
    for (int jv = 0; jv < NVT; ++jv)
#pragma unroll
      for (int r = 0; r < 4; ++r) acc[jv][r] *= rs[r];
  }
#pragma unroll
  for (int ks = 0; ks < 2; ++ks) {
    bf16x8 af = *(const bf16x8*)(am + (16 * w + fr) * 64 + ks * 32 + fq * 8);
#pragma unroll
    for (int jv = 0; jv < NVT; ++jv) {
      bf16x8 vf = *(const bf16x8*)(vt + (jv * 16 + fr) * 64 + ks * 32 + fq * 8);
      acc[jv] = MFMA16(af, vf, acc[jv]);
    }
  }
}
DI void oproj_head128(const bfu* qd, const bfu* am, const bfu* st, const bfu* vt, const bfu* zP, int zld, const float* nw, bfu* Yo) {
  const int tid = TIDX, lane = tid & 63, w = tid >> 6, fr = lane & 15, fq = lane >> 4;
  const int row = 16 * w + (lane >> 2), q = lane & 3;
  u16x8 zr[4];
#pragma unroll
  for (int i = 0; i < 4; ++i) zr[i] = *(const u16x8*)(zP + (long)row * zld + q * 32 + i * 8);
  f32x4 acc[8];
  oproj_core<8, false>(acc, qd, am, st, vt, nullptr, w, fr, fq);
  float* T = (float*)g_smem;
#pragma unroll
  for (int jv = 0; jv < 8; ++jv)
#pragma unroll
    for (int r = 0; r < 4; ++r) T[(16 * w + fq * 4 + r) * 132 + jv * 16 + fr] = acc[jv][r];
  float o[32];
  float ss = 0.f;
#pragma unroll
  for (int i = 0; i < 8; ++i) {
    f32x4 v = *(const f32x4*)(T + row * 132 + q * 32 + i * 4);
#pragma unroll
    for (int j = 0; j < 4; ++j) { o[i * 4 + j] = v[j]; ss += v[j] * v[j]; }
  }
  ss += __shfl_xor(ss, 1); ss += __shfl_xor(ss, 2);
  const float rs = rsqrtf(ss * (1.f / 128.f) + 1e-6f);
#pragma unroll
  for (int i = 0; i < 4; ++i) {
    u16x8 res;
    f32x4 w0 = *(const f32x4*)(nw + q * 32 + i * 8), w1 = *(const f32x4*)(nw + q * 32 + i * 8 + 4);
#pragma unroll
    for (int j = 0; j < 8; ++j) {
      float wv = j < 4 ? w0[j & 3] : w1[j & 3];
      res[j] = f2bf(o[i * 8 + j] * rs * wv * siluf(bf2f(zr[i][j])));
    }
    *(u16x8*)(Yo + (long)row * 512 + q * 32 + i * 8) = res;
  }
}
DI void oproj_ssd(const bfu* Xb  , int g, const float* SCb, const bfu* SSb, const bfu* zP, const float* nw, bfu* Yo) {
  const int tid = TIDX, lane = tid & 63, w = tid >> 6, fr = lane & 15, fq = lane >> 4;
  const int row = 16 * w + (lane >> 2), q = lane & 3;
  float* T = (float*)g_smem;
#pragma unroll
  for (int hh = 0; hh < 4; ++hh) {
    int hd = g * 4 + hh;
    f32x4 acc[4];
    oproj_core<4, true>(acc, Xb + g * 16384, Xb + 32768 + hd * 12288, SSb + hd * 8192, Xb + 32768 + hd * 12288 + 4096, SCb + hd * 256, w, fr, fq);
#pragma unroll
    for (int jv = 0; jv < 4; ++jv)
#pragma unroll
      for (int r = 0; r < 4; ++r) T[(16 * w + fq * 4 + r) * 260 + hh * 64 + jv * 16 + fr] = acc[jv][r];
  }
  float ss = 0.f;
  float o[64];
#pragma unroll
  for (int i = 0; i < 8; ++i) {
    u16x8 z = *(const u16x8*)(zP + (long)row * 512 + q * 64 + i * 8);
    f32x4 v0 = *(const f32x4*)(T + row * 260 + q * 64 + i * 8), v1 = *(const f32x4*)(T + row * 260 + q * 64 + i * 8 + 4);
#pragma unroll
    for (int j = 0; j < 8; ++j) {
      float y = (j < 4 ? v0[j & 3] : v1[j & 3]) * siluf(bf2f(z[j]));
      o[i * 8 + j] = y;
      ss += y * y;
    }
  }
  ss += __shfl_xor(ss, 1); ss += __shfl_xor(ss, 2);
  const float rs = rsqrtf(ss * (1.f / 256.f) + 1e-6f);
#pragma unroll
  for (int i = 0; i < 8; ++i) {
    u16x8 res;
    f32x4 w0 = *(const f32x4*)(nw + q * 64 + i * 8), w1 = *(const f32x4*)(nw + q * 64 + i * 8 + 4);
#pragma unroll
    for (int j = 0; j < 8; ++j) res[j] = f2bf(o[i * 8 + j] * rs * (j < 4 ? w0[j & 3] : w1[j & 3]));
    *(u16x8*)(Yo + (long)row * 512 + q * 64 + i * 8) = res;
  }
}

DI float geluf(float x) { float u = 0.7978845608028654f * (x + 0.044715f * x * x * x); return 0.5f * x * (1.f + tanhf(u)); }

DI void phase_s5_gemm1(const Params& p) {
  const bfu* U2 = (const bfu*)(p.ws + OFF_U2);
  const bfu* Ms = (const bfu*)(p.ws + OFF_MS);
  float* Xloc = (float*)(p.ws + OFF_XLOC);
  for (int t = BIDX; t < 32 * 17; t += gridDim.x) {
    int g = t / 17, tm = t - g * 17;
    f32x4 acc[4][4];
    zero_acc<4>(acc);
    gemm_tile<4>(acc, U2 + ((long)g * 2176 + tm * 128) * 256, 256, Ms + (long)g * 128 * 256, 256, 256);
    ACC_FOREACH(4, { Xloc[((long)g * 2176 + tm * 128 + trow) * 128 + tcol] = acc[m][n][j]; })
  }
}
DI void phase_s5_scan(const Params& p, int layer) {
  float* Xloc = (float*)(p.ws + OFF_XLOC);
  bfu* Xst = (bfu*)(p.ws + OFF_XST);
  const int tid = TIDX;
  const int seg = tid >> 4, p16 = tid & 15;
  float* ex = (float*)g_smem;
  for (int it = BIDX; it < 256; it += gridDim.x) {
    const int g = it >> 3, b = (it >> 2) & 1, pq = it & 3;
    const int pr = pq * 16 + p16;
    const int idx = (layer * 32 + g) * 64 + pr;
    const float dt = expf(p.in[24][layer * 32 + g]);
    const float e1 = p.in[17][idx] * dt * 16.f, a1 = p.in[18][idx] * dt * 16.f;
    const float m16 = expf(e1);
    const float l16x = m16 * cosf(a1), l16y = m16 * sinf(a1);
    const int n0 = seg * 65, n1 = (n0 + 65 < 1028) ? n0 + 65 : 1028;
    const float* xl = Xloc + ((long)g * 2176 + b * 1028) * 128;
    bfu* xs = Xst + ((long)g * 2176 + b * 1028) * 128;
    float sre = 0.f, sim = 0.f;
#pragma unroll 13
    for (int n = n0; n < n1; ++n) {
      float lre = xl[(long)n * 128 + pr], lim = xl[(long)n * 128 + 64 + pr];
      float nre = l16x * sre - l16y * sim + lre;
      float nim = l16x * sim + l16y * sre + lim;
      sre = nre; sim = nim;
    }
    __syncthreads();
    ex[(seg * 16 + p16) * 2] = sre; ex[(seg * 16 + p16) * 2 + 1] = sim;
    __syncthreads();
    float cre = 0.f, cim = 0.f;
    {
      const float mL = expf(e1 * 65.f), aL = a1 * 65.f;
      const float lLx = mL * cosf(aL), lLy = mL * sinf(aL);
      for (int s2 = 0; s2 < seg; ++s2) {
        float ere = ex[(s2 * 16 + p16) * 2], eim = ex[(s2 * 16 + p16) * 2 + 1];
        float nre = lLx * cre - lLy * cim + ere;
        float nim = lLx * cim + lLy * cre + eim;
        cre = nre; cim = nim;
      }
    }
    sre = cre; sim = cim;
#pragma unroll 13
    for (int n = n0; n < n1; ++n) {
      float lre = xl[(long)n * 128 + pr], lim = xl[(long)n * 128 + 64 + pr];
      xs[(long)n * 128 + pr] = f2bf(sre);
      xs[(long)n * 128 + 64 + pr] = f2bf(sim);
      float nre = l16x * sre - l16y * sim + lre;
      float nim = l16x * sim + l16y * sre + lim;
      sre = nre; sim = nim;
    }
  }
}
DI void phase_s5_gemm2(const Params& p) {
  const bfu* U2 = (const bfu*)(p.ws + OFF_U2);
  const bfu* Xst = (const bfu*)(p.ws + OFF_XST);
  const bfu* Mc = (const bfu*)(p.ws + OFF_MC);
  bfu* Ys5 = (bfu*)(p.ws + OFF_YS5);
  for (int t = BIDX; t < 32 * 17 * 2; t += gridDim.x) {
    int g = t / 34, rem = t - g * 34, tm = rem >> 1, tn = rem & 1;
    f32x4 acc[4][4];
    zero_acc<4>(acc);
    const bfu* Bt = Mc + ((long)g * 256 + tn * 128) * 384;
    gemm_tile<4>(acc, U2 + ((long)g * 2176 + tm * 128) * 256, 256, Bt, 384, 256);
    gemm_tile<4>(acc, Xst + ((long)g * 2176 + tm * 128) * 128, 128, Bt + 256, 384, 128);
    ACC_FOREACH(4, {
      int nc = tm * 128 + trow, o = tn * 128 + tcol;
      if (nc < 2056) Ys5[((long)nc * 16 + (o >> 4)) * 512 + g * 16 + (o & 15)] = f2bf(geluf(acc[m][n][j]));
    })
  }
}
DI void phase_glu(const Params& p) {
  const bfu* Ys5 = (const bfu*)(p.ws + OFF_YS5);
  const bfu* Wg = (const bfu*)(p.ws + OFF_WGLU);
  const bfu* Pz = (const bfu*)(p.ws + OFF_PZ);
  bfu* Yd = (bfu*)(p.ws + OFF_Y) + (long)3 * TR * 512;
  for (int v = BIDX; v < 320 * 8; v += gridDim.x) {
    int tm, tn;
    if (!tile_map(v, 8, tm, tn)) continue;
    f32x4 acc[4][4];
    zero_acc<4>(acc);
    gemm_tile<4>(acc, Ys5 + (long)tm * 128 * 512, 512, Wg + (long)tn * 128 * 512, 512, 512);
    const int lane = TIDX & 63, wid = TIDX >> 6, wr = wid >> 1, wc = wid & 1, fr = lane & 15, fq = lane >> 4;
#pragma unroll
    for (int m = 0; m < 4; ++m)
#pragma unroll
      for (int n = 0; n < 2; ++n)
#pragma unroll
        for (int j = 0; j < 4; ++j) {
          int row = tm * 128 + wr * 64 + m * 16 + fq * 4 + j;
          int oc = tn * 64 + wc * 32 + n * 16 + fr;
          float z = bf2f(Pz[(long)row * 512 + oc]);
          Yd[(long)row * 512 + oc] = f2bf(acc[m][n][j] * sigm(acc[m][n + 2][j]) * siluf(z));
        }
  }
}
DI void phase_gates(const Params& p) {
  const bfu* h16 = (const bfu*)(p.ws + OFF_H16);
  const bfu* WT = (const bfu*)(p.ws + OFF_WIN);
  bfu* G = (bfu*)(p.ws + OFF_P);
  for (int v = BIDX; v < 320 * 32; v += gridDim.x) {
    int tm, tn;
    if (!tile_map(v, 32, tm, tn)) continue;
    f32x4 acc[4][4];
    zero_acc<4>(acc);
    gemm_tile<4>(acc, h16 + (long)tm * 128 * 1024, 1024, WT + (long)(6656 + tn * 128) * 1024, 1024, 1024);
    {
      const int lane = TIDX & 63, wid = TIDX >> 6, wr = wid >> 1, wc = wid & 1, fr = lane & 15, fq = lane >> 4;
#pragma unroll
      for (int m = 0; m < 4; ++m)
#pragma unroll
        for (int n = 0; n < 4; ++n) {
          const int row4 = (tm * 128 + wr * 64 + m * 16 + fq * 4) >> 2, col = tn * 128 + wc * 64 + n * 16 + fr;
          u16x4 pk = {f2bf(sigm(acc[m][n][0])), f2bf(sigm(acc[m][n][1])), f2bf(sigm(acc[m][n][2])), f2bf(sigm(acc[m][n][3]))};
          *(u16x4*)(G + ((long)row4 * 4096 + col) * 4) = pk;
        }
    }
  }
}
DI void phase_merge(const Params& p) {
  const bfu* WbT = (const bfu*)(p.ws + OFF_WB);
  const bfu* Y = (const bfu*)(p.ws + OFF_Y);
  const bfu* G = (const bfu*)(p.ws + OFF_P);
  bfu* mixed = (bfu*)(p.ws + OFF_H16);
  for (int v = BIDX; v < 320 * 8; v += gridDim.x) {
    int tm, tn;
    if (!tile_map(v, 8, tm, tn)) continue;
    f32x4 tot[4][4];
    zero_acc<4>(tot);
    for (int b = 0; b < 4; ++b) {
      f32x4 acc[4][4];
      zero_acc<4>(acc);
      gemm_tile<4>(acc, Y + ((long)b * TR + tm * 128) * 512, 512, WbT + (long)(b * 1024 + tn * 128) * 512, 512, 512);
      {
        const int lane = TIDX & 63, wid = TIDX >> 6, wr = wid >> 1, wc = wid & 1, fr = lane & 15, fq = lane >> 4;
#pragma unroll
        for (int m = 0; m < 4; ++m)
#pragma unroll
          for (int n = 0; n < 4; ++n) {
            const int row4 = (tm * 128 + wr * 64 + m * 16 + fq * 4) >> 2, col = b * 1024 + tn * 128 + wc * 64 + n * 16 + fr;
            u16x4 gk = *(const u16x4*)(G + ((long)row4 * 4096 + col) * 4);
#pragma unroll
            for (int j = 0; j < 4; ++j) tot[m][n][j] += bf2f(gk[j]) * acc[m][n][j];
          }
      }
    }
    ACC_FOREACH(4, { mixed[(long)(tm * 128 + trow) * 1024 + tn * 128 + tcol] = f2bf(tot[m][n][j]); })
  }
}
DI void phase_out(const Params& p) {
  const bfu* mixed = (const bfu*)(p.ws + OFF_H16);
  const bfu* WoT = (const bfu*)(p.ws + OFF_WO);
  float* h32 = (float*)(p.ws + OFF_H32);
  const float ALPHA = 1.6817928305074290f;
  for (int v = BIDX; v < 320 * 8; v += gridDim.x) {
    int tm, tn;
    if (!tile_map(v, 8, tm, tn)) continue;
    f32x4 acc[4][4];
    zero_acc<4>(acc);
    gemm_tile<4>(acc, mixed + (long)tm * 128 * 1024, 1024, WoT + (long)tn * 128 * 1024, 1024, 1024);
    ACC_FOREACH(4, {
      long a = (long)(tm * 128 + trow) * 1024 + tn * 128 + tcol;
      h32[a] = ALPHA * h32[a] + acc[m][n][j];
    })
  }
}

DI void run_phase(const Params& p, int ph) {
  if (ph == 0) { phase_tables(p); return; }
  if (ph == NPHASE - 1) { ln_rows(p, 3, true); return; }
  const int layer = (ph - 1) / NPL, sub = (ph - 1) % NPL;
  bfu* Xb = (bfu*)(p.ws + OFF_X);
  float* SC = (float*)(p.ws + OFF_SC);
  bfu* Y = (bfu*)(p.ws + OFF_Y);
  const bfu* Zb = (const bfu*)(p.ws + OFF_Z);
  const int bid = BIDX;
  switch (sub) {
    case 0: ln_rows(p, layer - 1, false); phase_convert(p, layer); break;
    case 1: phase_proj(p, 0, 2048, 0, true, 0); break;
    case 2: for (int it = bid; it < 2056; it += gridDim.x) gdn_prep_item(p, layer, it); break;
    case 3:
      if (bid < 64) {
        int b = bid >> 5, h = (bid >> 3) & 3, sl = bid & 7;
        GdnArgs e;
        bfu* base = Xb + ((long)(b * NCHK) * 4 + h) * 36864;
        e.w = base + 8192; e.kdt = base + 16384; e.ut = base + 24576 + sl * 16 * 64; e.cs = 4 * 36864;
        e.sc = SC + ((long)(b * NCHK) * 4 + h) * 256; e.sc_cs = 4 * 256;
        e.ss = Y + (long)TR * 512 + ((long)(b * NCHK) * 4 + h) * 16384 + sl * 16 * 128; e.ss_cs = 4 * 16384;
        engine_gdn<5, 1>(e);
      } else phase_proj(p, 2048, 1536, 0, false, 64, gridDim.x == 512 ? 64 : 0);
      break;
    case 4:
      for (int it = bid; it < 2056; it += gridDim.x) {
        int h = it & 3; long r0 = (long)(it >> 2) * 64;
        const bfu* base = Xb + (long)it * 36864;
        oproj_head128(base, base + 32768, Y + (long)TR * 512 + (long)it * 16384, base + 24576,
                      Zb + r0 * 512 + h * 128, 512, p.in[8] + layer * 128, Y + r0 * 512 + h * 128);
      }
      break;
    case 5: for (int it = bid; it < 1028; it += gridDim.x) ssd_prep_item(p, layer, it); break;
    case 6:
      if (bid < 128) {
        int b = bid >> 6, hd = (bid >> 3) & 7, sl = (bid >> 1) & 3, kh = bid & 1, g = hd >> 2;
        LinArgs e;
        const bfu* base = Xb + (long)(b * NCHK) * 131072;
        e.kdt = base + g * 16384 + 8192; e.kdt_cs = 131072;
        e.vt = base + 32768 + hd * 12288 + 8192 + sl * 16 * 64; e.vt_cs = 131072;
        e.sc = SC + ((long)(b * NCHK) * 8 + hd) * 256; e.sc_cs = 8 * 256;
        e.ss = Y + (long)2 * TR * 512 + ((long)(b * NCHK) * 8 + hd) * 8192 + sl * 16 * 128; e.ss_cs = 8 * 8192;
        e.kt0 = kh * 4;
        engine_lin<9>(e);
      } else phase_proj(p, 3584, 2048, 0, false, 128);
      break;
    case 7:
      for (int it = bid; it < 1028; it += gridDim.x) {
        int g = it & 1; long cn = it >> 1; long r0 = cn * 64;
        oproj_ssd(Xb + cn * 131072, g, SC + cn * 8 * 256, Y + (long)2 * TR * 512 + cn * 8 * 8192,
                  Zb + r0 * 512 + g * 256, p.in[14] + layer * 512 + g * 256, Y + (long)TR * 512 + r0 * 512 + g * 256);
      }
      break;
    case 8: for (int it = bid; it < 2056; it += gridDim.x) hg_prep_item(p, layer, it); break;
    case 9:
      if (bid < 128) {
        int b = bid >> 6, h = (bid >> 4) & 3, sl = (bid >> 1) & 7, kh = bid & 1;
        LinArgs e;
        const bfu* base = Xb + ((long)(b * NCHK) * 4 + h) * 28672;
        e.kdt = base + 8192; e.kdt_cs = 4 * 28672;
        e.vt = base + 20480 + sl * 16 * 64; e.vt_cs = 4 * 28672;
        e.sc = SC + ((long)(b * NCHK) * 4 + h) * 256; e.sc_cs = 4 * 256;
        bfu* ssb = b == 0 ? (Y + (long)3 * TR * 512) : (Xb + (long)2056 * 28672);
        e.ss = ssb + (long)h * 16384 + sl * 16 * 128; e.ss_cs = 4 * 16384;
        e.kt0 = kh * 4;
        engine_lin<9>(e);
      } else phase_proj(p, 5632, 1024, 1, false, 128, gridDim.x == 512 ? 128 : 0);
      break;
    case 10:
      for (int it = bid; it < 2056; it += gridDim.x) {
        int h = it & 3; int cn = it >> 2; long r0 = (long)cn * 64;
        int b = cn / NCHK, n = cn - b * NCHK;
        const bfu* base = Xb + (long)it * 28672;
        const bfu* ssb = b == 0 ? (Y + (long)3 * TR * 512) : (Xb + (long)2056 * 28672);
        oproj_head128(base, base + 16384, ssb + ((long)n * 4 + h) * 16384, base + 20480,
                      Zb + r0 * 512 + h * 128, 512, p.in[16] + layer * 128, Y + (long)2 * TR * 512 + r0 * 512 + h * 128);
      }
      break;
    case 11: phase_s5_gemm1(p); break;
    case 12: phase_s5_scan(p, layer); break;
    case 13: phase_s5_gemm2(p); break;
    case 14: phase_glu(p); break;
    case 15: phase_gates(p); break;
    case 16: phase_merge(p); break;
    case 17: phase_out(p); break;
  }
}


#define XB_TMO      128
#define XB_XCNT(j)  (256  + 64 * (j))
#define XB_XSUB(j)  (1280 + 64 * (j))
#define XB_XGEN(j)  (2304 + 64 * (j))
#define XB_TOP      3328
#define XB_TOPGEN   3392
#define XCD_BAR_WORDS 3456
#define XB_SPIN_CAP (1u << 20)
#define LAS __attribute__((address_space(3)))
DI unsigned xb_ld(unsigned* p) { return __hip_atomic_load(p, __ATOMIC_RELAXED, __HIP_MEMORY_SCOPE_AGENT); }
DI unsigned xb_add(unsigned* p, unsigned v) { return __hip_atomic_fetch_add(p, v, __ATOMIC_RELAXED, __HIP_MEMORY_SCOPE_AGENT); }
DI unsigned xb_xcc_id() { return (unsigned)__builtin_amdgcn_s_getreg((3 << 11) | 20) & 0xFu; }
#define XB_SPIN(cond, bar) do { unsigned _sp = 0; while (cond) { __builtin_amdgcn_s_sleep(1); \
    if ((++_sp & 255u) == 0u) { if (xb_ld(&(bar)[XB_TMO])) break; if (_sp > XB_SPIN_CAP) { atomicAdd(&(bar)[XB_TMO], 1u); break; } } } } while (0)
struct XcdBarrier { unsigned* bar; unsigned x; volatile LAS unsigned* st; };
DI XcdBarrier xcd_barrier_post(unsigned* bar, volatile LAS unsigned* st) {
  XcdBarrier b; b.bar = bar; b.x = xb_xcc_id(); b.st = st;
  if (threadIdx.x == 0) (void)xb_add(&bar[XB_XCNT(b.x)], 1u);
  return b;
}
DI void xcd_barrier_complete(unsigned* bar, unsigned x, unsigned& nloc, unsigned& nx) {
  const unsigned G = gridDim.x * gridDim.y * gridDim.z;
  unsigned sum, cnt, mine, sp = 0u;
  for (;;) {
    sum = 0u; cnt = 0u; mine = 0u;
#pragma unroll
    for (unsigned j = 0; j < 16; ++j) { const unsigned c = xb_ld(&bar[XB_XCNT(j)]); sum += c; cnt += (c > 0u) ? 1u : 0u; mine = (j == x) ? c : mine; }
    if (sum == G) break;
    __builtin_amdgcn_s_sleep(1);
    if ((++sp & 255u) == 0u) { if (xb_ld(&bar[XB_TMO])) break; if (sp > XB_SPIN_CAP) { atomicAdd(&bar[XB_TMO], 1u); break; } }
  }
  nloc = mine > 0u ? mine : 1u; nx = cnt > 0u ? cnt : 1u;
}
DI void xcd_barrier(const XcdBarrier& b) {
  asm volatile("s_waitcnt vmcnt(0)" ::: "memory");
  __syncthreads();
  if (threadIdx.x == 0) {
    unsigned* bar = b.bar;
    __builtin_amdgcn_s_waitcnt(0);
    unsigned nloc = b.st[0], nx = b.st[1];
    if (nloc == 0u) { xcd_barrier_complete(bar, b.x, nloc, nx); b.st[0] = nloc; b.st[1] = nx; }
    const unsigned old = xb_add(&bar[XB_XSUB(b.x)], 1u);
    const unsigned gen = old / nloc;
    if (old + 1u == (gen + 1u) * nloc) {
      __builtin_amdgcn_fence(__ATOMIC_RELEASE, "agent");
      asm volatile("s_waitcnt vmcnt(0)" ::: "memory");
      const unsigned og = xb_add(&bar[XB_TOP], 1u);
      const unsigned tg = og / nx;
      if (og + 1u == (tg + 1u) * nx) xb_add(&bar[XB_TOPGEN], 1u);
      else XB_SPIN(xb_ld(&bar[XB_TOPGEN]) == tg, bar);
      __builtin_amdgcn_fence(__ATOMIC_ACQUIRE, "agent");
      xb_add(&bar[XB_XGEN(b.x)], 1u);
      asm volatile("s_waitcnt vmcnt(0)" ::: "memory");
    } else {
      XB_SPIN(xb_ld(&bar[XB_XGEN(b.x)]) == gen, bar);
      __builtin_amdgcn_fence(__ATOMIC_ACQUIRE, "agent");
      asm volatile("s_waitcnt vmcnt(0)" ::: "memory");
    }
  }
  __syncthreads();
}
#ifndef DBL_MASK
#define DBL_MASK 0
#endif
#ifndef TIMING_PROBE
#define TIMING_PROBE 0
#endif
#ifndef TP_MASK_A
#define TP_MASK_A 0
#endif
#ifndef TP_MASK_B
#define TP_MASK_B 0
#endif
__global__ void __launch_bounds__(256, 2) mega_kernel(Params p, int ph_lo, int ph_hi) {
  if (ph_hi - ph_lo == 1) { run_phase(p, ph_lo); return; }
  cg::grid_group grid = cg::this_grid();
  volatile LAS unsigned* xst = (volatile LAS unsigned*)(g_smem + LDS_BYTES - 16);
  if (threadIdx.x == 0) { xst[0] = 0u; xst[1] = 0u; xst[2] = 0u; xst[3] = 0u; }
  __syncthreads();
  XcdBarrier xb = xcd_barrier_post((unsigned*)(p.ws + OFF_BAR), xst);
  for (int ph = ph_lo; ph < ph_hi; ++ph) {
    run_phase(p, ph);
#if DBL_MASK
    if (ph > 0 && ph < NPHASE - 1 && ((DBL_MASK >> ((ph - 1) % NPL)) & 1)) { xcd_barrier(xb); run_phase(p, ph); }
#endif
    if (ph + 1 < ph_hi) {
      if (ph == ph_lo) grid.sync();
      else xcd_barrier(xb);
    }
  }
}

extern "C" void kernel_launch(void* const* d_in, const int* in_sizes, int n_in, void* d_out, int out_size, void* d_ws, size_t ws_size,
                              hipStream_t stream) {
  static int grid_blocks = 0;
  if (!grid_blocks) {
    int dev = 0, cus = 0, per_cu = 0;
    hipGetDevice(&dev);
    hipDeviceGetAttribute(&cus, hipDeviceAttributeMultiprocessorCount, dev);
    hipFuncSetAttribute((const void*)mega_kernel, hipFuncAttributeMaxDynamicSharedMemorySize, LDS_BYTES);
    hipOccupancyMaxActiveBlocksPerMultiprocessor(&per_cu, mega_kernel, 256, LDS_BYTES);
    if (per_cu > 2) per_cu = 2;
    if (per_cu < 1) per_cu = 1;
    grid_blocks = cus * per_cu;
  }
  if (ws_size < WS_NEEDED) { fprintf(stderr, "workspace too small: %zu < %zu\n", ws_size, WS_NEEDED); return; }
  Params p{};
  for (int i = 0; i < 31; ++i) p.in[i] = (const float*)d_in[i];
  p.out = (float*)d_out;
  p.ws = (char*)d_ws;
#if MULTI_LAUNCH
  for (int ph = 0; ph < NPHASE; ++ph) {
    hipLaunchKernelGGL(mega_kernel, dim3(grid_blocks), dim3(256), LDS_BYTES, stream, p, ph, ph + 1);
  }
#else
  int lo = 0, hi = NPHASE;
  hipMemsetAsync((char*)d_ws + OFF_BAR, 0, 16384, stream);
  void* args[] = {&p, &lo, &hi};
  hipError_t e = hipLaunchCooperativeKernel((void*)mega_kernel, dim3(grid_blocks), dim3(256), args, LDS_BYTES, stream);
  if (e != hipSuccess) fprintf(stderr, "cooperative launch failed: %s (grid %d)\n", hipGetErrorString(e), grid_blocks);
#endif
}
```

```cpp
#include <hip/hip_runtime.h>
#include <hip/hip_cooperative_groups.h>
#include <cstdio>
namespace cg = cooperative_groups;

typedef unsigned short bfu;
using bf16x8 = __attribute__((ext_vector_type(8))) short;
using f32x4 = __attribute__((ext_vector_type(4))) float;
using u16x4 = __attribute__((ext_vector_type(4))) unsigned short;
using u16x8 = __attribute__((ext_vector_type(8))) unsigned short;
#define DI __device__ __forceinline__
#define MFMA16(a, b, c) __builtin_amdgcn_mfma_f32_16x16x32_bf16((a), (b), (c), 0, 0, 0)

#ifndef PH_MASK
#define PH_MASK 0xFFFFFF
#endif
#ifndef MULTI_LAUNCH
#define MULTI_LAUNCH 0
#endif

constexpr int TR = 32896;
constexpr int NCHK = 257;
constexpr int LBATCH = 16448;
constexpr int LDS_BYTES = 73728;
constexpr int NPL = 18;
constexpr int NPHASE = 1 + 4 * NPL + 1;

constexpr size_t OFF_H32 = 0;
constexpr size_t OFF_H16 = 134742016;
constexpr size_t OFF_Y = 202113024;
constexpr size_t OFF_P = 336855040;
constexpr size_t OFF_X = 471597056;
constexpr size_t OFF_SC = 623181824;
constexpr size_t OFF_PS = 627392512;
constexpr size_t OFF_W = 629497856;
constexpr size_t OFF_WIN = OFF_W;
constexpr size_t OFF_WS = OFF_WIN + 22020096;
constexpr size_t OFF_WGLU = OFF_WS + 32768;
constexpr size_t OFF_WB = OFF_WGLU + 1048576;
constexpr size_t OFF_WO = OFF_WB + 4194304;
constexpr size_t OFF_MS = OFF_WO + 2097152;
constexpr size_t OFF_MC = OFF_MS + 2097152;
constexpr size_t OFF_LB = OFF_MC + 6291456;
constexpr size_t OFF_LP = OFF_LB + 2048;
constexpr size_t OFF_BB = OFF_LP + 1114112;
constexpr size_t OFF_BAR = OFF_BB + 1048576;
constexpr size_t OFF_Z = OFF_BAR + 16384;
constexpr size_t WS_NEEDED = OFF_Z + 33685504;
constexpr size_t OFF_PZ = OFF_P;
constexpr size_t OFF_U2 = OFF_P + 33685504;
constexpr size_t OFF_YS5 = OFF_U2 + 35651584;
constexpr size_t OFF_XLOC = OFF_X;
constexpr size_t OFF_XST = OFF_X + 35651584;

struct Params {
  const float* in[31];
  float* out;
  char* ws;
};

extern __shared__ __attribute__((aligned(16))) char g_smem[];
DI int tid_laundered() { int t = threadIdx.x; asm volatile("" : "+v"(t)); return t; }
DI int bid_laundered() { int b = blockIdx.x; asm volatile("" : "+s"(b)); return b; }
#define TIDX tid_laundered()
#define BIDX bid_laundered()


DI bfu f2bf(float x) { unsigned u = __float_as_uint(x); u += 0x7fffu + ((u >> 16) & 1u); return (bfu)(u >> 16); }
DI float bf2f(bfu b) { return __uint_as_float(((unsigned)b) << 16); }
DI float sigm(float x) { return 1.f / (1.f + __expf(-x)); }
DI float siluf(float x) { return x / (1.f + __expf(-x)); }
DI float softplusf(float x) { return x > 20.f ? x : log1pf(expf(x)); }
DI float wave_sum(float v) {
#pragma unroll
  for (int m = 32; m >= 1; m >>= 1) v += __shfl_xor(v, m);
  return v;
}
DI float wave_scan_incl(float s, int lane) {
#pragma unroll
  for (int d = 1; d < 64; d <<= 1) { float o = __shfl_up(s, d); if (lane >= d) s += o; }
  return s;
}

template <int NREP>
DI void gemm_stage(const bfu* __restrict__ A, int lda, const bfu* __restrict__ Bt, int ldb, int kt, char* buf, int tid) {
#pragma unroll
  for (int i = 0; i < 2; ++i) {
    int b = tid * 16 + i * 4096; int r = b >> 6, c = (b & 63) >> 1;
    __builtin_amdgcn_global_load_lds((const unsigned*)(A + (long)r * lda + kt + c), (unsigned*)(buf + b), 16, 0, 0);
  }
#pragma unroll
  for (int i = 0; i < NREP / 2; ++i) {
    int b = tid * 16 + i * 4096; int r = b >> 6, c = (b & 63) >> 1;
    __builtin_amdgcn_global_load_lds((const unsigned*)(Bt + (long)r * ldb + kt + c), (unsigned*)(buf + 8192 + b), 16, 0, 0);
  }
}
template <int NREP>
DI void gemm_tile(f32x4 (&acc)[4][NREP], const bfu* __restrict__ A, int lda, const bfu* __restrict__ Bt, int ldb, int K) {
  const int tid = TIDX, lane = tid & 63, wid = tid >> 6, wr = wid >> 1, wc = wid & 1, fr = lane & 15, fq = lane >> 4;
  constexpr int GL = 2 + NREP / 2;
  const int nk = K >> 5;
  __syncthreads();
#pragma unroll
  for (int s = 0; s < 3; ++s)
    if (s < nk) gemm_stage<NREP>(A, lda, Bt, ldb, s * 32, g_smem + s * 16384, tid);
  for (int i = 0; i < nk; ++i) {
    const int younger = nk - 1 - i;
    if (younger >= 2) asm volatile("s_waitcnt vmcnt(%0)" ::"n"(2 * GL) : "memory");
    else if (younger == 1) asm volatile("s_waitcnt vmcnt(%0)" ::"n"(GL) : "memory");
    else asm volatile("s_waitcnt vmcnt(0)" ::: "memory");
    __builtin_amdgcn_s_barrier();
    if (i + 3 < nk) gemm_stage<NREP>(A, lda, Bt, ldb, (i + 3) * 32, g_smem + ((i + 3) & 3) * 16384, tid);
    const char* SA = g_smem + (i & 3) * 16384;
    const char* SB = SA + 8192;
    bf16x8 af[4], bfr[NREP];
#pragma unroll
    for (int m = 0; m < 4; ++m) af[m] = *(const bf16x8*)(SA + (wr * 64 + m * 16 + fr) * 64 + fq * 16);
#pragma unroll
    for (int n = 0; n < NREP; ++n) bfr[n] = *(const bf16x8*)(SB + (wc * (NREP * 16) + n * 16 + fr) * 64 + fq * 16);
#pragma unroll
    for (int m = 0; m < 4; ++m)
#pragma unroll
      for (int n = 0; n < NREP; ++n) acc[m][n] = MFMA16(af[m], bfr[n], acc[m][n]);
  }
}
template <int NREP>
DI void zero_acc(f32x4 (&acc)[4][NREP]) {
#pragma unroll
  for (int m = 0; m < 4; ++m)
#pragma unroll
    for (int n = 0; n < NREP; ++n) acc[m][n] = f32x4{0.f, 0.f, 0.f, 0.f};
}
#define ACC_FOREACH(NREP_, ...)                                                                \
  {                                                                                              \
    const int lane_ = TIDX & 63, wid_ = TIDX >> 6, wr_ = wid_ >> 1, wc_ = wid_ & 1; \
    const int fr_ = lane_ & 15, fq_ = lane_ >> 4;                                                \
    _Pragma("unroll") for (int m = 0; m < 4; ++m) _Pragma("unroll") for (int n = 0; n < NREP_; ++n) \
        _Pragma("unroll") for (int j = 0; j < 4; ++j) {                                          \
      const int trow = wr_ * 64 + m * 16 + fq_ * 4 + j;                                          \
      const int tcol = wc_ * (NREP_ * 16) + n * 16 + fr_;                                        \
      __VA_ARGS__                                                                                \
    }                                                                                            \
  }

DI void phase_tables(const Params& p) {
  const int gtid = BIDX * 256 + TIDX, gth = gridDim.x * 256;
  float2* LP = (float2*)(p.ws + OFF_LP);
  float2* BB = (float2*)(p.ws + OFF_BB);
  for (int idx = gtid; idx < 4 * 32 * 64; idx += gth) {
    int l = idx >> 11, g = (idx >> 6) & 31;
    float dt = expf(p.in[24][l * 32 + g]);
    float are = p.in[17][idx], aim = p.in[18][idx];
    float e1 = are * dt, a1 = aim * dt;
    for (int d = 0; d <= 16; ++d) {
      float mag = expf((float)d * e1), ang = (float)d * a1;
      LP[(long)idx * 17 + d] = make_float2(mag * cosf(ang), mag * sinf(ang));
    }
    float mag = expf(e1);
    float lre = mag * cosf(a1), lim = mag * sinf(a1);
    float den = are * are + aim * aim;
    float nr = lre - 1.f, ni = lim;
    float zre = (nr * are + ni * aim) / den, zim = (ni * are - nr * aim) / den;
    for (int c = 0; c < 16; ++c) {
      float bre = p.in[19][(long)idx * 16 + c], bim = p.in[20][(long)idx * 16 + c];
      BB[(long)idx * 16 + c] = make_float2(zre * bre - zim * bim, zre * bim + zim * bre);
    }
  }
}

DI void ln_rows(const Params& p, int layer, bool final_) {
  float* h32 = (float*)(p.ws + OFF_H32);
  bfu* h16 = (bfu*)(p.ws + OFF_H16);
  const int lane = TIDX & 63;
  const int gw = BIDX * 4 + (TIDX >> 6), nw = gridDim.x * 4;
  const float* gam = layer < 0 ? p.in[2] : p.in[29] + layer * 1024;
  const float* bet = layer < 0 ? p.in[3] : p.in[30] + layer * 1024;
  for (int r = gw; r < TR; r += nw) {
    int b = r / LBATCH, pos = r - b * LBATCH;
    float* d32 = h32 + (long)r * 1024;
    bfu* d16 = h16 + (long)r * 1024;
    if (pos < 48) {
      if (!final_) {
#pragma unroll
        for (int i = 0; i < 4; ++i) {
          *(float4*)(d32 + i * 256 + lane * 4) = make_float4(0.f, 0.f, 0.f, 0.f);
          *(u16x4*)(d16 + i * 256 + lane * 4) = u16x4{0, 0, 0, 0};
        }
      }
      continue;
    }
    const float* src;
    if (layer < 0) src = pos < 64 ? p.in[1] + (pos - 48) * 1024 : p.in[0] + ((long)b * 16384 + (pos - 64)) * 1024;
    else src = d32;
    float4 v[4];
    float s = 0.f;
#pragma unroll
    for (int i = 0; i < 4; ++i) { v[i] = *(const float4*)(src + i * 256 + lane * 4); s += v[i].x + v[i].y + v[i].z + v[i].w; }
    float mu = wave_sum(s) * (1.f / 1024.f);
    float q = 0.f;
#pragma unroll
    for (int i = 0; i < 4; ++i) {
      v[i].x -= mu; v[i].y -= mu; v[i].z -= mu; v[i].w -= mu;
      q += v[i].x * v[i].x + v[i].y * v[i].y + v[i].z * v[i].z + v[i].w * v[i].w;
    }
    float rs = rsqrtf(wave_sum(q) * (1.f / 1024.f) + 1e-5f);
#pragma unroll
    for (int i = 0; i < 4; ++i) {
      float4 g4 = *(const float4*)(gam + i * 256 + lane * 4), b4 = *(const float4*)(bet + i * 256 + lane * 4);
      float4 o = make_float4(v[i].x * rs * g4.x + b4.x, v[i].y * rs * g4.y + b4.y, v[i].z * rs * g4.z + b4.z, v[i].w * rs * g4.w + b4.w);
      if (final_) {
        if (pos >= 64) *(float4*)(p.out + ((long)b * 16384 + (pos - 64)) * 1024 + i * 256 + lane * 4) = o;
      } else {
        *(float4*)(d32 + i * 256 + lane * 4) = o;
        *(u16x4*)(d16 + i * 256 + lane * 4) = u16x4{f2bf(o.x), f2bf(o.y), f2bf(o.z), f2bf(o.w)};
      }
    }
  }
}

template <class F>
DI void conv_T(bfu* dst, int N, int K, F src) {
  const long gtid = BIDX * 256 + TIDX, gth = (long)gridDim.x * 256;
  const long total = (long)N * (K / 8);
  for (long idx = gtid; idx < total; idx += gth) {
    int n = (int)(idx % N); int kg = (int)(idx / N);
    u16x8 o;
#pragma unroll
    for (int j = 0; j < 8; ++j) o[j] = f2bf(src(kg * 8 + j, n));
    *(u16x8*)(dst + (long)n * K + kg * 8) = o;
  }
}

DI void phase_convert(const Params& p, int l) {
  const float* win = p.in[4] + (long)l * 1024 * 10768;
  conv_T((bfu*)(p.ws + OFF_WIN), 10752, 1024, [&](int k, int n) {
    int sc = n < 2048 ? n : n < 3584 ? n + 8 : n < 5632 ? n + 16 : n < 6656 ? n + 16 : n + 16;
    return win[(long)k * 10768 + sc];
  });
  conv_T((bfu*)(p.ws + OFF_WS), 16, 1024, [&](int k, int n) { int sc = n < 8 ? 2048 + n : 3592 + (n - 8); return win[(long)k * 10768 + sc]; });
  const float* w1 = p.in[25] + (long)l * 512 * 512;
  const float* w2 = p.in[26] + (long)l * 512 * 512;
  conv_T((bfu*)(p.ws + OFF_WGLU), 1024, 512, [&](int k, int r) {
    int j = r >> 7, wc = (r >> 6) & 1, n = (r >> 4) & 3, fr = r & 15;
    int oc = j * 64 + wc * 32 + (n & 1) * 16 + fr;
    return (n >> 1) ? w2[k * 512 + oc] : w1[k * 512 + oc];
  });
  const float* wb = p.in[27] + (long)l * 4 * 512 * 1024;
  conv_T((bfu*)(p.ws + OFF_WB), 4096, 512, [&](int k, int r) { int b = r >> 10, n = r & 1023; return wb[((long)b * 512 + k) * 1024 + n]; });
  const float* wo = p.in[28] + (long)l * 1024 * 1024;
  conv_T((bfu*)(p.ws + OFF_WO), 1024, 1024, [&](int k, int n) { return wo[(long)k * 1024 + n]; });
  const int gtid = BIDX * 256 + TIDX, gth = gridDim.x * 256;
  float* lbv = (float*)(p.ws + OFF_LB);
  for (int c = gtid; c < 512; c += gth) {
    float v0 = p.in[15][c], v1 = p.in[15][512 + c], v2 = p.in[15][1024 + c], v3 = p.in[15][1536 + c];
    float mx = fmaxf(fmaxf(v0, v1), fmaxf(v2, v3));
    float e0 = expf(v0 - mx), e1 = expf(v1 - mx), e2 = expf(v2 - mx), e3 = expf(v3 - mx);
    float inv = 1.f / (e0 + e1 + e2 + e3);
    float acc = 0.f;
    if (l >= 1) acc += e1 * inv;
    if (l >= 2) acc += e2 * inv;
    if (l >= 3) acc += e3 * inv;
    lbv[c] = acc;
  }
  const float2* LP = (const float2*)(p.ws + OFF_LP) + (long)l * 32 * 64 * 17;
  const float2* BB = (const float2*)(p.ws + OFF_BB) + (long)l * 32 * 64 * 16;
  const float* cre = p.in[21] + (long)l * 32 * 16 * 64;
  const float* cim = p.in[22] + (long)l * 32 * 16 * 64;
  const float* dd = p.in[23] + l * 512;
  bfu* Ms = (bfu*)(p.ws + OFF_MS);
  bfu* Mc = (bfu*)(p.ws + OFF_MC);
  for (int idx = gtid; idx < 32 * 128 * 256; idx += gth) {
    int g = idx >> 15, pp = (idx >> 8) & 127, kk = idx & 255;
    int s = kk >> 4, c2 = kk & 15, pr = pp & 63;
    float2 lp = LP[((long)g * 64 + pr) * 17 + (15 - s)];
    float2 bb = BB[((long)g * 64 + pr) * 16 + c2];
    float v = pp < 64 ? lp.x * bb.x - lp.y * bb.y : lp.x * bb.y + lp.y * bb.x;
    Ms[idx] = f2bf(v);
  }
  for (int idx = gtid; idx < 32 * 256 * 384; idx += gth) {
    int g = idx / (256 * 384); int rem = idx - g * (256 * 384);
    int o = rem / 384, kk = rem - o * 384;
    int t = o >> 4, c = o & 15;
    float v = 0.f;
    const float* cr = cre + ((long)g * 16 + c) * 64;
    const float* ci = cim + ((long)g * 16 + c) * 64;
    if (kk < 256) {
      int s = kk >> 4, c2 = kk & 15;
      if (t >= s) {
        int d = t - s;
        for (int pr = 0; pr < 64; ++pr) {
          float2 lp = LP[((long)g * 64 + pr) * 17 + d];
          float2 bb = BB[((long)g * 64 + pr) * 16 + c2];
          float ere = lp.x * bb.x - lp.y * bb.y, eim = lp.x * bb.y + lp.y * bb.x;
          v += cr[pr] * ere - ci[pr] * eim;
        }
        if (kk == o) v += dd[g * 16 + c];
      }
    } else {
      int pp = kk - 256, pr = pp & 63;
      float2 lp = LP[((long)g * 64 + pr) * 17 + (t + 1)];
      v = pp < 64 ? cr[pr] * lp.x - ci[pr] * lp.y : -(cr[pr] * lp.y + ci[pr] * lp.x);
    }
    Mc[idx] = f2bf(v);
  }
}

DI bool tile_map(int v, int ntn, int& tm, int& tn) {
  const int x = v & 7, j = v >> 3, sidx = j >> 5, within = j & 31, ntng = ntn >> 2;
  const int gq = sidx / ntng, tng = sidx - gq * ntng;
  tm = (gq * 8 + x) * 8 + (within >> 2);
  tn = tng * 4 + (within & 3);
  return tm < 257;
}
DI void phase_proj(const Params& p, int wrow0, int ncols, int mode, bool with_small, int boff, int nskip = 0) {
  const bfu* h16 = (const bfu*)(p.ws + OFF_H16);
  const bfu* WT = (const bfu*)(p.ws + OFF_WIN);
  bfu* P = (bfu*)(p.ws + OFF_P);
  bfu* U2 = (bfu*)(p.ws + OFF_U2);
  const int ntn = ncols >> 7;
  const int G = gridDim.x - boff - nskip;
  const int bsel = BIDX;
  if (nskip && bsel >= 256 && bsel < 256 + nskip) return;
  const int bidx = bsel - boff - ((nskip && bsel >= 256) ? nskip : 0);
  for (int v = bidx; v < 320 * ntn; v += G) {
    int tm, tn;
    if (!tile_map(v, ntn, tm, tn)) continue;
    {
      f32x4 acc[4][4];
      zero_acc<4>(acc);
      gemm_tile<4>(acc, h16 + (long)tm * 128 * 1024, 1024, WT + (long)(wrow0 + tn * 128) * 1024, 1024, 1024);
      if (mode == 0) {
        ACC_FOREACH(4, { P[(long)(tm * 128 + trow) * ncols + tn * 128 + tcol] = f2bf(acc[m][n][j]); })
      } else {
        ACC_FOREACH(4, {
          int row = tm * 128 + trow, col = tn * 128 + tcol;
          if (col < 512) { int g = col >> 4, c2 = col & 15; U2[((long)g * 2176 + (row >> 4)) * 256 + (row & 15) * 16 + c2] = f2bf(acc[m][n][j]); }
          else P[(long)row * 512 + (col - 512)] = f2bf(acc[m][n][j]);
        })
      }
    }
  }
  if (with_small) for (int tm = bidx; tm < 257; tm += G) {
    {
      const int lane = TIDX & 63, w = TIDX >> 6, fr = lane & 15, fq = lane >> 4;
      const bfu* WsT = (const bfu*)(p.ws + OFF_WS);
      float* Ps = (float*)(p.ws + OFF_PS);
      f32x4 a0 = {0.f, 0.f, 0.f, 0.f}, a1 = {0.f, 0.f, 0.f, 0.f};
      const bfu* pa0 = h16 + (long)(tm * 128 + w * 32 + fr) * 1024 + fq * 8;
      const bfu* pa1 = pa0 + 16 * 1024;
      const bfu* pb = WsT + fr * 1024 + fq * 8;
      for (int k = 0; k < 1024; k += 32) {
        bf16x8 x0 = *(const bf16x8*)(pa0 + k), x1 = *(const bf16x8*)(pa1 + k), y = *(const bf16x8*)(pb + k);
        a0 = MFMA16(x0, y, a0);
        a1 = MFMA16(x1, y, a1);
      }
#pragma unroll
      for (int j = 0; j < 4; ++j) {
        Ps[(long)(tm * 128 + w * 32 + fq * 4 + j) * 16 + fr] = a0[j];
        Ps[(long)(tm * 128 + w * 32 + 16 + fq * 4 + j) * 16 + fr] = a1[j];
      }
    }
  }
}

DI void copy_z(const Params& p, const bfu* src, int sld, bfu* dst, int pieces_per_row) {
  const int tid = TIDX;
  const int total = 64 * pieces_per_row;
  for (int i = tid; i < total; i += 256) {
    int r = i / pieces_per_row, c = i - r * pieces_per_row;
    *(u16x8*)(dst + (long)r * 512 + c * 8) = *(const u16x8*)(src + (long)r * sld + c * 8);
  }
}
DI void gdn_prep_item(const Params& p, int layer, int item) {
  const int tid = TIDX, lane = tid & 63, w = tid >> 6, fr = lane & 15, fq = lane >> 4;
  const int h = item & 3, cn = item >> 2, n = cn % NCHK;
  const long r0 = (long)cn * 64;
  const bfu* P = (const bfu*)(p.ws + OFF_P);
  const float* Ps = (const float*)(p.ws + OFF_PS);
  bfu* Xb = (bfu*)(p.ws + OFF_X) + (long)item * 36864;
  float* SC = (float*)(p.ws + OFF_SC) + (long)item * 256;
  bfu* rawQ = (bfu*)g_smem;
  bfu* rawK = rawQ + 64 * 136;
  bfu* rawV = rawK + 64 * 136;
  float* aL = (float*)(g_smem + 52224);
  float* sm = (float*)(g_smem + 69632);
  const float* cw = p.in[5] + layer * 4 * 1536;
  copy_z(p, P + r0 * 2048 + 1536 + h * 128, 2048, (bfu*)(p.ws + OFF_Z) + r0 * 512 + h * 128, 16);
  if (w < 3) {
    const int cgp = tid % 48, seg = tid / 48;
    const int which = cgp >> 4, c8 = (cgp & 15) * 8;
    const int col = which * 512 + h * 128 + c8;
    const int t0 = seg * 16;
    u16x8 xr[19];
    const bool nohist = (seg == 0 && n == 0);
#pragma unroll
    for (int i = 0; i < 19; ++i) {
      const bool valid = !(nohist && i < 3);
      const long rr = valid ? (r0 + t0 - 3 + i) : r0;
      u16x8 v = *(const u16x8*)(P + rr * 2048 + col);
      xr[i] = valid ? v : u16x8{0, 0, 0, 0, 0, 0, 0, 0};
    }
    float wt[4][8];
#pragma unroll
    for (int j = 0; j < 4; ++j) {
      float4 a4 = *(const float4*)(cw + j * 1536 + col), b4 = *(const float4*)(cw + j * 1536 + col + 4);
      wt[j][0] = a4.x; wt[j][1] = a4.y; wt[j][2] = a4.z; wt[j][3] = a4.w; wt[j][4] = b4.x; wt[j][5] = b4.y; wt[j][6] = b4.z; wt[j][7] = b4.w;
    }
    bfu* dst = rawQ + which * (64 * 136) + c8;
#pragma unroll
    for (int r = 0; r < 16; ++r) {
      u16x8 o;
#pragma unroll
      for (int c = 0; c < 8; ++c) {
        float v = wt[0][c] * bf2f(xr[r][c]) + wt[1][c] * bf2f(xr[r + 1][c]) + wt[2][c] * bf2f(xr[r + 2][c]) + wt[3][c] * bf2f(xr[r + 3][c]);
        o[c] = f2bf(siluf(v));
      }
      *(u16x8*)(dst + (t0 + r) * 136) = o;
    }
  }
  if (w == 3) {
    const float* ps = Ps + (r0 + lane) * 16;
    float be = sigm(ps[h]);
    float gl = -__expf(p.in[6][layer * 4 + h]) * softplusf(ps[4 + h] + p.in[7][layer * 4 + h]);
    float s = wave_scan_incl(gl, lane);
    sm[128 + lane] = be;
    sm[192 + lane] = s;
  }
  __syncthreads();
  if (tid < 128) {
    int row = tid & 63, mat = tid >> 6;
    const bfu* rp = rawQ + mat * (64 * 136) + row * 136;
    float ss = 0.f;
    for (int c = 0; c < 128; ++c) { float v = bf2f(rp[c]); ss += v * v; }
    float sc = rsqrtf(ss + 1e-6f);
    if (mat == 0) sc *= 0.08838834764831845f;
    sm[mat * 64 + row] = sc;
  }
  __syncthreads();
  if (tid < 64) { float be = sm[128 + tid]; sm[256 + tid] = be; sm[320 + tid] = be * sm[64 + tid] * __expf(sm[192 + tid]); }
  {
    bf16x8 kf[4], qf[4];
#pragma unroll
    for (int ks = 0; ks < 4; ++ks) {
      kf[ks] = *(const bf16x8*)(rawK + (16 * w + fr) * 136 + ks * 32 + fq * 8);
      qf[ks] = *(const bf16x8*)(rawQ + (16 * w + fr) * 136 + ks * 32 + fq * 8);
    }
    bfu* AMg = Xb + 32768;
    for (int tj = 0; tj < 4; ++tj) {
      if (tj <= w) {
        f32x4 akk = {0.f, 0.f, 0.f, 0.f}, aqk = {0.f, 0.f, 0.f, 0.f};
#pragma unroll
        for (int ks = 0; ks < 4; ++ks) {
          bf16x8 bk = *(const bf16x8*)(rawK + (16 * tj + fr) * 136 + ks * 32 + fq * 8);
          akk = MFMA16(kf[ks], bk, akk);
          aqk = MFMA16(qf[ks], bk, aqk);
        }
        int j = 16 * tj + fr;
        float rkj = sm[64 + j], gcj = sm[192 + j];
#pragma unroll
        for (int r = 0; r < 4; ++r) {
          int i = 16 * w + fq * 4 + r;
          float dec = (i >= j) ? __expf(sm[192 + i] - gcj) : 0.f;
          aL[i * 68 + j] = (i > j) ? sm[128 + i] * sm[64 + i] * rkj * akk[r] * dec : 0.f;
          AMg[i * 64 + j] = f2bf((i >= j) ? sm[i] * rkj * aqk[r] * dec : 0.f);
        }
      } else {
#pragma unroll
        for (int r = 0; r < 4; ++r) AMg[(16 * w + fq * 4 + r) * 64 + 16 * tj + fr] = 0;
      }
    }
  }
  __syncthreads();
  {
    const bfu* src = (tid < 128) ? (rawV + tid) : (rawK + (tid - 128));
    const float* rs = sm + ((tid < 128) ? 256 : 320);
    float x[64];
#pragma unroll
    for (int i = 0; i < 64; ++i) {
      float a = bf2f(src[i * 136]) * rs[i];
#pragma unroll
      for (int j = 0; j < i; ++j) a -= aL[i * 68 + j] * x[j];
      x[i] = a;
    }
    if (tid < 128) {
      bfu* UT = Xb + 24576 + tid * 64;
#pragma unroll
      for (int i = 0; i < 64; i += 8) {
        u16x8 o;
#pragma unroll
        for (int j = 0; j < 8; ++j) o[j] = f2bf(x[i + j]);
        *(u16x8*)(UT + i) = o;
      }
    } else {
      bfu* Wg = Xb + 8192 + (tid - 128);
#pragma unroll
      for (int i = 0; i < 64; ++i) Wg[i * 128] = f2bf(x[i]);
    }
  }
  {
    bfu* QDg = Xb;
    bfu* KDTg = Xb + 16384;
    float gl_last = sm[192 + 63];
    for (int idx = tid; idx < 8192; idx += 256) { int i = idx >> 7, c = idx & 127; QDg[idx] = f2bf(bf2f(rawQ[i * 136 + c]) * sm[i] * __expf(sm[192 + i])); }
    for (int idx = tid; idx < 8192; idx += 256) { int c = idx >> 6, i = idx & 63; KDTg[idx] = f2bf(bf2f(rawK[i * 136 + c]) * sm[64 + i] * __expf(gl_last - sm[192 + i])); }
    if (tid < 128) SC[128 + tid] = __expf(gl_last);
  }
  __syncthreads();
}

DI void ssd_prep_item(const Params& p, int layer, int item) {
  const int tid = TIDX, lane = tid & 63, w = tid >> 6, fr = lane & 15, fq = lane >> 4;
  const int g = item & 1, cn = item >> 1, n = cn % NCHK;
  const long r0 = (long)cn * 64;
  const bfu* P = (const bfu*)(p.ws + OFF_P);
  const float* Ps = (const float*)(p.ws + OFF_PS);
  bfu* Xb = (bfu*)(p.ws + OFF_X) + (long)cn * 131072;
  float* SCb = (float*)(p.ws + OFF_SC) + (long)cn * 8 * 256;
  bfu* Bm = (bfu*)g_smem;
  bfu* Cm = Bm + 64 * 136;
  float* cb = (float*)(g_smem + 34816);
  float* sm = (float*)(g_smem + 34816 + 17408);
  {
    int hd = g * 4 + w;
    float dtv = softplusf(Ps[(r0 + lane) * 16 + 8 + hd] + p.in[11][layer * 8 + hd]);
    float a = -dtv * __expf(p.in[12][layer * 8 + hd]);
    float ac = wave_scan_incl(a, lane);
    sm[w * 64 + lane] = dtv;
    sm[256 + w * 64 + lane] = ac;
  }
  __syncthreads();
  const float* cw = p.in[9] + layer * 4 * 1024;
  const float* cbias = p.in[10] + layer * 1024;
  copy_z(p, P + r0 * 1536 + 1024 + g * 256, 1536, (bfu*)(p.ws + OFF_Z) + r0 * 512 + g * 256, 32);
  {
    const int cg8 = tid & 63, seg = tid >> 6, t0 = seg * 16;
    const int col = (cg8 < 16) ? 512 + g * 128 + cg8 * 8 : (cg8 < 32) ? 768 + g * 128 + (cg8 - 16) * 8 : g * 256 + (cg8 - 32) * 8;
    u16x8 xr[19];
    const bool nohist = (seg == 0 && n == 0);
#pragma unroll
    for (int i = 0; i < 19; ++i) {
      const bool valid = !(nohist && i < 3);
      const long rr = valid ? (r0 + t0 - 3 + i) : r0;
      u16x8 v = *(const u16x8*)(P + rr * 1536 + col);
      xr[i] = valid ? v : u16x8{0, 0, 0, 0, 0, 0, 0, 0};
    }
    float wt[4][8], bias[8];
#pragma unroll
    for (int j = 0; j < 4; ++j) {
      float4 a4 = *(const float4*)(cw + j * 1024 + col), b4 = *(const float4*)(cw + j * 1024 + col + 4);
      wt[j][0] = a4.x; wt[j][1] = a4.y; wt[j][2] = a4.z; wt[j][3] = a4.w; wt[j][4] = b4.x; wt[j][5] = b4.y; wt[j][6] = b4.z; wt[j][7] = b4.w;
    }
    {
      float4 a4 = *(const float4*)(cbias + col), b4 = *(const float4*)(cbias + col + 4);
      bias[0] = a4.x; bias[1] = a4.y; bias[2] = a4.z; bias[3] = a4.w; bias[4] = b4.x; bias[5] = b4.y; bias[6] = b4.z; bias[7] = b4.w;
    }
    if (cg8 < 32) {
      bfu* dst = (cg8 < 16) ? (Bm + cg8 * 8) : (Cm + (cg8 - 16) * 8);
#pragma unroll
      for (int r = 0; r < 16; ++r) {
        u16x8 o;
        const bool padrow = (n == 0 && t0 + r < 48);
#pragma unroll
        for (int c = 0; c < 8; ++c) {
          float v = wt[0][c] * bf2f(xr[r][c]) + wt[1][c] * bf2f(xr[r + 1][c]) + wt[2][c] * bf2f(xr[r + 2][c]) + wt[3][c] * bf2f(xr[r + 3][c]) + bias[c];
          o[c] = padrow ? (bfu)0 : f2bf(siluf(v));
        }
        *(u16x8*)(dst + (t0 + r) * 136) = o;
      }
    } else {
      const int hh = (cg8 - 32) >> 3, pp8 = ((cg8 - 32) & 7) * 8;
      bfu* vtb = Xb + 32768 + (g * 4 + hh) * 12288 + 4096;
      const float alast = sm[256 + hh * 64 + 63];
#pragma unroll
      for (int q4 = 0; q4 < 4; ++q4) {
        float dtv[4], ksv[4];
#pragma unroll
        for (int rr = 0; rr < 4; ++rr) {
          int t = t0 + q4 * 4 + rr;
          const bool padrow = (n == 0 && t < 48);
          dtv[rr] = padrow ? 0.f : sm[hh * 64 + t];
          ksv[rr] = __expf(alast - sm[256 + hh * 64 + t]);
        }
#pragma unroll
        for (int c = 0; c < 8; ++c) {
          u16x4 oa, ob;
#pragma unroll
          for (int rr = 0; rr < 4; ++rr) {
            int r = q4 * 4 + rr;
            float v = wt[0][c] * bf2f(xr[r][c]) + wt[1][c] * bf2f(xr[r + 1][c]) + wt[2][c] * bf2f(xr[r + 2][c]) + wt[3][c] * bf2f(xr[r + 3][c]) + bias[c];
            float xd = siluf(v) * dtv[rr];
            oa[rr] = f2bf(xd);
            ob[rr] = f2bf(xd * ksv[rr]);
          }
          *(u16x4*)(vtb + (pp8 + c) * 64 + t0 + q4 * 4) = oa;
          *(u16x4*)(vtb + 4096 + (pp8 + c) * 64 + t0 + q4 * 4) = ob;
        }
      }
    }
  }
  __syncthreads();
  {
    bf16x8 cf[4];
#pragma unroll
    for (int ks = 0; ks < 4; ++ks) cf[ks] = *(const bf16x8*)(Cm + (16 * w + fr) * 136 + ks * 32 + fq * 8);
    for (int tj = 0; tj < 4; ++tj) {
      if (tj <= w) {
        f32x4 a = {0.f, 0.f, 0.f, 0.f};
#pragma unroll
        for (int ks = 0; ks < 4; ++ks) {
          bf16x8 bk = *(const bf16x8*)(Bm + (16 * tj + fr) * 136 + ks * 32 + fq * 8);
          a = MFMA16(cf[ks], bk, a);
        }
#pragma unroll
        for (int r = 0; r < 4; ++r) cb[(16 * w + fq * 4 + r) * 68 + 16 * tj + fr] = a[r];
      }
    }
    bfu* Cg = Xb + g * 16384;
    bfu* BTg = Cg + 8192;
    for (int idx = tid; idx < 8192; idx += 256) Cg[idx] = Cm[(idx >> 7) * 136 + (idx & 127)];
    for (int idx = tid; idx < 8192; idx += 256) BTg[idx] = Bm[(idx & 63) * 136 + (idx >> 6)];
  }
  __syncthreads();
  for (int hh = 0; hh < 4; ++hh) {
    int hd = g * 4 + hh;
    bfu* AMg = Xb + 32768 + hd * 12288;
    float Dh = p.in[13][layer * 8 + hd];
    const float* dtp = sm + hh * 64;
    const float* acp = sm + 256 + hh * 64;
    for (int idx = tid; idx < 4096; idx += 256) {
      int l = idx >> 6, m = idx & 63;
      float v = (m <= l) ? cb[l * 68 + m] * __expf(acp[l] - acp[m]) : 0.f;
      if (m == l) v += Dh / dtp[l];
      AMg[idx] = f2bf(v);
    }
    float* sc = SCb + hd * 256;
    float alast = acp[63];
    if (tid < 64) { sc[tid] = __expf(acp[tid]); sc[64 + tid] = __expf(alast - acp[tid]); }
    else if (tid < 192) sc[128 + (tid - 64)] = __expf(alast);
  }
  __syncthreads();
}

DI void hg_prep_item(const Params& p, int layer, int item) {
  const int tid = TIDX, lane = tid & 63, w = tid >> 6, fr = lane & 15, fq = lane >> 4;
  const int h = item & 3, cn = item >> 2;
  const long r0 = (long)cn * 64;
  const bfu* P = (const bfu*)(p.ws + OFF_P);
  const float* lbv = (const float*)(p.ws + OFF_LB);
  bfu* Xb = (bfu*)(p.ws + OFF_X) + (long)item * 28672;
  float* SC = (float*)(p.ws + OFF_SC) + (long)item * 256;
  bfu* Qall = (bfu*)g_smem;
  bfu* Ks = Qall + 160 * 136;
  float* segs = (float*)(g_smem + 60928);
  bfu* QDg = Xb;
  bfu* KDTg = Xb + 8192;
  bfu* AMg = Xb + 16384;
  bfu* VTg = Xb + 20480;
  copy_z(p, P + r0 * 2048 + 1536 + h * 128, 2048, (bfu*)(p.ws + OFF_Z) + r0 * 512 + h * 128, 16);
  {
    const int k8 = (tid & 15) * 8, rs = tid >> 4, t0 = rs * 4;
    u16x8 fr4[4], qr4[4], ir4[4];
    const bfu* base = P + (r0 + t0) * 2048 + h * 128 + k8;
#pragma unroll
    for (int r = 0; r < 4; ++r) {
      qr4[r] = *(const u16x8*)(base + (long)r * 2048);
      fr4[r] = *(const u16x8*)(base + (long)r * 2048 + 512);
      ir4[r] = *(const u16x8*)(base + (long)r * 2048 + 1024);
    }
    float lb[8];
    {
      float4 a4 = *(const float4*)(lbv + h * 128 + k8), b4 = *(const float4*)(lbv + h * 128 + k8 + 4);
      lb[0] = a4.x; lb[1] = a4.y; lb[2] = a4.z; lb[3] = a4.w; lb[4] = b4.x; lb[5] = b4.y; lb[6] = b4.z; lb[7] = b4.w;
    }
    float lf[4][8];
    float ssum[8];
#pragma unroll
    for (int c = 0; c < 8; ++c) ssum[c] = 0.f;
#pragma unroll
    for (int r = 0; r < 4; ++r)
#pragma unroll
      for (int c = 0; c < 8; ++c) {
        float zf = bf2f(fr4[r][c]);
        float f = lb[c] + (1.f - lb[c]) * (1.f / (1.f + __expf(-zf)));
        lf[r][c] = __logf(f);
        ssum[c] += lf[r][c];
      }
    *(float4*)(segs + rs * 128 + k8) = make_float4(ssum[0], ssum[1], ssum[2], ssum[3]);
    *(float4*)(segs + rs * 128 + k8 + 4) = make_float4(ssum[4], ssum[5], ssum[6], ssum[7]);
#pragma unroll
    for (int c = 0; c < 8; ++c) {
      u16x4 o = {ir4[0][c], ir4[1][c], ir4[2][c], ir4[3][c]};
      *(u16x4*)(VTg + (k8 + c) * 64 + t0) = o;
    }
    __syncthreads();
    float Gb[8], G1[8], G2[8], G3[8], GL[8];
#pragma unroll
    for (int c = 0; c < 8; ++c) { Gb[c] = 0.f; G1[c] = 0.f; G2[c] = 0.f; G3[c] = 0.f; GL[c] = 0.f; }
    for (int s2 = 0; s2 < 16; ++s2) {
      float4 a4 = *(const float4*)(segs + s2 * 128 + k8), b4 = *(const float4*)(segs + s2 * 128 + k8 + 4);
      float v[8] = {a4.x, a4.y, a4.z, a4.w, b4.x, b4.y, b4.z, b4.w};
#pragma unroll
      for (int c = 0; c < 8; ++c) {
        if (s2 < rs) Gb[c] += v[c];
        if (s2 < 4) G1[c] += v[c];
        if (s2 < 8) G2[c] += v[c];
        if (s2 < 12) G3[c] += v[c];
        GL[c] += v[c];
      }
    }
    const int Jt = rs >> 2;
    float G[8];
#pragma unroll
    for (int c = 0; c < 8; ++c) G[c] = Gb[c];
#pragma unroll
    for (int r = 0; r < 4; ++r) {
      const int t = t0 + r;
      u16x8 oq, oq1, oq2, oq3, ok;
#pragma unroll
      for (int c = 0; c < 8; ++c) {
        G[c] += lf[r][c];
        float zf = bf2f(fr4[r][c]);
        float kk = (1.f - lb[c]) * (1.f / (1.f + __expf(zf)));
        float q = siluf(bf2f(qr4[r][c]));
        oq[c] = f2bf(q * __expf(G[c]));
        oq1[c] = f2bf(q * __expf(G[c] - G1[c]));
        oq2[c] = f2bf(q * __expf(G[c] - G2[c]));
        oq3[c] = f2bf(q * __expf(G[c] - G3[c]));
        float GJ = (Jt == 0) ? 0.f : (Jt == 1) ? G1[c] : (Jt == 2) ? G2[c] : G3[c];
        ok[c] = f2bf(kk * __expf(fminf(GJ - G[c], 80.f)));
      }
      *(u16x8*)(QDg + t * 128 + k8) = oq;
      *(u16x8*)(Qall + t * 136 + k8) = oq;
      if (t >= 16) *(u16x8*)(Qall + (64 + t - 16) * 136 + k8) = oq1;
      if (t >= 32) *(u16x8*)(Qall + (112 + t - 32) * 136 + k8) = oq2;
      if (t >= 48) *(u16x8*)(Qall + (144 + t - 48) * 136 + k8) = oq3;
      *(u16x8*)(Ks + t * 136 + k8) = ok;
    }
#pragma unroll
    for (int c = 0; c < 8; ++c) {
      float Gc = Gb[c];
      u16x4 o;
#pragma unroll
      for (int r = 0; r < 4; ++r) {
        Gc += lf[r][c];
        float zf = bf2f(fr4[r][c]);
        float kk = (1.f - lb[c]) * (1.f / (1.f + __expf(zf)));
        o[r] = f2bf(kk * __expf(GL[c] - Gc));
      }
      *(u16x4*)(KDTg + (k8 + c) * 64 + t0) = o;
    }
    if (rs == 0) {
#pragma unroll
      for (int c = 0; c < 8; ++c) SC[128 + k8 + c] = __expf(GL[c]);
    }
  }
  __syncthreads();
  for (int J = 0; J < 4; ++J) {
    if (J <= w) {
      int rowbase = (J == 0 ? 0 : J == 1 ? 64 : J == 2 ? 112 : 144) + 16 * (w - J);
      f32x4 a = {0.f, 0.f, 0.f, 0.f};
#pragma unroll
      for (int ks = 0; ks < 4; ++ks) {
        bf16x8 af = *(const bf16x8*)(Qall + (rowbase + fr) * 136 + ks * 32 + fq * 8);
        bf16x8 bk = *(const bf16x8*)(Ks + (16 * J + fr) * 136 + ks * 32 + fq * 8);
        a = MFMA16(af, bk, a);
      }
#pragma unroll
      for (int r = 0; r < 4; ++r) {
        int t = 16 * w + fq * 4 + r, s = 16 * J + fr;
        AMg[t * 64 + s] = f2bf((s <= t) ? a[r] : 0.f);
      }
    } else {
#pragma unroll
      for (int r = 0; r < 4; ++r) AMg[(16 * w + fq * 4 + r) * 64 + 16 * J + fr] = 0;
    }
  }
  __syncthreads();
}

struct LinArgs {
  const bfu* kdt; long kdt_cs;
  const bfu* vt; long vt_cs;
  const float* sc; long sc_cs;
  bfu* ss; long ss_cs;
  int kt0;
};
template <int NVT> struct LinFrags { bf16x8 kf[2]; bf16x8 vf[NVT][2]; f32x4 dv; };
template <int NVT>
DI void lin_load(LinFrags<NVT>& f, const LinArgs& e, int n, int w, int fr, int fq) {
#pragma unroll
  for (int ks = 0; ks < 2; ++ks) f.kf[ks] = *(const bf16x8*)(e.kdt + n * e.kdt_cs + ((e.kt0 + w) * 16 + fr) * 64 + ks * 32 + fq * 8);
#pragma unroll
  for (int jv = 0; jv < NVT; ++jv)
#pragma unroll
    for (int ks = 0; ks < 2; ++ks) f.vf[jv][ks] = *(const bf16x8*)(e.vt + n * e.vt_cs + (jv * 16 + fr) * 64 + ks * 32 + fq * 8);
  f.dv = *(const f32x4*)(e.sc + n * e.sc_cs + 128 + (e.kt0 + w) * 16 + fq * 4);
}
template <int NST, int NVT>
DI void engine_lin(const LinArgs& e) {
  const int tid = TIDX, lane = tid & 63, w = tid >> 6, fr = lane & 15, fq = lane >> 4;
  f32x4 S[NVT];
#pragma unroll
  for (int jv = 0; jv < NVT; ++jv) S[jv] = f32x4{0.f, 0.f, 0.f, 0.f};
  LinFrags<NVT> f[NST];
#pragma unroll
  for (int s = 0; s < NST - 1; ++s) lin_load<NVT>(f[s], e, s, w, fr, fq);
  for (int n0 = 0; n0 < NCHK; n0 += NST) {
#pragma unroll
    for (int s = 0; s < NST; ++s) {
      const int n = n0 + s;
      if (n < NCHK) {
        int nl = n + NST - 1; if (nl > NCHK - 1) nl = NCHK - 1;
        lin_load<NVT>(f[(s + NST - 1) % NST], e, nl, w, fr, fq);
        const LinFrags<NVT>& c = f[s];
#pragma unroll
        for (int jv = 0; jv < NVT; ++jv) {
          u16x4 pk = {f2bf(S[jv][0]), f2bf(S[jv][1]), f2bf(S[jv][2]), f2bf(S[jv][3])};
          *(u16x4*)(e.ss + n * e.ss_cs + (jv * 16 + fr) * 128 + (e.kt0 + w) * 16 + fq * 4) = pk;
        }
#pragma unroll
        for (int jv = 0; jv < NVT; ++jv)
#pragma unroll
          for (int r = 0; r < 4; ++r) S[jv][r] *= c.dv[r];
#pragma unroll
        for (int ks = 0; ks < 2; ++ks)
#pragma unroll
          for (int jv = 0; jv < NVT; ++jv) S[jv] = MFMA16(c.kf[ks], c.vf[jv][ks], S[jv]);
      }
    }
  }
}

struct GdnArgs {
  const bfu* w; const bfu* kdt; bfu* ut; long cs;
  const float* sc; long sc_cs;
  bfu* ss; long ss_cs;
};
template <int NVT> struct GdnFrags { bf16x8 wf[4]; bf16x8 kf[2][2]; u16x4 v[NVT]; float dv; };
template <int NVT>
DI void gdn_load(GdnFrags<NVT>& f, const GdnArgs& e, int n, int w, int fr, int fq) {
#pragma unroll
  for (int ks = 0; ks < 4; ++ks) f.wf[ks] = *(const bf16x8*)(e.w + n * e.cs + (16 * w + fr) * 128 + ks * 32 + fq * 8);
#pragma unroll
  for (int a = 0; a < 2; ++a)
#pragma unroll
    for (int ks = 0; ks < 2; ++ks) f.kf[a][ks] = *(const bf16x8*)(e.kdt + n * e.cs + ((2 * w + a) * 16 + fr) * 64 + ks * 32 + fq * 8);
#pragma unroll
  for (int jv = 0; jv < NVT; ++jv) f.v[jv] = *(const u16x4*)(e.ut + n * e.cs + (jv * 16 + fr) * 64 + 16 * w + fq * 4);
  f.dv = e.sc[n * e.sc_cs + 128];
}
template <int NST, int NVT>
DI void engine_gdn(const GdnArgs& e) {
  const int tid = TIDX, lane = tid & 63, w = tid >> 6, fr = lane & 15, fq = lane >> 4;
  char* VT = g_smem + 17408;
  f32x4 S[2][NVT];
#pragma unroll
  for (int a = 0; a < 2; ++a)
#pragma unroll
    for (int jv = 0; jv < NVT; ++jv) S[a][jv] = f32x4{0.f, 0.f, 0.f, 0.f};
  GdnFrags<NVT> f[NST];
#pragma unroll
  for (int s = 0; s < NST - 1; ++s) gdn_load<NVT>(f[s], e, s, w, fr, fq);
  for (int n0 = 0; n0 < NCHK; n0 += NST) {
#pragma unroll
    for (int s = 0; s < NST; ++s) {
      const int n = n0 + s;
      if (n < NCHK) {
        int nl = n + NST - 1; if (nl > NCHK - 1) nl = NCHK - 1;
        gdn_load<NVT>(f[(s + NST - 1) % NST], e, nl, w, fr, fq);
        const GdnFrags<NVT>& c = f[s];
        char* STc = g_smem + (n & 1) * 8704;
#pragma unroll
        for (int a = 0; a < 2; ++a)
#pragma unroll
          for (int jv = 0; jv < NVT; ++jv) {
            u16x4 pk = {f2bf(S[a][jv][0]), f2bf(S[a][jv][1]), f2bf(S[a][jv][2]), f2bf(S[a][jv][3])};
            *(u16x4*)(STc + ((jv * 16 + fr) * 136 + (2 * w + a) * 16 + fq * 4) * 2) = pk;
            *(u16x4*)(e.ss + n * e.ss_cs + (jv * 16 + fr) * 128 + (2 * w + a) * 16 + fq * 4) = pk;
          }
        __syncthreads();
        f32x4 av[NVT];
#pragma unroll
        for (int jv = 0; jv < NVT; ++jv) av[jv] = f32x4{0.f, 0.f, 0.f, 0.f};
#pragma unroll
        for (int ks = 0; ks < 4; ++ks)
#pragma unroll
          for (int jv = 0; jv < NVT; ++jv) {
            bf16x8 sf = *(const bf16x8*)(STc + ((jv * 16 + fr) * 136 + ks * 32 + fq * 8) * 2);
            av[jv] = MFMA16(c.wf[ks], sf, av[jv]);
          }
#pragma unroll
        for (int jv = 0; jv < NVT; ++jv) {
          u16x4 pk;
#pragma unroll
          for (int r = 0; r < 4; ++r) pk[r] = f2bf(bf2f(c.v[jv][r]) - av[jv][r]);
          *(u16x4*)(VT + ((jv * 16 + fr) * 72 + 16 * w + fq * 4) * 2) = pk;
          *(u16x4*)(e.ut + n * e.cs + (jv * 16 + fr) * 64 + 16 * w + fq * 4) = pk;
        }
        __syncthreads();
#pragma unroll
        for (int a = 0; a < 2; ++a) {
#pragma unroll
          for (int jv = 0; jv < NVT; ++jv)
#pragma unroll
            for (int r = 0; r < 4; ++r) S[a][jv][r] *= c.dv;
#pragma unroll
          for (int ks = 0; ks < 2; ++ks)
#pragma unroll
            for (int jv = 0; jv < NVT; ++jv) {
              bf16x8 vf = *(const bf16x8*)(VT + ((jv * 16 + fr) * 72 + ks * 32 + fq * 8) * 2);
              S[a][jv] = MFMA16(c.kf[a][ks], vf, S[a][jv]);
            }
        }
      }
    }
  }
  __syncthreads();
}

template <int NVT, bool USE_RS>
DI void oproj_core(f32x4 (&acc)[NVT], const bfu* qd, const bfu* am, const bfu* st, const bfu* vt, const float* rsp, int w, int fr, int fq) {
#pragma unroll
  for (int jv = 0; jv < NVT; ++jv) acc[jv] = f32x4{0.f, 0.f, 0.f, 0.f};
#pragma unroll
  for (int ks = 0; ks < 4; ++ks) {
    bf16x8 qf = *(const bf16x8*)(qd + (16 * w + fr) * 128 + ks * 32 + fq * 8);
#pragma unroll
    for (int jv = 0; jv < NVT; ++jv) {
      bf16x8 sf = *(const bf16x8*)(st + (jv * 16 + fr) * 128 + ks * 32 + fq * 8);
      acc[jv] = MFMA16(qf, sf, acc[jv]);
    }
  }
  if (USE_RS) {
    f32x4 rs = *(const f32x4*)(rsp + 16 * w + fq * 4);
#pragma unroll
    for (int jv = 0; jv < NVT; ++jv)
#pragma unroll
      for (int r = 0; r < 4; ++r) acc[jv][r] *= rs[r];
  }
#pragma unroll
  for (int ks = 0; ks < 2; ++ks) {
    bf16x8 af = *(const bf16x8*)(am + (16 * w + fr) * 64 + ks * 32 + fq * 8);
#pragma unroll
    for (int jv = 0; jv < NVT; ++jv) {
      bf16x8 vf = *(const bf16x8*)(vt + (jv * 16 + fr) * 64 + ks * 32 + fq * 8);
      acc[jv] = MFMA16(af, vf, acc[jv]);
    }
  }
}
DI void oproj_head128(const bfu* qd, const bfu* am, const bfu* st, const bfu* vt, const bfu* zP, int zld, const float* nw, bfu* Yo) {
  const int tid = TIDX, lane = tid & 63, w = tid >> 6, fr = lane & 15, fq = lane >> 4;
  const int row = 16 * w + (lane >> 2), q = lane & 3;
  u16x8 zr[4];
#pragma unroll
  for (int i = 0; i < 4; ++i) zr[i] = *(const u16x8*)(zP + (long)row * zld + q * 32 + i * 8);
  f32x4 acc[8];
  oproj_core<8, false>(acc, qd, am, st, vt, nullptr, w, fr, fq);
  float* T = (float*)g_smem;
#pragma unroll
  for (int jv = 0; jv < 8; ++jv)
#pragma unroll
    for (int r = 0; r < 4; ++r) T[(16 * w + fq * 4 + r) * 132 + jv * 16 + fr] = acc[jv][r];
  float o[32];
  float ss = 0.f;
#pragma unroll
  for (int i = 0; i < 8; ++i) {
    f32x4 v = *(const f32x4*)(T + row * 132 + q * 32 + i * 4);
#pragma unroll
    for (int j = 0; j < 4; ++j) { o[i * 4 + j] = v[j]; ss += v[j] * v[j]; }
  }
  ss += __shfl_xor(ss, 1); ss += __shfl_xor(ss, 2);
  const float rs = rsqrtf(ss * (1.f / 128.f) + 1e-6f);
#pragma unroll
  for (int i = 0; i < 4; ++i) {
    u16x8 res;
    f32x4 w0 = *(const f32x4*)(nw + q * 32 + i * 8), w1 = *(const f32x4*)(nw + q * 32 + i * 8 + 4);
#pragma unroll
    for (int j = 0; j < 8; ++j) {
      float wv = j < 4 ? w0[j & 3] : w1[j & 3];
      res[j] = f2bf(o[i * 8 + j] * rs * wv * siluf(bf2f(zr[i][j])));
    }
    *(u16x8*)(Yo + (long)row * 512 + q * 32 + i * 8) = res;
  }
}
DI void oproj_ssd(const bfu* Xb  , int g, const float* SCb, const bfu* SSb, const bfu* zP, const float* nw, bfu* Yo) {
  const int tid = TIDX, lane = tid & 63, w = tid >> 6, fr = lane & 15, fq = lane >> 4;
  const int row = 16 * w + (lane >> 2), q = lane & 3;
  float* T = (float*)g_smem;
#pragma unroll
  for (int hh = 0; hh < 4; ++hh) {
    int hd = g * 4 + hh;
    f32x4 acc[4];
    oproj_core<4, true>(acc, Xb + g * 16384, Xb + 32768 + hd * 12288, SSb + hd * 8192, Xb + 32768 + hd * 12288 + 4096, SCb + hd * 256, w, fr, fq);
#pragma unroll
    for (int jv = 0; jv < 4; ++jv)
#pragma unroll
      for (int r = 0; r < 4; ++r) T[(16 * w + fq * 4 + r) * 260 + hh * 64 + jv * 16 + fr] = acc[jv][r];
  }
  float ss = 0.f;
  float o[64];
#pragma unroll
  for (int i = 0; i < 8; ++i) {
    u16x8 z = *(const u16x8*)(zP + (long)row * 512 + q * 64 + i * 8);
    f32x4 v0 = *(const f32x4*)(T + row * 260 + q * 64 + i * 8), v1 = *(const f32x4*)(T + row * 260 + q * 64 + i * 8 + 4);
#pragma unroll
    for (int j = 0; j < 8; ++j) {
      float y = (j < 4 ? v0[j & 3] : v1[j & 3]) * siluf(bf2f(z[j]));
      o[i * 8 + j] = y;
      ss += y * y;
    }
  }
  ss += __shfl_xor(ss, 1); ss += __shfl_xor(ss, 2);
  const float rs = rsqrtf(ss * (1.f / 256.f) + 1e-6f);
#pragma unroll
  for (int i = 0; i < 8; ++i) {
    u16x8 res;
    f32x4 w0 = *(const f32x4*)(nw + q * 64 + i * 8), w1 = *(const f32x4*)(nw + q * 64 + i * 8 + 4);
#pragma unroll
    for (int j = 0; j < 8; ++j) res[j] = f2bf(o[i * 8 + j] * rs * (j < 4 ? w0[j & 3] : w1[j & 3]));
    *(u16x8*)(Yo + (long)row * 512 + q * 64 + i * 8) = res;
  }
}

DI float geluf(float x) { float u = 0.7978845608028654f * (x + 0.044715f * x * x * x); return 0.5f * x * (1.f + tanhf(u)); }

DI void phase_s5_gemm1(const Params& p) {
  const bfu* U2 = (const bfu*)(p.ws + OFF_U2);
  const bfu* Ms = (const bfu*)(p.ws + OFF_MS);
  float* Xloc = (float*)(p.ws + OFF_XLOC);
  for (int t = BIDX; t < 32 * 17; t += gridDim.x) {
    int g = t / 17, tm = t - g * 17;
    f32x4 acc[4][4];
    zero_acc<4>(acc);
    gemm_tile<4>(acc, U2 + ((long)g * 2176 + tm * 128) * 256, 256, Ms + (long)g * 128 * 256, 256, 256);
    ACC_FOREACH(4, { Xloc[((long)g * 2176 + tm * 128 + trow) * 128 + tcol] = acc[m][n][j]; })
  }
}
DI void phase_s5_scan(const Params& p, int layer) {
  float* Xloc = (float*)(p.ws + OFF_XLOC);
  bfu* Xst = (bfu*)(p.ws + OFF_XST);
  const int tid = TIDX;
  const int seg = tid >> 4, p16 = tid & 15;
  float* ex = (float*)g_smem;
  for (int it = BIDX; it < 256; it += gridDim.x) {
    const int g = it >> 3, b = (it >> 2) & 1, pq = it & 3;
    const int pr = pq * 16 + p16;
    const int idx = (layer * 32 + g) * 64 + pr;
    const float dt = expf(p.in[24][layer * 32 + g]);
    const float e1 = p.in[17][idx] * dt * 16.f, a1 = p.in[18][idx] * dt * 16.f;
    const float m16 = expf(e1);
    const float l16x = m16 * cosf(a1), l16y = m16 * sinf(a1);
    const int n0 = seg * 65, n1 = (n0 + 65 < 1028) ? n0 + 65 : 1028;
    const float* xl = Xloc + ((long)g * 2176 + b * 1028) * 128;
    bfu* xs = Xst + ((long)g * 2176 + b * 1028) * 128;
    float sre = 0.f, sim = 0.f;
#pragma unroll 13
    for (int n = n0; n < n1; ++n) {
      float lre = xl[(long)n * 128 + pr], lim = xl[(long)n * 128 + 64 + pr];
      float nre = l16x * sre - l16y * sim + lre;
      float nim = l16x * sim + l16y * sre + lim;
      sre = nre; sim = nim;
    }
    __syncthreads();
    ex[(seg * 16 + p16) * 2] = sre; ex[(seg * 16 + p16) * 2 + 1] = sim;
    __syncthreads();
    float cre = 0.f, cim = 0.f;
    {
      const float mL = expf(e1 * 65.f), aL = a1 * 65.f;
      const float lLx = mL * cosf(aL), lLy = mL * sinf(aL);
      for (int s2 = 0; s2 < seg; ++s2) {
        float ere = ex[(s2 * 16 + p16) * 2], eim = ex[(s2 * 16 + p16) * 2 + 1];
        float nre = lLx * cre - lLy * cim + ere;
        float nim = lLx * cim + lLy * cre + eim;
        cre = nre; cim = nim;
      }
    }
    sre = cre; sim = cim;
#pragma unroll 13
    for (int n = n0; n < n1; ++n) {
      float lre = xl[(long)n * 128 + pr], lim = xl[(long)n * 128 + 64 + pr];
      xs[(long)n * 128 + pr] = f2bf(sre);
      xs[(long)n * 128 + 64 + pr] = f2bf(sim);
      float nre = l16x * sre - l16y * sim + lre;
      float nim = l16x * sim + l16y * sre + lim;
      sre = nre; sim = nim;
    }
  }
}
DI void phase_s5_gemm2(const Params& p) {
  const bfu* U2 = (const bfu*)(p.ws + OFF_U2);
  const bfu* Xst = (const bfu*)(p.ws + OFF_XST);
  const bfu* Mc = (const bfu*)(p.ws + OFF_MC);
  bfu* Ys5 = (bfu*)(p.ws + OFF_YS5);
  for (int t = BIDX; t < 32 * 17 * 2; t += gridDim.x) {
    int g = t / 34, rem = t - g * 34, tm = rem >> 1, tn = rem & 1;
    f32x4 acc[4][4];
    zero_acc<4>(acc);
    const bfu* Bt = Mc + ((long)g * 256 + tn * 128) * 384;
    gemm_tile<4>(acc, U2 + ((long)g * 2176 + tm * 128) * 256, 256, Bt, 384, 256);
    gemm_tile<4>(acc, Xst + ((long)g * 2176 + tm * 128) * 128, 128, Bt + 256, 384, 128);
    ACC_FOREACH(4, {
      int nc = tm * 128 + trow, o = tn * 128 + tcol;
      if (nc < 2056) Ys5[((long)nc * 16 + (o >> 4)) * 512 + g * 16 + (o & 15)] = f2bf(geluf(acc[m][n][j]));
    })
  }
}
DI void phase_glu(const Params& p) {
  const bfu* Ys5 = (const bfu*)(p.ws + OFF_YS5);
  const bfu* Wg = (const bfu*)(p.ws + OFF_WGLU);
  const bfu* Pz = (const bfu*)(p.ws + OFF_PZ);
  bfu* Yd = (bfu*)(p.ws + OFF_Y) + (long)3 * TR * 512;
  for (int v = BIDX; v < 320 * 8; v += gridDim.x) {
    int tm, tn;
    if (!tile_map(v, 8, tm, tn)) continue;
    f32x4 acc[4][4];
    zero_acc<4>(acc);
    gemm_tile<4>(acc, Ys5 + (long)tm * 128 * 512, 512, Wg + (long)tn * 128 * 512, 512, 512);
    const int lane = TIDX & 63, wid = TIDX >> 6, wr = wid >> 1, wc = wid & 1, fr = lane & 15, fq = lane >> 4;
#pragma unroll
    for (int m = 0; m < 4; ++m)
#pragma unroll
      for (int n = 0; n < 2; ++n)
#pragma unroll
        for (int j = 0; j < 4; ++j) {
          int row = tm * 128 + wr * 64 + m * 16 + fq * 4 + j;
          int oc = tn * 64 + wc * 32 + n * 16 + fr;
          float z = bf2f(Pz[(long)row * 512 + oc]);
          Yd[(long)row * 512 + oc] = f2bf(acc[m][n][j] * sigm(acc[m][n + 2][j]) * siluf(z));
        }
  }
}
DI void phase_gates(const Params& p) {
  const bfu* h16 = (const bfu*)(p.ws + OFF_H16);
  const bfu* WT = (const bfu*)(p.ws + OFF_WIN);
  bfu* G = (bfu*)(p.ws + OFF_P);
  for (int v = BIDX; v < 320 * 32; v += gridDim.x) {
    int tm, tn;
    if (!tile_map(v, 32, tm, tn)) continue;
    f32x4 acc[4][4];
    zero_acc<4>(acc);
    gemm_tile<4>(acc, h16 + (long)tm * 128 * 1024, 1024, WT + (long)(6656 + tn * 128) * 1024, 1024, 1024);
    {
      const int lane = TIDX & 63, wid = TIDX >> 6, wr = wid >> 1, wc = wid & 1, fr = lane & 15, fq = lane >> 4;
#pragma unroll
      for (int m = 0; m < 4; ++m)
#pragma unroll
        for (int n = 0; n < 4; ++n) {
          const int row4 = (tm * 128 + wr * 64 + m * 16 + fq * 4) >> 2, col = tn * 128 + wc * 64 + n * 16 + fr;
          u16x4 pk = {f2bf(sigm(acc[m][n][0])), f2bf(sigm(acc[m][n][1])), f2bf(sigm(acc[m][n][2])), f2bf(sigm(acc[m][n][3]))};
          *(u16x4*)(G + ((long)row4 * 4096 + col) * 4) = pk;
        }
    }
  }
}
DI void phase_merge(const Params& p) {
  const bfu* WbT = (const bfu*)(p.ws + OFF_WB);
  const bfu* Y = (const bfu*)(p.ws + OFF_Y);
  const bfu* G = (const bfu*)(p.ws + OFF_P);
  bfu* mixed = (bfu*)(p.ws + OFF_H16);
  for (int v = BIDX; v < 320 * 8; v += gridDim.x) {
    int tm, tn;
    if (!tile_map(v, 8, tm, tn)) continue;
    f32x4 tot[4][4];
    zero_acc<4>(tot);
    for (int b = 0; b < 4; ++b) {
      f32x4 acc[4][4];
      zero_acc<4>(acc);
      gemm_tile<4>(acc, Y + ((long)b * TR + tm * 128) * 512, 512, WbT + (long)(b * 1024 + tn * 128) * 512, 512, 512);
      {
        const int lane = TIDX & 63, wid = TIDX >> 6, wr = wid >> 1, wc = wid & 1, fr = lane & 15, fq = lane >> 4;
#pragma unroll
        for (int m = 0; m < 4; ++m)
#pragma unroll
          for (int n = 0; n < 4; ++n) {
            const int row4 = (tm * 128 + wr * 64 + m * 16 + fq * 4) >> 2, col = b * 1024 + tn * 128 + wc * 64 + n * 16 + fr;
            u16x4 gk = *(const u16x4*)(G + ((long)row4 * 4096 + col) * 4);
#pragma unroll
            for (int j = 0; j < 4; ++j) tot[m][n][j] += bf2f(gk[j]) * acc[m][n][j];
          }
      }
    }
    ACC_FOREACH(4, { mixed[(long)(tm * 128 + trow) * 1024 + tn * 128 + tcol] = f2bf(tot[m][n][j]); })
  }
}
DI void phase_out(const Params& p) {
  const bfu* mixed = (const bfu*)(p.ws + OFF_H16);
  const bfu* WoT = (const bfu*)(p.ws + OFF_WO);
  float* h32 = (float*)(p.ws + OFF_H32);
  const float ALPHA = 1.6817928305074290f;
  for (int v = BIDX; v < 320 * 8; v += gridDim.x) {
    int tm, tn;
    if (!tile_map(v, 8, tm, tn)) continue;
    f32x4 acc[4][4];
    zero_acc<4>(acc);
    gemm_tile<4>(acc, mixed + (long)tm * 128 * 1024, 1024, WoT + (long)tn * 128 * 1024, 1024, 1024);
    ACC_FOREACH(4, {
      long a = (long)(tm * 128 + trow) * 1024 + tn * 128 + tcol;
      h32[a] = ALPHA * h32[a] + acc[m][n][j];
    })
  }
}

DI void run_phase(const Params& p, int ph) {
  if (ph == 0) { phase_tables(p); return; }
  if (ph == NPHASE - 1) { ln_rows(p, 3, true); return; }
  const int layer = (ph - 1) / NPL, sub = (ph - 1) % NPL;
  bfu* Xb = (bfu*)(p.ws + OFF_X);
  float* SC = (float*)(p.ws + OFF_SC);
  bfu* Y = (bfu*)(p.ws + OFF_Y);
  const bfu* Zb = (const bfu*)(p.ws + OFF_Z);
  const int bid = BIDX;
  switch (sub) {
    case 0: ln_rows(p, layer - 1, false); phase_convert(p, layer); break;
    case 1: phase_proj(p, 0, 2048, 0, true, 0); break;
    case 2: for (int it = bid; it < 2056; it += gridDim.x) gdn_prep_item(p, layer, it); break;
    case 3:
      if (bid < 64) {
        int b = bid >> 5, h = (bid >> 3) & 3, sl = bid & 7;
        GdnArgs e;
        bfu* base = Xb + ((long)(b * NCHK) * 4 + h) * 36864;
        e.w = base + 8192; e.kdt = base + 16384; e.ut = base + 24576 + sl * 16 * 64; e.cs = 4 * 36864;
        e.sc = SC + ((long)(b * NCHK) * 4 + h) * 256; e.sc_cs = 4 * 256;
        e.ss = Y + (long)TR * 512 + ((long)(b * NCHK) * 4 + h) * 16384 + sl * 16 * 128; e.ss_cs = 4 * 16384;
        engine_gdn<5, 1>(e);
      } else phase_proj(p, 2048, 1536, 0, false, 64, gridDim.x == 512 ? 64 : 0);
      break;
    case 4:
      for (int it = bid; it < 2056; it += gridDim.x) {
        int h = it & 3; long r0 = (long)(it >> 2) * 64;
        const bfu* base = Xb + (long)it * 36864;
        oproj_head128(base, base + 32768, Y + (long)TR * 512 + (long)it * 16384, base + 24576,
                      Zb + r0 * 512 + h * 128, 512, p.in[8] + layer * 128, Y + r0 * 512 + h * 128);
      }
      break;
    case 5: for (int it = bid; it < 1028; it += gridDim.x) ssd_prep_item(p, layer, it); break;
    case 6:
      if (bid < 64) {
        int b = bid >> 5, hd = (bid >> 2) & 7, sl = (bid >> 1) & 1, kh = bid & 1, g = hd >> 2;
        LinArgs e;
        const bfu* base = Xb + (long)(b * NCHK) * 131072;
        e.kdt = base + g * 16384 + 8192; e.kdt_cs = 131072;
        e.vt = base + 32768 + hd * 12288 + 8192 + sl * 32 * 64; e.vt_cs = 131072;
        e.sc = SC + ((long)(b * NCHK) * 8 + hd) * 256; e.sc_cs = 8 * 256;
        e.ss = Y + (long)2 * TR * 512 + ((long)(b * NCHK) * 8 + hd) * 8192 + sl * 32 * 128; e.ss_cs = 8 * 8192;
        e.kt0 = kh * 4;
        engine_lin<7, 2>(e);
      } else phase_proj(p, 3584, 2048, 0, false, 64, gridDim.x == 512 ? 64 : 0);
      break;
    case 7:
      for (int it = bid; it < 1028; it += gridDim.x) {
        int g = it & 1; long cn = it >> 1; long r0 = cn * 64;
        oproj_ssd(Xb + cn * 131072, g, SC + cn * 8 * 256, Y + (long)2 * TR * 512 + cn * 8 * 8192,
                  Zb + r0 * 512 + g * 256, p.in[14] + layer * 512 + g * 256, Y + (long)TR * 512 + r0 * 512 + g * 256);
      }
      break;
    case 8: for (int it = bid; it < 2056; it += gridDim.x) hg_prep_item(p, layer, it); break;
    case 9:
      if (bid < 64) {
        int b = bid >> 5, h = (bid >> 3) & 3, sl = (bid >> 1) & 3, kh = bid & 1;
        LinArgs e;
        const bfu* base = Xb + ((long)(b * NCHK) * 4 + h) * 28672;
        e.kdt = base + 8192; e.kdt_cs = 4 * 28672;
        e.vt = base + 20480 + sl * 32 * 64; e.vt_cs = 4 * 28672;
        e.sc = SC + ((long)(b * NCHK) * 4 + h) * 256; e.sc_cs = 4 * 256;
        bfu* ssb = b == 0 ? (Y + (long)3 * TR * 512) : (Xb + (long)2056 * 28672);
        e.ss = ssb + (long)h * 16384 + sl * 32 * 128; e.ss_cs = 4 * 16384;
        e.kt0 = kh * 4;
        engine_lin<7, 2>(e);
      } else phase_proj(p, 5632, 1024, 1, false, 64, gridDim.x == 512 ? 64 : 0);
      break;
    case 10:
      for (int it = bid; it < 2056; it += gridDim.x) {
        int h = it & 3; int cn = it >> 2; long r0 = (long)cn * 64;
        int b = cn / NCHK, n = cn - b * NCHK;
        const bfu* base = Xb + (long)it * 28672;
        const bfu* ssb = b == 0 ? (Y + (long)3 * TR * 512) : (Xb + (long)2056 * 28672);
        oproj_head128(base, base + 16384, ssb + ((long)n * 4 + h) * 16384, base + 20480,
                      Zb + r0 * 512 + h * 128, 512, p.in[16] + layer * 128, Y + (long)2 * TR * 512 + r0 * 512 + h * 128);
      }
      break;
    case 11: phase_s5_gemm1(p); break;
    case 12: phase_s5_scan(p, layer); break;
    case 13: phase_s5_gemm2(p); break;
    case 14: phase_glu(p); break;
    case 15: phase_gates(p); break;
    case 16: phase_merge(p); break;
    case 17: phase_out(p); break;
  }
}


#define XB_TMO      128
#define XB_XCNT(j)  (256  + 64 * (j))
#define XB_XSUB(j)  (1280 + 64 * (j))
#define XB_XGEN(j)  (2304 + 64 * (j))
#define XB_TOP      3328
#define XB_TOPGEN   3392
#define XCD_BAR_WORDS 3456
#define XB_SPIN_CAP (1u << 20)
#define LAS __attribute__((address_space(3)))
DI unsigned xb_ld(unsigned* p) { return __hip_atomic_load(p, __ATOMIC_RELAXED, __HIP_MEMORY_SCOPE_AGENT); }
DI unsigned xb_add(unsigned* p, unsigned v) { return __hip_atomic_fetch_add(p, v, __ATOMIC_RELAXED, __HIP_MEMORY_SCOPE_AGENT); }
DI unsigned xb_xcc_id() { return (unsigned)__builtin_amdgcn_s_getreg((3 << 11) | 20) & 0xFu; }
#define XB_SPIN(cond, bar) do { unsigned _sp = 0; while (cond) { __builtin_amdgcn_s_sleep(1); \
    if ((++_sp & 255u) == 0u) { if (xb_ld(&(bar)[XB_TMO])) break; if (_sp > XB_SPIN_CAP) { atomicAdd(&(bar)[XB_TMO], 1u); break; } } } } while (0)
struct XcdBarrier { unsigned* bar; unsigned x; volatile LAS unsigned* st; };
DI XcdBarrier xcd_barrier_post(unsigned* bar, volatile LAS unsigned* st) {
  XcdBarrier b; b.bar = bar; b.x = xb_xcc_id(); b.st = st;
  if (threadIdx.x == 0) (void)xb_add(&bar[XB_XCNT(b.x)], 1u);
  return b;
}
DI void xcd_barrier_complete(unsigned* bar, unsigned x, unsigned& nloc, unsigned& nx) {
  const unsigned G = gridDim.x * gridDim.y * gridDim.z;
  unsigned sum, cnt, mine, sp = 0u;
  for (;;) {
    sum = 0u; cnt = 0u; mine = 0u;
#pragma unroll
    for (unsigned j = 0; j < 16; ++j) { const unsigned c = xb_ld(&bar[XB_XCNT(j)]); sum += c; cnt += (c > 0u) ? 1u : 0u; mine = (j == x) ? c : mine; }
    if (sum == G) break;
    __builtin_amdgcn_s_sleep(1);
    if ((++sp & 255u) == 0u) { if (xb_ld(&bar[XB_TMO])) break; if (sp > XB_SPIN_CAP) { atomicAdd(&bar[XB_TMO], 1u); break; } }
  }
  nloc = mine > 0u ? mine : 1u; nx = cnt > 0u ? cnt : 1u;
}
DI void xcd_barrier(const XcdBarrier& b) {
  asm volatile("s_waitcnt vmcnt(0)" ::: "memory");
  __syncthreads();
  if (threadIdx.x == 0) {
    unsigned* bar = b.bar;
    __builtin_amdgcn_s_waitcnt(0);
    unsigned nloc = b.st[0], nx = b.st[1];
    if (nloc == 0u) { xcd_barrier_complete(bar, b.x, nloc, nx); b.st[0] = nloc; b.st[1] = nx; }
    const unsigned old = xb_add(&bar[XB_XSUB(b.x)], 1u);
    const unsigned gen = old / nloc;
    if (old + 1u == (gen + 1u) * nloc) {
      __builtin_amdgcn_fence(__ATOMIC_RELEASE, "agent");
      asm volatile("s_waitcnt vmcnt(0)" ::: "memory");
      const unsigned og = xb_add(&bar[XB_TOP], 1u);
      const unsigned tg = og / nx;
      if (og + 1u == (tg + 1u) * nx) xb_add(&bar[XB_TOPGEN], 1u);
      else XB_SPIN(xb_ld(&bar[XB_TOPGEN]) == tg, bar);
      __builtin_amdgcn_fence(__ATOMIC_ACQUIRE, "agent");
      xb_add(&bar[XB_XGEN(b.x)], 1u);
      asm volatile("s_waitcnt vmcnt(0)" ::: "memory");
    } else {
      XB_SPIN(xb_ld(&bar[XB_XGEN(b.x)]) == gen, bar);
      __builtin_amdgcn_fence(__ATOMIC_ACQUIRE, "agent");
      asm volatile("s_waitcnt vmcnt(0)" ::: "memory");
    }
  }
  __syncthreads();
}
#ifndef DBL_MASK
#define DBL_MASK 0
#endif
#ifndef TIMING_PROBE
#define TIMING_PROBE 0
#endif
#ifndef TP_MASK_A
#define TP_MASK_A 0
#endif
#ifndef TP_MASK_B
#define TP_MASK_B 0
#endif
__global__ void __launch_bounds__(256, 2) mega_kernel(Params p, int ph_lo, int ph_hi) {
  if (ph_hi - ph_lo == 1) { run_phase(p, ph_lo); return; }
  cg::grid_group grid = cg::this_grid();
  volatile LAS unsigned* xst = (volatile LAS unsigned*)(g_smem + LDS_BYTES - 16);
  if (threadIdx.x == 0) { xst[0] = 0u; xst[1] = 0u; xst[2] = 0u; xst[3] = 0u; }
  __syncthreads();
  XcdBarrier xb = xcd_barrier_post((unsigned*)(p.ws + OFF_BAR), xst);
  for (int ph = ph_lo; ph < ph_hi; ++ph) {
    run_phase(p, ph);
#if DBL_MASK
    if (ph > 0 && ph < NPHASE - 1 && ((DBL_MASK >> ((ph - 1) % NPL)) & 1)) { xcd_barrier(xb); run_phase(p, ph); }
#endif
    if (ph + 1 < ph_hi) {
      if (ph == ph_lo) grid.sync();
      else xcd_barrier(xb);
    }
  }
}

extern "C" void kernel_launch(void* const* d_in, const int* in_sizes, int n_in, void* d_out, int out_size, void* d_ws, size_t ws_size,
                              hipStream_t stream) {
  static int grid_blocks = 0;
  if (!grid_blocks) {
    int dev = 0, cus = 0, per_cu = 0;
    hipGetDevice(&dev);
    hipDeviceGetAttribute(&cus, hipDeviceAttributeMultiprocessorCount, dev);
    hipFuncSetAttribute((const void*)mega_kernel, hipFuncAttributeMaxDynamicSharedMemorySize, LDS_BYTES);
    hipOccupancyMaxActiveBlocksPerMultiprocessor(&per_cu, mega_kernel, 256, LDS_BYTES);
    if (per_cu > 2) per_cu = 2;
    if (per_cu < 1) per_cu = 1;
    grid_blocks = cus * per_cu;
  }
  if (ws_size < WS_NEEDED) { fprintf(stderr, "workspace too small: %zu < %zu\n", ws_size, WS_NEEDED); return; }
  Params p{};
  for (int i = 0; i < 31; ++i) p.in[i] = (const float*)d_in[i];
  p.out = (float*)d_out;
  p.ws = (char*)d_ws;
#if MULTI_LAUNCH
  for (int ph = 0; ph < NPHASE; ++ph) {
    hipLaunchKernelGGL(mega_kernel, dim3(grid_blocks), dim3(256), LDS_BYTES, stream, p, ph, ph + 1);
  }
#else
  int lo = 0, hi = NPHASE;
  hipMemsetAsync((char*)d_ws + OFF_BAR, 0, 16384, stream);
  void* args[] = {&p, &lo, &hi};
  hipError_t e = hipLaunchCooperativeKernel((void*)mega_kernel, dim3(grid_blocks), dim3(256), args, LDS_BYTES, stream);
  if (e != hipSuccess) fprintf(stderr, "cooperative launch failed: %s (grid %d)\n", hipGetErrorString(e), grid_blocks);
#endif
}
```
